# Optimizing an MI355X kernel written in HIP

```python
import math
import jax, jax.numpy as jnp
from jax import lax
import numpy as np

D_MODEL = 1024
BATCH = 4
SEQ = 8192
DEPTH = 2

N_HEADS = 16
HEAD_DIM = D_MODEL // N_HEADS
Q_BLOCK = 128
CONV_WIDTH = 3
D_FF = 2816
N_EXPERTS = 8
TOP_K = 2
RMS_EPS = 1e-6
N_EVEN = (DEPTH + 1) // 2
N_ODD = DEPTH // 2

kernel_name = "fox_shortconv_moe_hybrid"


def rmsnorm(x, g):
    x32 = x.astype(jnp.float32)
    y = x32 * lax.rsqrt(jnp.mean(x32 * x32, axis=-1, keepdims=True) + RMS_EPS)
    return (y * g.astype(jnp.float32)).astype(x.dtype)


def swiglu(t, w_gate, w_up, w_down):
    return (jax.nn.silu(t @ w_gate) * (t @ w_up)) @ w_down


def forgetting_attention(h, w_in, b_forget, w_out):
    bsz, seq, _ = h.shape
    proj = h @ w_in
    q = proj[..., :D_MODEL].reshape(bsz, seq, N_HEADS, HEAD_DIM)
    k = proj[..., D_MODEL:2 * D_MODEL].reshape(bsz, seq, N_HEADS, HEAD_DIM)
    v = proj[..., 2 * D_MODEL:3 * D_MODEL].reshape(bsz, seq, N_HEADS, HEAD_DIM)
    f_logit = proj[..., 3 * D_MODEL:] + b_forget
    log_f = jax.nn.log_sigmoid(f_logit.astype(jnp.float32))
    c = jnp.cumsum(log_f, axis=1).transpose(0, 2, 1)
    scale = 1.0 / math.sqrt(HEAD_DIM)
    key_pos = jnp.arange(seq)

    def query_block(i):
        start = i * Q_BLOCK
        qb = lax.dynamic_slice_in_dim(q, start, Q_BLOCK, axis=1)
        cb = lax.dynamic_slice_in_dim(c, start, Q_BLOCK, axis=2)
        s = jnp.einsum('bqhd,bkhd->bhqk', qb, k).astype(jnp.float32) * scale
        s = s + cb[:, :, :, None] - c[:, :, None, :]
        q_pos = start + jnp.arange(Q_BLOCK)
        causal = key_pos[None, :] <= q_pos[:, None]
        s = jnp.where(causal[None, None], s, -jnp.inf)
        p = jax.nn.softmax(s, axis=-1)
        return jnp.einsum('bhqk,bkhd->bqhd', p.astype(v.dtype), v)

    o = lax.map(query_block, jnp.arange(seq // Q_BLOCK))
    o = o.transpose(1, 0, 2, 3, 4).reshape(bsz, seq, D_MODEL)
    return o @ w_out


def short_conv_mixer(h, w_in, conv_w, w_out):
    proj = h @ w_in
    gate_b = proj[..., :D_MODEL]
    gate_c = proj[..., D_MODEL:2 * D_MODEL]
    xv = proj[..., 2 * D_MODEL:]
    u = gate_c * xv
    conv = lax.conv_general_dilated(
        u, conv_w[:, None, :].astype(u.dtype), window_strides=(1,),
        padding=[(CONV_WIDTH - 1, 0)],
        dimension_numbers=('NWC', 'WIO', 'NWC'),
        feature_group_count=D_MODEL)
    return (gate_b * conv) @ w_out


def expert_swiglu(h, w_router, w_gate, w_up, w_down):
    bsz, seq, _ = h.shape
    t = h.reshape(bsz * seq, D_MODEL)
    logits = (t @ w_router).astype(jnp.float32)
    top_v, top_i = lax.top_k(logits, TOP_K)
    top_w = jax.nn.softmax(top_v, axis=-1)
    gates = jnp.sum(jax.nn.one_hot(top_i, N_EXPERTS, dtype=jnp.float32) * top_w[..., None], axis=1)
    out = jnp.zeros_like(t)
    for e in range(N_EXPERTS):
        y = swiglu(t, w_gate[e], w_up[e], w_down[e])
        out = out + gates[:, e:e + 1].astype(t.dtype) * y
    return out.reshape(bsz, seq, D_MODEL)


def setup_inputs(seed: int = 0) -> dict:
    key = jax.random.key(seed)
    ks = jax.random.split(key, 20)
    D, H, F, E = D_MODEL, N_HEADS, D_FF, N_EXPERTS
    nrm = lambda k, shape, fan_in: jax.random.normal(k, shape, jnp.float32) * fan_in ** -0.5
    gain = lambda k, shape: 1.0 + 0.02 * jax.random.normal(k, shape, jnp.float32)
    return {
        "x": jax.random.normal(ks[0], (BATCH, SEQ, D), jnp.float32),
        "attn_norm": gain(ks[1], (N_EVEN, D)),
        "attn_w_in": nrm(ks[2], (N_EVEN, D, 3 * D + H), D),
        "attn_b_forget": jax.random.uniform(ks[3], (N_EVEN, H), jnp.float32, 1.0, 5.0),
        "attn_w_out": nrm(ks[4], (N_EVEN, D, D), D),
        "ffn_norm": gain(ks[5], (N_EVEN, D)),
        "ffn_w_gate": nrm(ks[6], (N_EVEN, D, F), D),
        "ffn_w_up": nrm(ks[7], (N_EVEN, D, F), D),
        "ffn_w_down": nrm(ks[8], (N_EVEN, F, D), F),
        "conv_norm": gain(ks[9], (N_ODD, D)),
        "conv_w_in": nrm(ks[10], (N_ODD, D, 3 * D), D),
        "conv_w": nrm(ks[11], (N_ODD, CONV_WIDTH, D), CONV_WIDTH),
        "conv_w_out": nrm(ks[12], (N_ODD, D, D), D),
        "moe_norm": gain(ks[13], (N_ODD, D)),
        "moe_w_router": nrm(ks[14], (N_ODD, D, E), D),
        "moe_w_gate": nrm(ks[15], (N_ODD, E, D, F), D),
        "moe_w_up": nrm(ks[16], (N_ODD, E, D, F), D),
        "moe_w_down": nrm(ks[17], (N_ODD, E, F, D), F),
        "final_norm": gain(ks[18], (D,)),
    }


def reference(x, attn_norm, attn_w_in, attn_b_forget, attn_w_out,
              ffn_norm, ffn_w_gate, ffn_w_up, ffn_w_down,
              conv_norm, conv_w_in, conv_w, conv_w_out,
              moe_norm, moe_w_router, moe_w_gate, moe_w_up, moe_w_down,
              final_norm):
    h = x
    for i in range(DEPTH):
        j = i // 2
        if i % 2 == 0:
            h = h + forgetting_attention(rmsnorm(h, attn_norm[j]), attn_w_in[j],
                                         attn_b_forget[j], attn_w_out[j])
            h = h + swiglu(rmsnorm(h, ffn_norm[j]), ffn_w_gate[j], ffn_w_up[j], ffn_w_down[j])
        else:
            h = h + short_conv_mixer(rmsnorm(h, conv_norm[j]), conv_w_in[j],
                                     conv_w[j], conv_w_out[j])
            h = h + expert_swiglu(rmsnorm(h, moe_norm[j]), moe_w_router[j],
                                  moe_w_gate[j], moe_w_up[j], moe_w_down[j])
    return rmsnorm(h, final_norm)
```

```cpp
#include <hip/hip_runtime.h>
#include <hip/hip_bf16.h>
#include <cstdio>
#include <cstdint>
#include <cmath>
namespace pg8 {
#define PG8_LAS __attribute__((address_space(3)))
typedef unsigned short bf16_t;
typedef short bf16x8 __attribute__((ext_vector_type(8)));
typedef float f32x4 __attribute__((ext_vector_type(4)));
typedef float f32x2 __attribute__((ext_vector_type(2)));
typedef unsigned u32x4 __attribute__((ext_vector_type(4)));
typedef int i32x4 __attribute__((ext_vector_type(4)));
typedef int i32x8 __attribute__((ext_vector_type(8)));
typedef _Float16 f16x8 __attribute__((ext_vector_type(8)));
typedef _Float16 f16x2 __attribute__((ext_vector_type(2)));
typedef unsigned u32x2 __attribute__((ext_vector_type(2)));
constexpr int BM = 256, BK = 64, HALF = 128, HTB = HALF * BK * 2  , STAGE_BYTES = 8 * HTB, NXCD = 8, WGM = 8;

__host__ __device__ __forceinline__ int lds_byte(int r, int c) { const int st = (r >> 4) * 2 + (c >> 5), rr = r & 15, cc = c & 31, ob = rr * 64 + cc * 2; return st * 1024 + (ob ^ (((ob >> 9) & 1) << 5)); }
__host__ __device__ __forceinline__ void stage_rc(int b, int& R, int& C) { const int st = b / 1024, sb = b % 1024, swz = sb ^ (((sb >> 9) & 1) << 5); R = (st >> 1) * 16 + swz / 64; C = (st & 1) * 32 + (swz % 64) / 2; }
__host__ __device__ __forceinline__ int perm32(int rho) { const int n = rho >> 4, i = rho & 15; return 8 * (i >> 2) + 4 * n + (i & 3); }

struct Unit { int pm, pn, e, lrow0, ui; };

__device__ __forceinline__ bool tile_order(int i, int G, int c, int nM, int nN, int& pm, int& pn) {
    const int nwg = nM * nN; const long L = (long)i * G + c; if (L >= nwg) return false;
    int wgid = (int)L; { const int q = nwg / NXCD, r = nwg % NXCD, xcd = wgid % NXCD, off = wgid / NXCD; wgid = (xcd < r ? xcd * (q + 1) : r * (q + 1) + (xcd - r) * q) + off; }
    const int nig = WGM * nN, gid = wgid / nig, fm = gid * WGM, gsz = (nM - fm) < WGM ? (nM - fm) : WGM;
    pm = fm + ((wgid % nig) % gsz); pn = (wgid % nig) / gsz; return true;
}
template <int K, int nM, int nN> struct DenseSched {
    int G, c; const char* Bt;
    __device__ __forceinline__ bool next(int i, Unit& u) const { u.e = 0; u.lrow0 = 0; u.ui = i; return tile_order(i, G, c, nM, nN, u.pm, u.pn); }
    __device__ __forceinline__ unsigned a_off(const Unit& u, int r) const { return (unsigned)(u.pm * BM + r) * (unsigned)(K * 2); }
    __device__ __forceinline__ const char* b_ptr(const Unit& u) const { return Bt + (size_t)u.pn * BM * K * 2; }
    __device__ __forceinline__ void a_ready(const Unit&) const {}
    __device__ __forceinline__ void done(const Unit&) const {}
};
__device__ __forceinline__ unsigned cvt_pk_bf16(float lo, float hi);
template <int K, int nM, int ldc, int tiles_per_seq> struct ConvSched {
    int G, c; const char* Bt; const bf16_t* U; const bf16_t* Bg; bf16_t* Z; const float* cw; float* zp; float* bgb;
    __device__ __forceinline__ bool next(int i, Unit& u) const { const int tr = i / 3, sub = i - 3 * tr; int pm, a; if (!tile_order(tr, G, c, nM, 4, pm, a)) return false;
        u.pm = pm; u.pn = sub < 2 ? 2 * a + sub : 8 + a; u.e = 0; u.lrow0 = 0; u.ui = i; return true; }
    __device__ __forceinline__ unsigned a_off(const Unit& u, int r) const { return (unsigned)(u.pm * BM + r) * (unsigned)(K * 2); }
    __device__ __forceinline__ const char* b_ptr(const Unit& u) const { return Bt + (size_t)u.pn * BM * K * 2; }
    __device__ __forceinline__ void a_ready(const Unit&) const {}
    __device__ __forceinline__ void done(const Unit& u) const {
        if (u.pn < 8) return;
        asm volatile("s_waitcnt vmcnt(0)" ::: "memory"); __builtin_amdgcn_s_barrier(); asm volatile("" ::: "memory");
        int t = threadIdx.x; asm volatile("" : "+v"(t));
        const int cg = t & 31, rsl = t >> 5, col = (u.pn - 8) * BM + 8 * cg, r0 = 16 * rsl; const size_t g0 = (size_t)u.pm * BM + r0;
        const bool seam = (u.pm % tiles_per_seq) != 0;
        float w0[8], w1[8], w2[8];
#pragma unroll
        for (int i = 0; i < 8; ++i) { w0[i] = cw[col + i]; w1[i] = cw[ldc + col + i]; w2[i] = cw[2 * ldc + col + i]; }
        u32x4 u1 = (u32x4){0u, 0u, 0u, 0u}, u2 = (u32x4){0u, 0u, 0u, 0u};
        if (r0 > 0) { u1 = *(const u32x4*)(U + (g0 - 1) * ldc + col); u2 = *(const u32x4*)(U + (g0 - 2) * ldc + col); }
#pragma unroll 1
        for (int rb = 0; rb < 16; rb += 4) { u32x4 uu[4], bb[4];
#pragma unroll
            for (int k = 0; k < 4; ++k) { uu[k] = *(const u32x4*)(U + (g0 + rb + k) * ldc + col); bb[k] = *(const u32x4*)(Bg + (g0 + rb + k) * ldc + col); }
#pragma unroll
            for (int k = 0; k < 4; ++k) { float zf[8], gf[8]; u32x4 o;
#pragma unroll
                for (int j = 0; j < 4; ++j) {
                    const float b0 = __uint_as_float(bb[k][j] << 16), b1 = __uint_as_float(bb[k][j] & 0xffff0000u);
                    const float c0 = w0[2 * j] * __uint_as_float(u2[j] << 16) + w1[2 * j] * __uint_as_float(u1[j] << 16) + w2[2 * j] * __uint_as_float(uu[k][j] << 16);
                    const float c1 = w0[2 * j + 1] * __uint_as_float(u2[j] & 0xffff0000u) + w1[2 * j + 1] * __uint_as_float(u1[j] & 0xffff0000u) + w2[2 * j + 1] * __uint_as_float(uu[k][j] & 0xffff0000u);
                    zf[2 * j] = b0 * c0; zf[2 * j + 1] = b1 * c1; gf[2 * j] = b0; gf[2 * j + 1] = b1; o[j] = cvt_pk_bf16(zf[2 * j], zf[2 * j + 1]); }
                *(u32x4*)(Z + (g0 + rb + k) * ldc + col) = o;
                if (seam && r0 + rb + k < 2) { float* p = zp + ((size_t)u.pm * 2 + rb + k) * ldc + col; float* q = bgb + ((size_t)u.pm * 2 + rb + k) * ldc + col;
                    *(f32x4*)p = (f32x4){zf[0], zf[1], zf[2], zf[3]}; *(f32x4*)(p + 4) = (f32x4){zf[4], zf[5], zf[6], zf[7]}; *(f32x4*)q = (f32x4){gf[0], gf[1], gf[2], gf[3]}; *(f32x4*)(q + 4) = (f32x4){gf[4], gf[5], gf[6], gf[7]}; }
                u2 = u1; u1 = uu[k]; } }
    }
};
template <bool GATHER, int K, int nN, int ntok> struct MoeSched {
    static constexpr size_t estride = (size_t)nN * BM * K * 2;
    int G, c; const char* Bt; const PG8_LAS int* tab; const int* list; const PG8_LAS unsigned short* gtok;
    __device__ __forceinline__ bool next(int i, Unit& u) const {
        const int nM = __builtin_amdgcn_readfirstlane(tab[8]); if (!tile_order(i, G, c, nM, nN, u.pm, u.pn)) return false;
        int e = 0;
#pragma unroll
        for (int j = 1; j < 8; ++j) e += (u.pm >= __builtin_amdgcn_readfirstlane(tab[j])) ? 1 : 0;
        u.e = e; u.lrow0 = (u.pm - __builtin_amdgcn_readfirstlane(tab[e])) * BM; u.ui = i; return true;
    }
    __device__ __forceinline__ unsigned a_off(const Unit& u, int r) const {
        if (GATHER) return (unsigned)gtok[u.ui * BM + r] * (unsigned)(K * 2);
        return (unsigned)(u.pm * BM + r) * (unsigned)(K * 2);
    }
    __device__ __forceinline__ const char* b_ptr(const Unit& u) const { return Bt + (size_t)u.e * estride + (size_t)u.pn * BM * K * 2; }
    __device__ __forceinline__ void a_ready(const Unit&) const {}
    __device__ __forceinline__ void done(const Unit&) const {}
    __device__ __forceinline__ void fill_gtok(PG8_LAS unsigned short* g, int max_units) const {
        Unit u;
        for (int i = 0; i < max_units && next(i, u); ++i) { const int cnt = __builtin_amdgcn_readfirstlane(tab[16 + u.e]);
            if (threadIdx.x < BM) { const int lr = u.lrow0 + (int)threadIdx.x; g[i * BM + threadIdx.x] = (unsigned short)((lr < cnt) ? list[(size_t)u.e * ntok + lr] : 0); } }
        __syncthreads();
    }
};

__device__ __forceinline__ unsigned cvt_pk_bf16(float lo, float hi) { unsigned r; asm volatile("v_cvt_pk_bf16_f32 %0, %1, %2" : "=v"(r) : "v"(lo), "v"(hi)); return r; }
__device__ __forceinline__ unsigned pk2h(float lo, float hi) { const f16x2 v = {(_Float16)lo, (_Float16)hi}; return __builtin_bit_cast(unsigned, v); }
__device__ __forceinline__ float h_lo(unsigned w) { return (float)__builtin_bit_cast(f16x2, w)[0]; }
__device__ __forceinline__ float h_hi(unsigned w) { return (float)__builtin_bit_cast(f16x2, w)[1]; }
__device__ __forceinline__ float silu_f(float g) { return g * __builtin_amdgcn_rcpf(1.0f + __builtin_amdgcn_exp2f(-1.4426950408889634f * g)); }

template <int ldc, int split_cols> struct EpiBf16 {
    static constexpr bool PERM = true;
    bf16_t* O; size_t split_stride; float scale0;
    unsigned* nrm; int rows_per_batch;
    __device__ __forceinline__ void operator()(const f32x4 (&acc)[2][2][4][2], const Unit& u, int wr, int wc, int fr, int fq) const {
        const int row0 = u.pm * BM + wr * 64 + fr; int colt = u.pn * BM; bf16_t* base = O; int tsel = 0;
        float sc = 1.f; if (split_cols) { const int t = colt / split_cols; tsel = t; base += (size_t)t * split_stride; colt -= t * split_cols; if (t == 0) sc = scale0; }
        const int col0 = colt + wc * 32 + 8 * fq;
        if (nrm && tsel < 2) {
#pragma unroll
            for (int bj = 0; bj < 2; ++bj) { float mx = 0.f;
#pragma unroll
                for (int ai = 0; ai < 2; ++ai)
#pragma unroll
                    for (int m = 0; m < 4; ++m) { const f32x4 v0 = acc[ai][bj][m][0] * sc, v1 = acc[ai][bj][m][1] * sc;
                        float s2 = ((v0[0] * v0[0] + v0[1] * v0[1]) + (v0[2] * v0[2] + v0[3] * v0[3])) + ((v1[0] * v1[0] + v1[1] * v1[1]) + (v1[2] * v1[2] + v1[3] * v1[3]));
                        s2 += __shfl_xor(s2, 16); s2 += __shfl_xor(s2, 32); mx = fmaxf(mx, s2); }
                mx = fmaxf(mx, __shfl_xor(mx, 1)); mx = fmaxf(mx, __shfl_xor(mx, 2)); mx = fmaxf(mx, __shfl_xor(mx, 4)); mx = fmaxf(mx, __shfl_xor(mx, 8));
                const int head = (colt + bj * HALF + wc * 32) >> 6, b = (u.pm * BM) / rows_per_batch;
                if ((fr | fq) == 0) __hip_atomic_fetch_max(nrm + ((tsel * 64 + b * 16 + head) * 2 + (wc & 1)), __float_as_uint(mx), __ATOMIC_RELAXED, __HIP_MEMORY_SCOPE_AGENT); }
        }
#pragma unroll
        for (int ai = 0; ai < 2; ++ai)
#pragma unroll
            for (int m = 0; m < 4; ++m) { bf16_t* rowp = base + (size_t)(row0 + ai * HALF + m * 16) * ldc + col0;
#pragma unroll
                for (int bj = 0; bj < 2; ++bj) { const f32x4 v0 = acc[ai][bj][m][0] * sc, v1 = acc[ai][bj][m][1] * sc;
                    u32x4 w; w.x = cvt_pk_bf16(v0[0], v0[1]); w.y = cvt_pk_bf16(v0[2], v0[3]); w.z = cvt_pk_bf16(v1[0], v1[1]); w.w = cvt_pk_bf16(v1[2], v1[3]);
                    *(u32x4*)(rowp + bj * HALF) = w; } }
    }
};
struct RowScale {
    const float* ss; PG8_LAS float* tab; int last_pm; float inv_n, eps;
    __device__ __forceinline__ void prepare(int pm) {
        if (pm == last_pm) return;
        last_pm = pm;
        const int t = threadIdx.x, row = t >> 1, h = t & 1;
        const f32x4* p = (const f32x4*)(ss + ((size_t)pm * BM + row) * 16 + h * 8);
        const f32x4 a = p[0], b = p[1]; float s = ((a[0] + a[1]) + (a[2] + a[3])) + ((b[0] + b[1]) + (b[2] + b[3]));
        s += __shfl_xor(s, 1);
        asm volatile("s_waitcnt lgkmcnt(0)" ::: "memory"); __builtin_amdgcn_s_barrier(); asm volatile("" ::: "memory");
        if (h == 0) tab[row] = 1.0f / sqrtf(s * inv_n + eps);
        asm volatile("s_waitcnt lgkmcnt(0)" ::: "memory"); __builtin_amdgcn_s_barrier(); asm volatile("" ::: "memory");
    }
    __device__ __forceinline__ float get(int r) const { return tab[r]; }
};
__device__ __forceinline__ unsigned pk4_fp8(float a, float b, float c, float d) { int p = __builtin_amdgcn_cvt_pk_fp8_f32(a, b, 0, false); p = __builtin_amdgcn_cvt_pk_fp8_f32(c, d, p, true); return (unsigned)p; }
constexpr float W8_SCALE = 256.f, H8_SCALE = 4.f;
template <int ldh> struct EpiSwiGLU8 {
    static constexpr bool PERM = true;
    unsigned char* H;
    __device__ __forceinline__ void operator()(const f32x4 (&acc)[2][2][4][2], const Unit& u, int wr, int wc, int fr, int fq) {
        const int row0 = u.pm * BM + wr * 64 + fr + (fq & 1) * 16, col0 = u.pn * HALF + wc * 32 + 16 * (fq >> 1); const float r = 1.0f / W8_SCALE;
#pragma unroll
        for (int ai = 0; ai < 2; ++ai)
#pragma unroll
            for (int p = 0; p < 2; ++p) { u32x2 w[2];
#pragma unroll
                for (int q = 0; q < 2; ++q) { const int m = 2 * p + q;
                    const f32x4 g0 = acc[ai][0][m][0] * r, g1 = acc[ai][0][m][1] * r, u0 = acc[ai][1][m][0] * (r * H8_SCALE), u1 = acc[ai][1][m][1] * (r * H8_SCALE);
                    w[q].x = pk4_fp8(silu_f(g0[0]) * u0[0], silu_f(g0[1]) * u0[1], silu_f(g0[2]) * u0[2], silu_f(g0[3]) * u0[3]);
                    w[q].y = pk4_fp8(silu_f(g1[0]) * u1[0], silu_f(g1[1]) * u1[1], silu_f(g1[2]) * u1[2], silu_f(g1[3]) * u1[3]); }
                const auto r0 = __builtin_amdgcn_permlane16_swap(w[0].x, w[1].x, false, false), r1 = __builtin_amdgcn_permlane16_swap(w[0].y, w[1].y, false, false);
                u32x4 o; o.x = r0[0]; o.y = r1[0]; o.z = r0[1]; o.w = r1[1];
                *(u32x4*)(H + (size_t)(row0 + ai * HALF + p * 32) * ldh + col0) = o; }
    }
};
template <int ldc> struct EpiY8 {
    static constexpr bool PERM = true;
    bf16_t* Y;
    __device__ __forceinline__ void operator()(const f32x4 (&acc)[2][2][4][2], const Unit& u, int wr, int wc, int fr, int fq) {
        const int row0 = u.pm * BM + wr * 64 + fr, col0 = u.pn * BM + wc * 32 + 8 * fq; const float sc = 1.0f / (W8_SCALE * H8_SCALE);
#pragma unroll
        for (int ai = 0; ai < 2; ++ai)
#pragma unroll
            for (int m = 0; m < 4; ++m) { bf16_t* rowp = Y + (size_t)(row0 + ai * HALF + m * 16) * ldc + col0;
#pragma unroll
                for (int bj = 0; bj < 2; ++bj) { const f32x4 v0 = acc[ai][bj][m][0] * sc, v1 = acc[ai][bj][m][1] * sc;
                    u32x4 w; w.x = cvt_pk_bf16(v0[0], v0[1]); w.y = cvt_pk_bf16(v0[2], v0[3]); w.z = cvt_pk_bf16(v1[0], v1[1]); w.w = cvt_pk_bf16(v1[2], v1[3]);
                    *(u32x4*)(rowp + bj * HALF) = w; } }
    }
};
template <int ldh, bool SCALED = false> struct EpiSwiGLU {
    static constexpr bool PERM = true;
    bf16_t* H; RowScale rs;
    __device__ __forceinline__ void operator()(const f32x4 (&acc)[2][2][4][2], const Unit& u, int wr, int wc, int fr, int fq) {
        const int row0 = u.pm * BM + wr * 64 + fr, col0 = u.pn * HALF + wc * 32 + 8 * fq;
        if (SCALED) rs.prepare(u.pm);
#pragma unroll
        for (int ai = 0; ai < 2; ++ai)
#pragma unroll
            for (int m = 0; m < 4; ++m) { bf16_t* rowp = H + (size_t)(row0 + ai * HALF + m * 16) * ldh + col0;
                const float r = SCALED ? rs.get(ai * HALF + wr * 64 + m * 16 + fr) : 1.0f;
                const f32x4 g0 = acc[ai][0][m][0] * r, g1 = acc[ai][0][m][1] * r, u0 = acc[ai][1][m][0] * r, u1 = acc[ai][1][m][1] * r;
                u32x4 w; w.x = cvt_pk_bf16(silu_f(g0[0]) * u0[0], silu_f(g0[1]) * u0[1]); w.y = cvt_pk_bf16(silu_f(g0[2]) * u0[2], silu_f(g0[3]) * u0[3]);
                w.z = cvt_pk_bf16(silu_f(g1[0]) * u1[0], silu_f(g1[1]) * u1[1]); w.w = cvt_pk_bf16(silu_f(g1[2]) * u1[2], silu_f(g1[3]) * u1[3]);
                *(u32x4*)rowp = w; }
    }
};
template <int ldc> struct EpiConvIn {
    static constexpr bool PERM = true;
    bf16_t* U; bf16_t* Bg; RowScale rs;
    __device__ __forceinline__ void operator()(const f32x4 (&acc)[2][2][4][2], const Unit& u, int wr, int wc, int fr, int fq) {
        const int row0 = u.pm * BM + wr * 64 + fr;
        rs.prepare(u.pm);
        if (u.pn < 8) {
            const int col0 = u.pn * HALF + wc * 32 + 8 * fq;
#pragma unroll
            for (int ai = 0; ai < 2; ++ai)
#pragma unroll
                for (int m = 0; m < 4; ++m) { bf16_t* rowp = U + (size_t)(row0 + ai * HALF + m * 16) * ldc + col0;
                    const float r = rs.get(ai * HALF + wr * 64 + m * 16 + fr), r2 = r * r;
                    const f32x4 a0 = acc[ai][0][m][0] * acc[ai][1][m][0] * r2, a1 = acc[ai][0][m][1] * acc[ai][1][m][1] * r2;
                    u32x4 w; w.x = cvt_pk_bf16(a0[0], a0[1]); w.y = cvt_pk_bf16(a0[2], a0[3]); w.z = cvt_pk_bf16(a1[0], a1[1]); w.w = cvt_pk_bf16(a1[2], a1[3]);
                    *(u32x4*)rowp = w; }
        } else {
            const int col0 = (u.pn - 8) * BM + wc * 32 + 8 * fq;
#pragma unroll
            for (int ai = 0; ai < 2; ++ai)
#pragma unroll
                for (int m = 0; m < 4; ++m) { bf16_t* rowp = Bg + (size_t)(row0 + ai * HALF + m * 16) * ldc + col0; const float r = rs.get(ai * HALF + wr * 64 + m * 16 + fr);
#pragma unroll
                    for (int bj = 0; bj < 2; ++bj) { const f32x4 v0 = acc[ai][bj][m][0] * r, v1 = acc[ai][bj][m][1] * r;
                        u32x4 w; w.x = cvt_pk_bf16(v0[0], v0[1]); w.y = cvt_pk_bf16(v0[2], v0[3]); w.z = cvt_pk_bf16(v1[0], v1[1]); w.w = cvt_pk_bf16(v1[2], v1[3]);
                        *(u32x4*)(rowp + bj * HALF) = w; } }
        }
    }
};
template <int ldc, bool BASE16, bool STATS> struct EpiResH16 {
    static constexpr bool PERM = true;
    const void* base; unsigned short* hb; float* ss;
    __device__ __forceinline__ void operator()(f32x4 (&acc)[2][2][4][2], const Unit& u, int wr, int wc, int fr, int fq) const {
        const int row0 = u.pm * BM + wr * 64 + fr, col0 = u.pn * BM + wc * 32 + 8 * fq;
#pragma unroll
        for (int ai = 0; ai < 2; ++ai) { f32x4 pre[4][2][2];
#pragma unroll
            for (int m = 0; m < 4; ++m)
#pragma unroll
                for (int bj = 0; bj < 2; ++bj) { const size_t off = (size_t)(row0 + ai * HALF + m * 16) * ldc + col0 + bj * HALF;
                    if (BASE16) pre[m][bj][0] = __builtin_bit_cast(f32x4, *(const u32x4*)((const unsigned short*)base + off));
                    else { pre[m][bj][0] = *(const f32x4*)((const float*)base + off); pre[m][bj][1] = *(const f32x4*)((const float*)base + off + 4); } }
            asm volatile("s_waitcnt vmcnt(0)" ::: "memory");
#pragma unroll
            for (int m = 0; m < 4; ++m) { const int row = row0 + ai * HALF + m * 16; const size_t off = (size_t)row * ldc + col0; float s = 0.f;
#pragma unroll
                for (int bj = 0; bj < 2; ++bj) { f32x4 b0, b1;
                    if (BASE16) { const u32x4 w = __builtin_bit_cast(u32x4, pre[m][bj][0]); b0 = (f32x4){h_lo(w.x), h_hi(w.x), h_lo(w.y), h_hi(w.y)}; b1 = (f32x4){h_lo(w.z), h_hi(w.z), h_lo(w.w), h_hi(w.w)}; }
                    else { b0 = pre[m][bj][0]; b1 = pre[m][bj][1]; }
                    const f32x4 v0 = b0 + acc[ai][bj][m][0], v1 = b1 + acc[ai][bj][m][1];
                    if (STATS) s += ((v0[0] * v0[0] + v0[1] * v0[1]) + (v0[2] * v0[2] + v0[3] * v0[3])) + ((v1[0] * v1[0] + v1[1] * v1[1]) + (v1[2] * v1[2] + v1[3] * v1[3]));
                    u32x4 w; w.x = pk2h(v0[0], v0[1]); w.y = pk2h(v0[2], v0[3]); w.z = pk2h(v1[0], v1[1]); w.w = pk2h(v1[2], v1[3]);
                    *(u32x4*)(hb + off + bj * HALF) = w; }
                if (STATS) { s += __shfl_xor(s, 16); s += __shfl_xor(s, 32); if (fq == 0) ss[(size_t)row * 16 + u.pn * 4 + wc] = s; } }
            asm volatile("" ::: "memory"); }
    }
};
template <int ldc, int ntok> struct EpiMoeDown {
    static constexpr bool PERM = false;
    float* out; const int* list; const float* glist; const PG8_LAS int* tab;
    __device__ __forceinline__ void operator()(const f32x4 (&acc)[2][2][4][2], const Unit& u, int wr, int wc, int fr, int fq) const {
        const int col0 = u.pn * BM + wc * 32 + 4 * fq, cnt = __builtin_amdgcn_readfirstlane(tab[16 + u.e]); const size_t lb = (size_t)u.e * ntok;
#pragma unroll
        for (int ai = 0; ai < 2; ++ai)
#pragma unroll
            for (int m = 0; m < 4; ++m) { const int lr = u.lrow0 + ai * HALF + wr * 64 + m * 16 + fr;
                if (lr < cnt) { const int tok = list[lb + lr]; const float g = glist[lb + lr]; const size_t off = (size_t)tok * ldc + col0;
#pragma unroll
                    for (int bj = 0; bj < 2; ++bj)
#pragma unroll
                        for (int n = 0; n < 2; ++n) { const f32x4 b = *(const f32x4*)(out + off + bj * HALF + n * 16); *(f32x4*)(out + off + bj * HALF + n * 16) = b + acc[ai][bj][m][n] * g; } }
                asm volatile("" ::: "memory"); }
    }
};

template <int K, class Epi, class Sched, bool ALIGN_EPI = false, bool SP2 = false, int DT = 0>
__device__ __forceinline__ void gemm_phase(PG8_LAS unsigned char* lds, const char* Abase, const Sched& S, Epi& E) {
    constexpr bool FP8 = (DT == 1);
    const int tid = threadIdx.x, wid = __builtin_amdgcn_readfirstlane(tid >> 6), lane = tid & 63, wr = wid >> 2, wc = wid & 3, fr = lane & 15, fq = lane >> 4;
    constexpr int nt = K / BK; static_assert(K % (2 * BK) == 0 && K >= 4 * BK, "K: a multiple of 128, at least 256");
    int RA[2]; unsigned cofA[2], voffB[2];
#pragma unroll
    for (int i = 0; i < 2; ++i) { int R, C; stage_rc(tid * 16 + i * 8192, R, C); const int Rb = Epi::PERM ? ((R & ~31) + perm32(R & 31)) : R;
        RA[i] = R; cofA[i] = (unsigned)C * 2u; voffB[i] = (unsigned)(Rb * K + C) * 2u; }
    const size_t kstep = (size_t)(BK * 2);
    const size_t hstep = (size_t)HALF * K * 2;
    const unsigned ldsw = (unsigned)wid * 1024u;
    const int aoff = lds_byte(wr * 64 + fr, fq * 8), boff = lds_byte(wc * 32 + fr, fq * 8);
#define PG8_SA(b, h) (((b) * 2 + (h)) * HTB)
#define PG8_SB(b, h) ((4 + (b) * 2 + (h)) * HTB)
#define PG8_STAGE(bufoff, gbase, voff) do { _Pragma("unroll") for (int _i = 0; _i < 2; ++_i) \
        __builtin_amdgcn_global_load_lds((const unsigned*)((const char*)(gbase) + (voff)[_i]), (PG8_LAS unsigned*)(lds + (bufoff) + ldsw + _i * 8192), 16, 0, 0); } while (0)
#define PG8_LD16(off) (*(const PG8_LAS i32x4*)(lds + (off)))
#define PG8_LDA(dst, b, h) do { _Pragma("unroll") for (int m = 0; m < 4; ++m) { const i32x4 lo_ = PG8_LD16(PG8_SA(b, h) + aoff + m * 2048), hi_ = PG8_LD16(PG8_SA(b, h) + aoff + m * 2048 + 1024); \
        if constexpr (FP8) dst##8[m] = __builtin_shufflevector(lo_, hi_, 0, 1, 2, 3, 4, 5, 6, 7); else { dst[m][0] = __builtin_bit_cast(bf16x8, lo_); dst[m][1] = __builtin_bit_cast(bf16x8, hi_); } } } while (0)
#define PG8_LDB(dst, b, h) do { _Pragma("unroll") for (int n = 0; n < 2; ++n) { const i32x4 lo_ = PG8_LD16(PG8_SB(b, h) + boff + n * 2048), hi_ = PG8_LD16(PG8_SB(b, h) + boff + n * 2048 + 1024); \
        if constexpr (FP8) dst##8[n] = __builtin_shufflevector(lo_, hi_, 0, 1, 2, 3, 4, 5, 6, 7); else { dst[n][0] = __builtin_bit_cast(bf16x8, lo_); dst[n][1] = __builtin_bit_cast(bf16x8, hi_); } } } while (0)
#define PG8_MMA(ai, bj, At, Bt) do { __builtin_amdgcn_s_setprio(1); _Pragma("unroll") for (int m = 0; m < 4; ++m) _Pragma("unroll") for (int n = 0; n < 2; ++n) { \
        if constexpr (FP8) asm volatile("v_mfma_f32_16x16x128_f8f6f4 %0, %1, %2, %0" : "+v"(acc[ai][bj][m][n]) : "v"(Bt##8[n]), "v"(At##8[m])); \
        else if constexpr (DT == 2) { _Pragma("unroll") for (int k = 0; k < 2; ++k) acc[ai][bj][m][n] = __builtin_amdgcn_mfma_f32_16x16x32_f16(__builtin_bit_cast(f16x8, Bt[n][k]), __builtin_bit_cast(f16x8, At[m][k]), acc[ai][bj][m][n], 0, 0, 0); } \
        else { _Pragma("unroll") for (int k = 0; k < 2; ++k) acc[ai][bj][m][n] = __builtin_amdgcn_mfma_f32_16x16x32_bf16(Bt[n][k], At[m][k], acc[ai][bj][m][n], 0, 0, 0); } } \
        __builtin_amdgcn_s_setprio(0); } while (0)
#define PG8_WAIT_V(n) asm volatile("s_waitcnt vmcnt(" #n ")" ::: "memory")
#define PG8_WAIT_L(n) asm volatile("s_waitcnt lgkmcnt(" #n ")" ::: "memory")
#define PG8_BAR __builtin_amdgcn_s_barrier()
#define PG8_SCHED __builtin_amdgcn_sched_barrier(0)
    Unit cur, nxt; int ui = 0;
    if (!S.next(0, cur)) return;
    f32x4 acc[2][2][4][2];
#pragma unroll
    for (int a = 0; a < 2; ++a)
#pragma unroll
        for (int b = 0; b < 2; ++b)
#pragma unroll
            for (int m = 0; m < 4; ++m)
#pragma unroll
                for (int n = 0; n < 2; ++n) acc[a][b][m][n] = (f32x4){0.f, 0.f, 0.f, 0.f};
    bf16x8 At[4][2], B0[2][2], B1[2][2]; i32x8 At8[4], B08[2], B18[2];
    unsigned c0[2], c1[2], n0[2], n1[2];
#pragma unroll
    for (int i = 0; i < 2; ++i) { c0[i] = S.a_off(cur, RA[i]) + cofA[i]; c1[i] = S.a_off(cur, HALF + RA[i]) + cofA[i]; }
    const char* cB = S.b_ptr(cur);
    S.a_ready(cur);
    if constexpr (SP2) {
        PG8_STAGE(PG8_SB(0, 0), cB, voffB); PG8_STAGE(PG8_SB(0, 1), cB + hstep, voffB); PG8_STAGE(PG8_SA(0, 0), Abase, c0); PG8_STAGE(PG8_SA(0, 1), Abase, c1);
        if (wr == 1) PG8_BAR;
        PG8_WAIT_V(2); PG8_BAR;
        PG8_STAGE(PG8_SB(1, 0), cB + kstep, voffB); PG8_STAGE(PG8_SA(1, 0), Abase + kstep, c0); PG8_STAGE(PG8_SB(1, 1), cB + hstep + kstep, voffB);
        PG8_WAIT_V(6); PG8_BAR;
    } else {
        PG8_STAGE(PG8_SB(0, 0), cB, voffB); PG8_STAGE(PG8_SA(0, 0), Abase, c0); PG8_STAGE(PG8_SB(0, 1), cB + hstep, voffB); PG8_STAGE(PG8_SA(0, 1), Abase, c1);
        if (wr == 1) PG8_BAR;
        PG8_WAIT_V(4); PG8_BAR;
        PG8_STAGE(PG8_SB(1, 0), cB + kstep, voffB); PG8_STAGE(PG8_SA(1, 0), Abase + kstep, c0); PG8_STAGE(PG8_SB(1, 1), cB + hstep + kstep, voffB);
        PG8_WAIT_V(6); PG8_BAR;
    }
    for (;;) {
        const bool has_next = S.next(ui + 1, nxt);
        const char* nB = cB;
#pragma unroll
        for (int i = 0; i < 2; ++i) { n0[i] = c0[i]; n1[i] = c1[i]; }
        if (has_next) { nB = S.b_ptr(nxt);
#pragma unroll
            for (int i = 0; i < 2; ++i) { n0[i] = S.a_off(nxt, RA[i]) + cofA[i]; n1[i] = S.a_off(nxt, HALF + RA[i]) + cofA[i]; } }
#pragma unroll 1
        for (int t = 0; t < nt; t += 2) {
            const bool last = (t == nt - 2);
            const char* a1 = Abase + (size_t)(t + 1) * kstep;
            const char* a2 = last ? Abase : Abase + (size_t)(t + 2) * kstep; const char* b2 = last ? nB : cB + (size_t)(t + 2) * kstep;
            const char* a3 = a2 + kstep; const char* b3 = b2 + kstep;
            unsigned x0[2], x1[2];
#pragma unroll
            for (int i = 0; i < 2; ++i) { x0[i] = last ? n0[i] : c0[i]; x1[i] = last ? n1[i] : c1[i]; }
            if (last && has_next) S.a_ready(nxt);
            if constexpr (SP2) {
            PG8_LDB(B0, 0, 0); PG8_LDB(B1, 0, 1); PG8_SCHED; PG8_LDA(At, 0, 0); PG8_STAGE(PG8_SA(1, 1), a1, c1);
            PG8_WAIT_V(8); PG8_WAIT_L(0); PG8_BAR; PG8_MMA(0, 0, At, B0); PG8_MMA(0, 1, At, B1); PG8_BAR; PG8_SCHED;
            PG8_LDA(At, 0, 1); PG8_STAGE(PG8_SB(0, 0), b2, voffB); PG8_STAGE(PG8_SB(0, 1), b2 + hstep, voffB); PG8_STAGE(PG8_SA(0, 0), a2, x0);
            PG8_WAIT_V(8); PG8_WAIT_L(0); PG8_BAR; PG8_MMA(1, 0, At, B0); PG8_MMA(1, 1, At, B1); PG8_BAR; PG8_SCHED;
            PG8_LDB(B0, 1, 0); PG8_LDB(B1, 1, 1); PG8_SCHED; PG8_LDA(At, 1, 0); PG8_STAGE(PG8_SA(0, 1), a2, x1);
            PG8_WAIT_V(8); PG8_WAIT_L(0); PG8_BAR; PG8_MMA(0, 0, At, B0); PG8_MMA(0, 1, At, B1); PG8_BAR; PG8_SCHED;
            PG8_LDA(At, 1, 1); PG8_STAGE(PG8_SB(1, 0), b3, voffB); PG8_STAGE(PG8_SB(1, 1), b3 + hstep, voffB); PG8_STAGE(PG8_SA(1, 0), a3, x0);
            PG8_WAIT_V(8); PG8_WAIT_L(0); PG8_BAR; PG8_MMA(1, 0, At, B0); PG8_MMA(1, 1, At, B1); PG8_BAR; PG8_SCHED;
            } else {
            PG8_LDB(B0, 0, 0); PG8_SCHED; PG8_LDA(At, 0, 0); PG8_STAGE(PG8_SA(1, 1), a1, c1);
            PG8_WAIT_L(8); PG8_BAR; PG8_WAIT_L(0); PG8_MMA(0, 0, At, B0); PG8_BAR; PG8_SCHED;
            PG8_LDB(B1, 0, 1); PG8_STAGE(PG8_SB(0, 0), b2, voffB);
            PG8_BAR; PG8_WAIT_L(0); PG8_MMA(0, 1, At, B1); PG8_BAR;
            PG8_LDA(At, 0, 1); PG8_STAGE(PG8_SA(0, 0), a2, x0);
            PG8_BAR; PG8_WAIT_L(0); PG8_MMA(1, 0, At, B0); PG8_BAR; PG8_SCHED;
            PG8_STAGE(PG8_SB(0, 1), b2 + hstep, voffB);
            PG8_WAIT_V(6); PG8_BAR; PG8_MMA(1, 1, At, B1); PG8_BAR;
            PG8_LDB(B0, 1, 0); PG8_SCHED; PG8_LDA(At, 1, 0); PG8_STAGE(PG8_SA(0, 1), a2, x1);
            PG8_WAIT_L(8); PG8_BAR; PG8_WAIT_L(0); PG8_MMA(0, 0, At, B0); PG8_BAR; PG8_SCHED;
            PG8_LDB(B1, 1, 1); PG8_STAGE(PG8_SB(1, 0), b3, voffB);
            PG8_BAR; PG8_WAIT_L(0); PG8_MMA(0, 1, At, B1); PG8_BAR;
            PG8_LDA(At, 1, 1); PG8_STAGE(PG8_SA(1, 0), a3, x0);
            PG8_BAR; PG8_WAIT_L(0); PG8_MMA(1, 0, At, B0); PG8_BAR; PG8_SCHED;
            PG8_STAGE(PG8_SB(1, 1), b3 + hstep, voffB);
            PG8_WAIT_V(6); PG8_BAR; PG8_MMA(1, 1, At, B1); PG8_BAR;
            }
        }
        if constexpr (ALIGN_EPI) { if (wr == 0) PG8_BAR; }
        if constexpr (FP8) asm volatile("s_nop 15\n\ts_nop 15" ::: "memory");
        E(acc, cur, wr, wc, fr, fq); S.done(cur);
        if (!has_next) break;
#pragma unroll
        for (int a = 0; a < 2; ++a)
#pragma unroll
            for (int b = 0; b < 2; ++b)
#pragma unroll
                for (int m = 0; m < 4; ++m)
#pragma unroll
                    for (int n = 0; n < 2; ++n) acc[a][b][m][n] = (f32x4){0.f, 0.f, 0.f, 0.f};
        cur = nxt; cB = nB; ++ui;
#pragma unroll
        for (int i = 0; i < 2; ++i) { c0[i] = n0[i]; c1[i] = n1[i]; }
        if constexpr (ALIGN_EPI) { if (wr == 1) PG8_BAR; }
    }
    PG8_WAIT_V(0);
    if constexpr (!ALIGN_EPI) { if (wr == 0) PG8_BAR; }
    PG8_BAR;
#undef PG8_SA
#undef PG8_SB
#undef PG8_STAGE
#undef PG8_LDA
#undef PG8_LDB
#undef PG8_MMA
#undef PG8_LD16
#undef PG8_WAIT_V
#undef PG8_WAIT_L
#undef PG8_BAR
#undef PG8_SCHED
}
}
#include <hip/hip_bf16.h>
#include <cmath>
namespace attn_body {
using bf16=__hip_bfloat16;
using bf16x8=__attribute__((ext_vector_type(8)))short;
using s16x4=__attribute__((ext_vector_type(4)))short;
using f32x16=__attribute__((ext_vector_type(16)))float;
using u32x4=__attribute__((ext_vector_type(4)))unsigned;
using f32x4_t=__attribute__((ext_vector_type(4)))float;
constexpr int BATCH=4,NHEAD=16,SEQ=8192,D=64,DM=NHEAD*D;
constexpr int NW=8,QBLK=32,QB=QBLK*NW,KVBLK=64,NQB=SEQ/QB;
constexpr int ATTN_PITCH=DM, ATTN_UNIT_ROWS=QB;
__device__ __forceinline__ int crow(int r,int hi){return (r&3)+8*(r>>2)+4*hi;}
#define SBAR() __builtin_amdgcn_sched_barrier(0)
__device__ __forceinline__ void cmask(f32x16&p0,f32x16&p1,int jb,int qrel,int hi){
  const float NEG=-INFINITY; int kb=64*jb+4*hi;
  #pragma unroll
  for(int r=0;r<16;++r){int kv=kb+(r&3)+8*(r>>2); if(kv>qrel)p0[r]=NEG; if(kv+32>qrel)p1[r]=NEG;}
}

constexpr int NSLOT=3, SLOTB=8192;
constexpr int LDS_K=0, LDS_V=NSLOT*SLOTB, LDS_WS=2*NSLOT*SLOTB, LDS_OST=LDS_WS+NW*64*4, LDS_CB=LDS_OST+NW*4096, LDS_Q=LDS_CB+SEQ*4, LDS_OK=LDS_Q+16, LDS_BYTES=LDS_OK+48;
constexpr float C2=0.125f*1.4426950408889634f;
__device__ __forceinline__ void glds16(const void*gsrc,unsigned lds_dst){unsigned keep;
  asm volatile("s_mov_b32 %0, m0\n\ts_mov_b32 m0, %2\n\ts_nop 0\n\tglobal_load_lds_dwordx4 %1, off\n\ts_mov_b32 m0, %0":"=&s"(keep):"v"(gsrc),"s"(lds_dst):"memory");}
__device__ __forceinline__ float max3f(float a,float b,float c){float r;asm("v_max3_f32 %0, %1, %2, %3":"=v"(r):"v"(a),"v"(b),"v"(c));return r;}
__device__ __forceinline__ float max2f(float a,float b){float r;asm("v_max_f32_e32 %0, %1, %2":"=v"(r):"v"(a),"v"(b));return r;}
__device__ __forceinline__ float fadd_s(float a,float b){float r;asm("v_add_f32_e32 %0, %1, %2":"=v"(r):"v"(a),"v"(b));return r;}
__device__ __forceinline__ float fsub_s(float a,float b){float r;asm("v_sub_f32_e32 %0, %1, %2":"=v"(r):"v"(a),"v"(b));return r;}
typedef float f32x2_t __attribute__((ext_vector_type(2))); typedef __bf16 bf16x2_t __attribute__((ext_vector_type(2)));
__device__ __forceinline__ unsigned cvtpk_s(float lo,float hi){f32x2_t v={lo,hi};bf16x2_t b=__builtin_convertvector(v,bf16x2_t);return __builtin_bit_cast(unsigned,b);}
#define WAIT_BAR(N) asm volatile("s_waitcnt vmcnt(" #N ") lgkmcnt(0)\n\ts_barrier":::"memory")

__device__ __forceinline__ void qkt(f32x16&p0,f32x16&p1,const char*Kslot,const bf16x8*qr,int r32,int hi){
  const char*kb=Kslot+hi*1024+r32*16;
  #pragma unroll
  for(int d0=0;d0<4;++d0){
    const bf16x8 b0=*reinterpret_cast<const bf16x8*>(kb+d0*2048);
    const bf16x8 b1=*reinterpret_cast<const bf16x8*>(kb+d0*2048+512);
    p0=__builtin_amdgcn_mfma_f32_32x32x16_bf16(b0,qr[d0],p0,0,0,0);p1=__builtin_amdgcn_mfma_f32_32x32x16_bf16(b1,qr[d0],p1,0,0,0);}
}
typedef __attribute__((address_space(3))) const char* lds_cptr;
typedef short v4i16_t __attribute__((ext_vector_type(4)));
__device__ __forceinline__ void kload8(bf16x8*kf,lds_cptr kp){
  kf[0]=*(const __attribute__((address_space(3))) bf16x8*)(kp);      kf[1]=*(const __attribute__((address_space(3))) bf16x8*)(kp+512);
  kf[2]=*(const __attribute__((address_space(3))) bf16x8*)(kp+2048); kf[3]=*(const __attribute__((address_space(3))) bf16x8*)(kp+2560);
  kf[4]=*(const __attribute__((address_space(3))) bf16x8*)(kp+4096); kf[5]=*(const __attribute__((address_space(3))) bf16x8*)(kp+4608);
  kf[6]=*(const __attribute__((address_space(3))) bf16x8*)(kp+6144); kf[7]=*(const __attribute__((address_space(3))) bf16x8*)(kp+6656);
}
__device__ __forceinline__ void kload2(bf16x8*kf,lds_cptr kp,int j){ kf[2*j]=*(const __attribute__((address_space(3))) bf16x8*)(kp+j*2048); kf[2*j+1]=*(const __attribute__((address_space(3))) bf16x8*)(kp+j*2048+512); }
__device__ __forceinline__ s16x4 vtr(lds_cptr p){ return __builtin_bit_cast(s16x4,__builtin_amdgcn_ds_read_tr16_b64_v4i16((__attribute__((address_space(3))) v4i16_t*)p)); }
__device__ __forceinline__ float rowmax(const f32x16&p0,const f32x16&p1){
  float a=max3f(p0[0],p0[1],p1[0]),b=max3f(p0[2],p0[3],p1[1]);a=max3f(a,p1[2],p1[3]);
  #pragma unroll
  for(int r=4;r<16;r+=4){a=max3f(a,p0[r],p0[r+1]);b=max3f(b,p0[r+2],p0[r+3]);a=max3f(a,p1[r],p1[r+1]);b=max3f(b,p1[r+2],p1[r+3]);}
  const float m=max2f(a,b);
  auto rr=__builtin_amdgcn_permlane32_swap(__float_as_uint(m),__float_as_uint(m),false,false);
  return max2f(__uint_as_float(rr[0]),__uint_as_float(rr[1]));
}
__device__ __forceinline__ void pv(f32x16*o,int vb,bf16x8 pa0,bf16x8 pa1,bf16x8 pa2,bf16x8 pa3){
  #pragma unroll
  for(int d0=0;d0<2;++d0){s16x4 lo[4],hi[4];
    #pragma unroll
    for(int ks=0;ks<4;++ks){
      asm volatile("ds_read_b64_tr_b16 %0,%1 offset:%c2":"=&v"(lo[ks]):"v"(vb),"i"(d0*4096+ks*1024):"memory");
      asm volatile("ds_read_b64_tr_b16 %0,%1 offset:%c2":"=&v"(hi[ks]):"v"(vb),"i"(d0*4096+ks*1024+512):"memory");}
    asm volatile("s_waitcnt lgkmcnt(0)":::"memory");SBAR();
    #define PK(k) (bf16x8){lo[k][0],lo[k][1],lo[k][2],lo[k][3],hi[k][0],hi[k][1],hi[k][2],hi[k][3]}
    o[d0]=__builtin_amdgcn_mfma_f32_32x32x16_bf16(pa0,PK(0),o[d0],0,0,0);
    o[d0]=__builtin_amdgcn_mfma_f32_32x32x16_bf16(pa1,PK(1),o[d0],0,0,0);
    o[d0]=__builtin_amdgcn_mfma_f32_32x32x16_bf16(pa2,PK(2),o[d0],0,0,0);
    o[d0]=__builtin_amdgcn_mfma_f32_32x32x16_bf16(pa3,PK(3),o[d0],0,0,0);
    #undef PK
  }
}

#ifndef ATTN_STORE16
#define ATTN_STORE16(p,v) (*(u32x4*)(p)=(v))
#endif
constexpr float SKIP_TH=200.f, SKIP_MARGIN=42.f, SKIP_G=10.f, SKIP_LMIN=0.0009765625f  ;
template<int THRL> __device__ __forceinline__ bool attn_unit(int b,int h,int qb,int t0s,const bf16*Q,const bf16*__restrict__ K,const bf16*__restrict__ V,bf16*O,const float*Cb,char*shm){
  const int tid=threadIdx.x,lane=tid&63,r32=lane&31,hi=lane>>5; const int wid=__builtin_amdgcn_readfirstlane(tid>>6);
  const long rowbase=(long)b*SEQ; const int q0=qb*QB;
  const bf16*Qw=Q+(rowbase+q0+wid*QBLK)*DM+h*D;
  const bf16*Kh=K+(rowbase+(long)t0s*KVBLK)*DM+h*D,*Vh=V+(rowbase+(long)t0s*KVBLK)*DM+h*D;
  const unsigned lds0=(unsigned)(uintptr_t)shm;
  float*wsf=(float*)(shm+LDS_WS)+wid*64;
  const bf16*ksrc=Kh+(long)lane*DM+wid*8;
  const bf16*vsrc=Vh+(long)(16*(wid&3)+(lane>>2))*DM+(wid>>2)*32+(lane&3)*8;
  const unsigned kdst=lds0+LDS_K+wid*1024, vdst=lds0+LDS_V+wid*1024;
  #define DMA_K(t,slot) glds16(ksrc+(long)(t)*KVBLK*DM,(unsigned)__builtin_amdgcn_readfirstlane(kdst+(slot)))
  #define DMA_V(t,slot) glds16(vsrc+(long)(t)*KVBLK*DM,(unsigned)__builtin_amdgcn_readfirstlane(vdst+(slot)))
  const int vb0=(int)(lds0+LDS_V)+((lane>>4)&1)*32+(lane&3)*8+(4*hi+((lane&15)>>2))*64;
  const char*Kbase=shm+LDS_K; bf16x8 kf[8];
  const lds_cptr shm3=(lds_cptr)shm; const lds_cptr kp0=shm3+LDS_K+hi*1024+r32*16; const lds_cptr vp0=shm3+LDS_V+((lane>>4)&1)*32+(lane&3)*8+(4*hi+((lane&15)>>2))*64;
  const int NT=(q0+QB)/KVBLK-t0s;
  typedef __attribute__((address_space(3))) f32x4_t* lds_f4ptr; typedef __attribute__((address_space(3))) const f32x4_t* lds_cf4ptr;
  { const f32x4_t*cg=(const f32x4_t*)(Cb+(size_t)(b*NHEAD+h)*SEQ); const int n4=(q0+QB)/4, i_=t0s*16+tid; lds_f4ptr cl=(lds_f4ptr)((lds_cptr)shm+LDS_CB);
    f32x4_t t0_=f32x4_t{},t1_=f32x4_t{},t2_=f32x4_t{},t3_=f32x4_t{};
    if(i_<n4)t0_=cg[i_]; if(i_+512<n4)t1_=cg[i_+512]; if(i_+1024<n4)t2_=cg[i_+1024]; if(i_+1536<n4)t3_=cg[i_+1536];
    if(i_<n4)cl[i_]=t0_; if(i_+512<n4)cl[i_+512]=t1_; if(i_+1024<n4)cl[i_+1024]=t2_; if(i_+1536<n4)cl[i_+1536]=t3_; }
  const lds_cf4ptr cbp=(lds_cf4ptr)((lds_cptr)shm+LDS_CB)+hi+16*t0s;
  #define CI4(PX,t_,g_,o_,nm_) do{ const f32x4_t z_=cbp[16*(t_)+(o_)+2*(g_)]; PX[4*(g_)]=(nm_)-z_.x; PX[4*(g_)+1]=(nm_)-z_.y; PX[4*(g_)+2]=(nm_)-z_.z; PX[4*(g_)+3]=(nm_)-z_.w; }while(0)
  #define CI16(PX,t_,o_,nm_) do{ CI4(PX,t_,0,o_,nm_); CI4(PX,t_,1,o_,nm_); CI4(PX,t_,2,o_,nm_); CI4(PX,t_,3,o_,nm_); }while(0)
  DMA_K(0,0);DMA_V(0,0);DMA_K(1,SLOTB);
  bf16x8 qr[4];
  #pragma unroll
  for(int d0=0;d0<4;++d0)qr[d0]=*reinterpret_cast<const bf16x8*>(&Qw[(long)r32*DM+d0*16+hi*8]);
  float mhat=0.f,l_reg=0.f;f32x16 o[2];o[0]=f32x16{};o[1]=f32x16{};
  const int qrel=wid*QBLK+r32;
  #define CMASK(P0,P1,t) do{int jb_=(t)-(NT-4); if(jb_>=0)cmask(P0,P1,jb_,qrel,hi);}while(0)
  bool resc=false;
  #define START(P0,P1) do{ const float rm=rowmax(P0,P1); resc=false; \
    if(__builtin_expect(__any(rm>(float)THRL),0)){ const float dl=__builtin_fmaxf(rm,0.f); mhat=fadd_s(mhat,dl); \
      _Pragma("unroll") for(int r=0;r<16;++r){P0[r]=fsub_s(P0[r],dl);P1[r]=fsub_s(P1[r],dl);} } \
    _Pragma("unroll") for(int r=0;r<16;++r)P0[r]=__builtin_amdgcn_exp2f(P0[r]); }while(0)
  #define RESC() do{ if(resc){ asm volatile("s_waitcnt lgkmcnt(0)":::"memory"); \
      _Pragma("unroll") for(int d_=0;d_<2;++d_) _Pragma("unroll") for(int r=0;r<16;++r)o[d_][r]*=wsf[crow(r,hi)]; } }while(0)
  f32x16 pA0,pA1,pB0,pB1;
  int sl_prev=0,sl_cur=0,sl_next=SLOTB;
  #define ROT() do{sl_prev=sl_cur;sl_cur=sl_next;sl_next=(sl_next==(NSLOT-1)*SLOTB)?0:sl_next+SLOTB;}while(0)
  DMA_K(2,2*SLOTB);
  WAIT_BAR(3);
  const float qb2=*((const __attribute__((address_space(3))) float*)((lds_cptr)shm+LDS_CB)+q0+qrel);
  CI16(pA0,0,0,qb2); CI16(pA1,0,8,qb2);
  qkt(pA0,pA1,Kbase,qr,r32,hi);asm volatile("s_nop 15\n\ts_nop 7":"+v"(pA0),"+v"(pA1));CMASK(pA0,pA1,0);
  START(pA0,pA1);
  _Pragma("unroll") for(int r=0;r<16;++r)pA1[r]=__builtin_amdgcn_exp2f(pA1[r]);
  WAIT_BAR(0);
  DMA_K(3,0);DMA_V(1,SLOTB);
  ROT();
  kload8(kf,kp0+sl_cur);
  WAIT_BAR(2);
  s16x4 vlo[8],vhi[8]; u32x4 pw0,pw1,pw2,pw3;
  #define PKW(P,B) cvtpk_s(P[B],P[B+1])
  #define PAF(k) __builtin_bit_cast(bf16x8,pw##k)
  #define VFR(i) (bf16x8){vlo[i][0],vlo[i][1],vlo[i][2],vlo[i][3],vhi[i][0],vhi[i][1],vhi[i][2],vhi[i][3]}
  #define PIN(x) asm volatile("":"+v"(x))
  #define MX3(a,b,c) __builtin_fmaxf(__builtin_fmaxf((a),(b)),(c))
  #define GAPA(MF,A0,A1,A2,A3,W0,W1,PW) do{ MF; sacc+=A0; sacc+=A1; sacc+=A2; sacc+=A3; PIN(sacc); W0; W1; PIN(PW); SBAR(); }while(0)
  #define EX(v) __builtin_amdgcn_exp2f(v)
  #define GAPB(MF,X,B,GI,PX,tn_,g_,o_) do{ MF; X[B]=EX(X[B]); X[B+1]=EX(X[B+1]); X[B+2]=EX(X[B+2]); X[B+3]=EX(X[B+3]); PIN(X); SBAR(); }while(0)
  #define VRD(i) do{ vlo[i]=vtr(vp_+(((i)>>2)*4096+((i)&3)*1024)); vhi[i]=vtr(vp_+(((i)>>2)*4096+((i)&3)*1024+512)); }while(0)
  #define KRD(G,j) do{ if(G){ kload2(kf,kp0+sl_next,j); SBAR(); } }while(0)
  #define STEP(C0,C1,P0,P1,t,GK,GV,GL,GI) do{ SBAR(); const float nm1_=qb2-mhat; CI16(C0,t,0,nm1_); SBAR(); \
    const lds_cptr vp_=vp0+sl_prev; \
    VRD(0); SBAR(); float sacc=(P0[0]+P0[1]); \
    GAPA(C0=__builtin_amdgcn_mfma_f32_32x32x16_bf16(kf[0],qr[0],C0,0,0,0), P0[2],P0[3],P0[4],P0[5],     pw0[0]=PKW(P0,0), pw0[1]=PKW(P0,2), pw0); \
    CI16(C1,t,8,nm1_); PIN(C1); SBAR(); \
    VRD(4); SBAR(); GAPA(C1=__builtin_amdgcn_mfma_f32_32x32x16_bf16(kf[1],qr[0],C1,0,0,0), P0[6],P0[7],P0[8],P0[9],     pw0[2]=PKW(P0,4), pw0[3]=PKW(P0,6), pw0); \
    VRD(1); SBAR(); GAPA(C0=__builtin_amdgcn_mfma_f32_32x32x16_bf16(kf[2],qr[1],C0,0,0,0),   P0[10],P0[11],P0[12],P0[13], pw1[0]=PKW(P0,8), pw1[1]=PKW(P0,10), pw1); \
    VRD(5); SBAR(); GAPA(C1=__builtin_amdgcn_mfma_f32_32x32x16_bf16(kf[3],qr[1],C1,0,0,0),   P0[14],P0[15],P1[0],P1[1],   pw1[2]=PKW(P0,12),pw1[3]=PKW(P0,14), pw1); \
    VRD(2); SBAR(); GAPA(C0=__builtin_amdgcn_mfma_f32_32x32x16_bf16(kf[4],qr[2],C0,0,0,0),   P1[2],P1[3],P1[4],P1[5],     pw2[0]=PKW(P1,0), pw2[1]=PKW(P1,2), pw2); \
    VRD(6); SBAR(); GAPA(C1=__builtin_amdgcn_mfma_f32_32x32x16_bf16(kf[5],qr[2],C1,0,0,0),   P1[6],P1[7],P1[8],P1[9],     pw2[2]=PKW(P1,4), pw2[3]=PKW(P1,6), pw2); \
    VRD(3); SBAR(); GAPA(C0=__builtin_amdgcn_mfma_f32_32x32x16_bf16(kf[6],qr[3],C0,0,0,0),   P1[10],P1[11],P1[12],P1[13], pw3[0]=PKW(P1,8), pw3[1]=PKW(P1,10), pw3); \
    VRD(7); SBAR(); GAPA(C1=__builtin_amdgcn_mfma_f32_32x32x16_bf16(kf[7],qr[3],C1,0,0,0),   P1[14],P1[15],0.f,0.f,       pw3[2]=PKW(P1,12),pw3[3]=PKW(P1,14), pw3); \
    l_reg+=sacc; \
    if(GK){DMA_K((t)+3,sl_cur);} if(GV){DMA_V((t)+1,sl_next);} \
    CMASK(C0,C1,t); \
    { float a=MX3(C0[0],C0[1],C1[0]),b=MX3(C0[2],C0[3],C1[1]); a=MX3(a,C1[2],C1[3]); \
      _Pragma("unroll") for(int r=4;r<16;r+=4){a=MX3(a,C0[r],C0[r+1]);b=MX3(b,C0[r+2],C0[r+3]);a=MX3(a,C1[r],C1[r+1]);b=MX3(b,C1[r+2],C1[r+3]);} \
      float rm=__builtin_fmaxf(a,b); { auto rr=__builtin_amdgcn_permlane32_swap(__float_as_uint(rm),__float_as_uint(rm),false,false); rm=__builtin_fmaxf(__uint_as_float(rr[0]),__uint_as_float(rr[1])); } \
      resc=false; \
      if(__builtin_expect(__any(rm>(float)THRL),0)){ const float dl=__builtin_fmaxf(rm,0.f); mhat+=dl; \
        _Pragma("unroll") for(int r=0;r<16;++r){C0[r]-=dl;C1[r]-=dl;} \
        const float f=__builtin_amdgcn_exp2f(-dl); l_reg*=f; if(hi==0)wsf[r32]=f; resc=true; } } \
    SBAR(); \
    GAPB(o[0]=__builtin_amdgcn_mfma_f32_32x32x16_bf16(PAF(0),VFR(0),o[0],0,0,0), C0,0,  GI,P0,(t)+1,0,0); \
    GAPB(o[1]=__builtin_amdgcn_mfma_f32_32x32x16_bf16(PAF(0),VFR(4),o[1],0,0,0), C0,4,  GI,P0,(t)+1,1,0); \
    KRD(GL,0); GAPB(o[0]=__builtin_amdgcn_mfma_f32_32x32x16_bf16(PAF(1),VFR(1),o[0],0,0,0), C0,8,  GI,P0,(t)+1,2,0); \
    KRD(GL,1); GAPB(o[1]=__builtin_amdgcn_mfma_f32_32x32x16_bf16(PAF(1),VFR(5),o[1],0,0,0), C0,12, GI,P0,(t)+1,3,0); \
    KRD(GL,2); GAPB(o[0]=__builtin_amdgcn_mfma_f32_32x32x16_bf16(PAF(2),VFR(2),o[0],0,0,0), C1,0,  GI,P1,(t)+1,0,8); \
    KRD(GL,3); GAPB(o[1]=__builtin_amdgcn_mfma_f32_32x32x16_bf16(PAF(2),VFR(6),o[1],0,0,0), C1,4,  GI,P1,(t)+1,1,8); \
    GAPB(o[0]=__builtin_amdgcn_mfma_f32_32x32x16_bf16(PAF(3),VFR(3),o[0],0,0,0), C1,8,  GI,P1,(t)+1,2,8); \
    GAPB(o[1]=__builtin_amdgcn_mfma_f32_32x32x16_bf16(PAF(3),VFR(7),o[1],0,0,0), C1,12, GI,P1,(t)+1,3,8); \
    }while(0)
  int t=1;
  #undef CMASK
  #define CMASK(P0,P1,t) do{}while(0)
  for(;t+5<NT;t+=2){
    STEP(pB0,pB1,pA0,pA1,t,true,true,true,true);     WAIT_BAR(2); RESC(); ROT();
    STEP(pA0,pA1,pB0,pB1,t+1,true,true,true,true);   WAIT_BAR(2); RESC(); ROT();
  }
  #undef CMASK
  #define CMASK(P0,P1,t) do{int jb_=(t)-(NT-4); if(jb_>=0)cmask(P0,P1,jb_,qrel,hi);}while(0)
  #define ENDW(tt) do{ if((tt)+3<NT){WAIT_BAR(2);} else if((tt)+2<NT){WAIT_BAR(1);} else {WAIT_BAR(0);} }while(0)
  for(;t+1<NT;t+=2){
    STEP(pB0,pB1,pA0,pA1,t,(t+3<NT),(t+1<NT),(t+1<NT),true);       ENDW(t);   RESC(); ROT();
    STEP(pA0,pA1,pB0,pB1,t+1,(t+4<NT),(t+2<NT),(t+2<NT),true);     ENDW(t+1); RESC(); ROT();
  }
  STEP(pB0,pB1,pA0,pA1,NT-1,false,false,false,false); RESC();
  { float sacc=pB0[0]+pB0[1]; _Pragma("unroll") for(int r=2;r<16;++r)sacc+=pB0[r]; _Pragma("unroll") for(int r=0;r<16;++r)sacc+=pB1[r]; l_reg+=sacc;
    pw0=(u32x4){PKW(pB0,0),PKW(pB0,2),PKW(pB0,4),PKW(pB0,6)};pw1=(u32x4){PKW(pB0,8),PKW(pB0,10),PKW(pB0,12),PKW(pB0,14)};pw2=(u32x4){PKW(pB1,0),PKW(pB1,2),PKW(pB1,4),PKW(pB1,6)};pw3=(u32x4){PKW(pB1,8),PKW(pB1,10),PKW(pB1,12),PKW(pB1,14)};
    SBAR(); pv(o,vb0+sl_cur,PAF(0),PAF(1),PAF(2),PAF(3)); }
  #undef PKW
  #undef PAF
  #undef VFR
  #undef PIN
  #undef MX3
  #undef GAPA
  #undef GAPB
  #undef EX
  #undef VRD
  #undef KRD
  #undef STEP
  #undef ENDW
  {auto rr=__builtin_amdgcn_permlane32_swap(__float_as_uint(l_reg),__float_as_uint(l_reg),false,false);l_reg=__uint_as_float(rr[0])+__uint_as_float(rr[1]);}
  { const bool okw_=__all(l_reg>=SKIP_LMIN); if(lane==0)*((volatile __attribute__((address_space(3))) unsigned*)((lds_cptr)shm+LDS_OK)+wid)=okw_?1u:0u; }
  if(hi==0)wsf[32+r32]=l_reg;asm volatile("s_waitcnt lgkmcnt(0)":::"memory");
  float rli[16];
  #pragma unroll
  for(int r=0;r<16;++r)rli[r]=__builtin_amdgcn_rcpf(wsf[32+crow(r,hi)]);
  bf16*Ow=O+(rowbase+q0+wid*QBLK)*DM+h*D;
  { bf16*stg=(bf16*)(shm+LDS_OST)+wid*2048;
    #pragma unroll
    for(int r=0;r<16;++r){const int orow=crow(r,hi);
      #pragma unroll
      for(int d0=0;d0<2;++d0)stg[orow*64+d0*32+r32]=__float2bfloat16(o[d0][r]*rli[r]);}
    asm volatile("s_waitcnt lgkmcnt(0)":::"memory");
    #pragma unroll
    for(int i=0;i<4;++i){const int row=i*8+(lane>>3),ch=lane&7; const u32x4 v=*(const u32x4*)(stg+row*64+ch*8); ATTN_STORE16(Ow+(long)row*DM+ch*8,v);} }
  asm volatile("s_waitcnt lgkmcnt(0)\n\ts_barrier":::"memory");
  { const volatile __attribute__((address_space(3))) unsigned*okp_=(const volatile __attribute__((address_space(3))) unsigned*)((lds_cptr)shm+LDS_OK);
    return (okp_[0]&okp_[1]&okp_[2]&okp_[3]&okp_[4]&okp_[5]&okp_[6]&okp_[7])!=0u; }
  #undef CI4
  #undef CI16
  #undef DMA_K
  #undef DMA_V
  #undef CMASK
  #undef START
  #undef RESC
  #undef ROT
}
constexpr int ATTN_LDS_BYTES=LDS_BYTES;
struct AttnTensors { const bf16* Q; const bf16* K; const bf16* V; bf16* O; const float* Cb; };
__device__ __forceinline__ unsigned aq_grab_from(unsigned*ctr,unsigned q0_){
  for(unsigned qq=0;qq<8;++qq){ const unsigned q=(q0_+qq)&7u; const unsigned r=__hip_atomic_fetch_add(ctr+64*q,1u,__ATOMIC_RELAXED,__HIP_MEMORY_SCOPE_AGENT); if(r<256u)return (q<<16)|r; }
  return 0xffffffffu; }
template<int THRL=8> __device__ __forceinline__ void attn_phase(char*lds,const AttnTensors&T,unsigned*ctr,unsigned xcc,const unsigned*nrm){
  const int tid=threadIdx.x,lane=tid&63;
  volatile __attribute__((address_space(3))) unsigned*qw=(volatile __attribute__((address_space(3))) unsigned*)((lds_cptr)lds+LDS_Q);
  if(tid==0)qw[0]=aq_grab_from(ctr,xcc&7u);
  asm volatile("s_waitcnt lgkmcnt(0)\n\ts_barrier":::"memory");
  bool redo=false; unsigned nraw=0u;
  for(;;){
    const unsigned pk=qw[0]; if(pk==0xffffffffu)break;
    const unsigned q=pk>>16,idx=pk&0xffffu; const int bh=(int)(q+8u*(idx&7u)),qb=31-(int)(idx>>3);
    if(!redo&&tid==0)nraw=__hip_atomic_fetch_add(ctr+64*q,1u,__ATOMIC_RELAXED,__HIP_MEMORY_SCOPE_AGENT);
    int t0s=0,t0a=0;
    if(qb>0){ const float*cg=T.Cb+(size_t)bh*SEQ; const int ntabs=4*qb+4;
      const unsigned nw=__hip_atomic_load(nrm+(((lane>>1)&1)*64+bh)*2+(lane&1),__ATOMIC_RELAXED,__HIP_MEMORY_SCOPE_AGENT);
      const float nv=__uint_as_float(nw); const float q2=__shfl(nv,0)+__shfl(nv,1), k2=__shfl(nv,2)+__shfl(nv,3);
      const float bnd=1.02f*sqrtf(q2*k2), th=fminf(SKIP_TH,SKIP_MARGIN+2.f*bnd), tha=fminf(th,SKIP_MARGIN+bnd+SKIP_G);
      const float e0=cg[64*lane+63], e1=(lane+64<ntabs)?cg[64*(lane+64)+63]:0.f;
      const int tq=4*qb-1; const float ref=__shfl((tq<64)?e0:e1,tq&63);
      const unsigned long long m0=__ballot((lane<ntabs)&&((e0-ref)>th)), m1=__ballot((lane+64<ntabs)&&((e1-ref)>th));
      const int nskip=__popcll(m0)+__popcll(m1); t0s=nskip&~1; if(t0s>ntabs-4)t0s=ntabs-4; t0s=__builtin_amdgcn_readfirstlane(t0s);
      const unsigned long long a0=__ballot((lane<ntabs)&&((e0-ref)>tha)), a1=__ballot((lane+64<ntabs)&&((e1-ref)>tha));
      const int nska=__popcll(a0)+__popcll(a1); t0a=nska&~1; if(t0a>ntabs-4)t0a=ntabs-4; t0a=__builtin_amdgcn_readfirstlane(t0a); }
    const int t0u=redo?t0s:t0a;
    const bool ok=attn_unit<THRL>(bh/NHEAD,bh%NHEAD,qb,t0u,T.Q,T.K,T.V,T.O,T.Cb,lds);
    if(!ok&&t0u!=t0s){ redo=true; continue; }
    redo=false;
    if(tid==0)qw[0]=(nraw<256u)?((q<<16)|nraw):aq_grab_from(ctr,(q+1u)&7u);
    asm volatile("s_waitcnt lgkmcnt(0)\n\ts_barrier":::"memory");
  }
}
#undef SBAR
#undef WAIT_BAR
}
#define ATTN_PHASE_BODY { static_assert(attn_body::ATTN_LDS_BYTES <= RING_BYTES && attn_body::ATTN_PITCH == D, "attention body geometry vs frame"); \
    const attn_body::AttnTensors AT{(const attn_body::bf16*)QO, (const attn_body::bf16*)KB, (const attn_body::bf16*)VB, (attn_body::bf16*)OB, (const float*)(F.ws + WS_C2)}; \
    attn_body::attn_phase<8>((char*)lds + RING_OFF, AT, (unsigned*)(F.ctl + CW_AQ), xb_xcc_id(), (const unsigned*)(F.ctl + CW_NRM)); }
constexpr int NWAVES = 8;
#ifndef MK_PER_PHASE
#define MK_PER_PHASE 0
#endif
constexpr int N_PHASES = 15;

constexpr int BATCH = 4, SEQ = 8192, D = 1024, H = 16, HD = 64, FF = 2816, NE = 8;
constexpr int M = BATCH * SEQ;
constexpr int NQKV = 3 * D, NIN = 3 * D + H;
constexpr int NCH = M / 128;
constexpr int TMAX = 2 * M / 256 + NE;
constexpr int HROWS = TMAX * 256;
constexpr float RMS_EPS = 1e-6f;
constexpr float QSCALE = 0.125f * 1.4426950408889634f;
constexpr float LOG2E = 1.4426950408889634f;

constexpr size_t MiB = 1u << 20;
constexpr size_t WS_CTL = 0, CTL_ZERO_BYTES = 1 * MiB;
constexpr size_t WS_CTOT = 1 * MiB;
constexpr size_t WS_WQKV = 2 * MiB, WS_WO = 8 * MiB, WS_WGU = 10 * MiB, WS_WD = 21 * MiB, WS_WCIN = 27 * MiB, WS_WCO = 33 * MiB;
constexpr size_t WS_MGU8 = 35 * MiB, WS_MD8 = 79 * MiB;
constexpr size_t WS_XN8 = 2 * MiB;
constexpr size_t WS_HB = 101 * MiB;
constexpr size_t WS_ZP = 165 * MiB, WS_BGB = 166 * MiB;
constexpr size_t WS_C2 = 167 * MiB;
constexpr size_t WS_LIST = 169 * MiB;
constexpr size_t WS_INV = 170 * MiB, WS_GATE = 170 * MiB + 512 * 1024;
constexpr size_t WS_SS = 173 * MiB;
constexpr size_t WS_XN = 176 * MiB;
constexpr size_t WS_QO = 240 * MiB, WS_K = 304 * MiB, WS_V = 368 * MiB;
constexpr size_t WS_HID = 240 * MiB;
constexpr size_t WS_HID8 = 176 * MiB, WS_Y = 358 * MiB;
constexpr size_t WS_O = 432 * MiB;
constexpr size_t WS_END = 496 * MiB;
static_assert(WS_WD + (size_t)D * FF * 2 <= WS_WCIN && WS_MGU8 + (size_t)NE * 2 * FF * D <= WS_MD8 && WS_MD8 + (size_t)NE * D * FF <= WS_HB && WS_HB + (size_t)M * D * 2 <= WS_ZP && WS_ZP + (size_t)(M / 256) * 2 * D * 4 <= WS_BGB && WS_BGB + (size_t)(M / 256) * 2 * D * 4 <= WS_C2 && WS_XN8 + (size_t)M * D <= WS_MGU8 && WS_LIST + (size_t)NE * M * 4 <= WS_INV && WS_GATE + (size_t)M * 8 <= WS_SS && WS_SS + (size_t)M * 16 * 4 <= WS_XN, "d_ws map (weights)");
static_assert(WS_HID + (size_t)M * FF * 2 <= WS_O && WS_HID8 + (size_t)HROWS * FF <= WS_Y && WS_Y + (size_t)HROWS * D * 2 <= WS_END && WS_V + (size_t)M * D * 2 <= WS_O && WS_O + (size_t)M * D * 2 <= WS_END && WS_V - WS_K == WS_K - WS_QO, "d_ws map (activations)");
constexpr int CW_TMO = 0, CW_CODE = 1;
constexpr int CW_BAR = 4096;
constexpr int CW_AQ = 12288;
constexpr int CW_NRM = 2048;
constexpr int CW_MOE = 8192;
constexpr int RING_OFF = 0, RING_BYTES = 131072;
constexpr int RSTAB_OFF = RING_BYTES + 1024;
constexpr int GTOK_OFF = RING_BYTES + 2048, GTOK_UNITS = 24;
constexpr int LDSCTL_OFF = RING_BYTES, MISC_OFF = LDSCTL_OFF + 320;
constexpr int LDS_BYTES = 147456;
static_assert(MISC_OFF + 128 <= RSTAB_OFF && GTOK_OFF + GTOK_UNITS * 512 <= LDS_BYTES && M <= 65536, "LDS map");

#define GAS __attribute__((address_space(1)))
#define LAS __attribute__((address_space(3)))
typedef unsigned short bf16;
typedef unsigned v4u __attribute__((ext_vector_type(4)));
typedef float f32x4 __attribute__((ext_vector_type(4)));
typedef short bf16x8 __attribute__((ext_vector_type(8)));
typedef GAS unsigned gu32;
typedef GAS unsigned long long gu64;
#define RLX_AGENT __ATOMIC_RELAXED, __HIP_MEMORY_SCOPE_AGENT
#define LDS_WAIT() asm volatile("s_waitcnt lgkmcnt(0)" ::: "memory")
#define VM_WAIT() asm volatile("s_waitcnt vmcnt(0)" ::: "memory")
__device__ __forceinline__ unsigned f2bf(float f) { unsigned u = __builtin_bit_cast(unsigned, f); return (u + 0x7fffu + ((u >> 16) & 1u)) >> 16; }
__device__ __forceinline__ unsigned pk2(float lo, float hi) { return f2bf(lo) | (f2bf(hi) << 16); }
__device__ __forceinline__ float bf_lo(unsigned w) { return __uint_as_float(w << 16); }
__device__ __forceinline__ float bf_hi(unsigned w) { return __uint_as_float(w & 0xffff0000u); }

#define XB_TMO      128
#define XB_XCNT(j)  (256  + 64 * (j))
#define XB_XSUB(j)  (1280 + 64 * (j))
#define XB_XGEN(j)  (2304 + 64 * (j))
#define XB_TOP      3328
#define XB_TOPGEN   3392
#define XCD_BAR_WORDS 3456
#define XB_SPIN_CAP (1u << 18)

__device__ __forceinline__ unsigned xb_ld(unsigned* p)              { return __hip_atomic_load(p, __ATOMIC_RELAXED, __HIP_MEMORY_SCOPE_AGENT); }
__device__ __forceinline__ unsigned xb_add(unsigned* p, unsigned v) { return __hip_atomic_fetch_add(p, v, __ATOMIC_RELAXED, __HIP_MEMORY_SCOPE_AGENT); }
__device__ __forceinline__ unsigned xb_xcc_id() { return (unsigned)__builtin_amdgcn_s_getreg((3 << 11) | 20) & 0xFu; }
#define XB_SPIN(cond, bar) do { unsigned _sp = 0; while (cond) { __builtin_amdgcn_s_sleep(1); \
    if ((++_sp & 255u) == 0u) { if (xb_ld(&(bar)[XB_TMO])) break; if (_sp > XB_SPIN_CAP) { atomicAdd(&(bar)[XB_TMO], 1u); break; } } } } while (0)

struct XcdBarrier {
    unsigned* bar; unsigned x;
    volatile LAS unsigned* st;
};

__device__ __forceinline__ XcdBarrier xcd_barrier_post(unsigned* bar, volatile LAS unsigned* st) {
    XcdBarrier b; b.bar = bar; b.x = xb_xcc_id(); b.st = st;
    if (threadIdx.x == 0) (void)xb_add(&bar[XB_XCNT(b.x)], 1u);
    return b;
}
__device__ __forceinline__ void xcd_barrier_complete(unsigned* bar, unsigned x, unsigned& nloc, unsigned& nx) {
    const unsigned G = gridDim.x * gridDim.y * gridDim.z;
    unsigned sum, cnt, mine, sp = 0u;
    for (;;) {
        sum = 0u; cnt = 0u; mine = 0u;
#pragma unroll
        for (unsigned j = 0; j < 16; ++j) { const unsigned c = xb_ld(&bar[XB_XCNT(j)]); sum += c; cnt += (c > 0u) ? 1u : 0u; mine = (j == x) ? c : mine; }
        if (sum == G) break;
        __builtin_amdgcn_s_sleep(1);
        if ((++sp & 255u) == 0u) { if (xb_ld(&bar[XB_TMO])) break; if (sp > XB_SPIN_CAP) { atomicAdd(&bar[XB_TMO], 1u); break; } }
    }
    nloc = mine > 0u ? mine : 1u; nx = cnt > 0u ? cnt : 1u;
}

__device__ __forceinline__ void xcd_barrier(const XcdBarrier& b) {
    asm volatile("s_waitcnt vmcnt(0)" ::: "memory");
    __syncthreads();
    if (threadIdx.x == 0) {
        unsigned* bar = b.bar;
        __builtin_amdgcn_s_waitcnt(0);
        unsigned nloc = b.st[0], nx = b.st[1];
        if (nloc == 0u) { xcd_barrier_complete(bar, b.x, nloc, nx); b.st[0] = nloc; b.st[1] = nx; }
        const unsigned old = xb_add(&bar[XB_XSUB(b.x)], 1u);
        const unsigned gen = old / nloc;
        if (old + 1u == (gen + 1u) * nloc) {
            __builtin_amdgcn_fence(__ATOMIC_RELEASE, "agent");
            asm volatile("s_waitcnt vmcnt(0)" ::: "memory");
            const unsigned og = xb_add(&bar[XB_TOP], 1u);
            const unsigned tg = og / nx;
            if (og + 1u == (tg + 1u) * nx) xb_add(&bar[XB_TOPGEN], 1u);
            else XB_SPIN(xb_ld(&bar[XB_TOPGEN]) == tg, bar);
            __builtin_amdgcn_fence(__ATOMIC_ACQUIRE, "agent");
            xb_add(&bar[XB_XGEN(b.x)], 1u);
            asm volatile("s_waitcnt vmcnt(0)" ::: "memory");
        } else {
            XB_SPIN(xb_ld(&bar[XB_XGEN(b.x)]) == gen, bar);
            __builtin_amdgcn_fence(__ATOMIC_ACQUIRE, "agent");
            asm volatile("s_waitcnt vmcnt(0)" ::: "memory");
        }
    }
    __syncthreads();
}

struct Frame {
    LAS unsigned char* lds;
    volatile LAS unsigned* MISC;
    gu32* ctl;
    int tid, lane, wave;
    int vcu, G;
    const float* const* in; float* out; unsigned char* ws;
};
enum { I_X = 0, I_ATTN_NORM, I_ATTN_WIN, I_ATTN_BF, I_ATTN_WOUT, I_FFN_NORM, I_FFN_WG, I_FFN_WU, I_FFN_WD, I_CONV_NORM, I_CONV_WIN, I_CONV_W, I_CONV_WOUT, I_MOE_NORM, I_MOE_WR, I_MOE_WG, I_MOE_WU, I_MOE_WD, I_FINAL_NORM };

__device__ __forceinline__ float wave_sum(float v) {
#pragma unroll
    for (int o = 1; o < 64; o <<= 1) v += __shfl_xor(v, o);
    return v;
}
__device__ __forceinline__ void tr_item(const float* W, int ldw, int K, bf16* WT, int k0, int n0, int drow0, LAS float* scr, int lane, const float* gain = nullptr) {
    { f32x4 t[8]; const int kr = lane >> 3, c4 = 4 * (lane & 7);
#pragma unroll
      for (int i = 0; i < 8; ++i) t[i] = *(const GAS f32x4*)(W + (size_t)(k0 + kr + 8 * i) * ldw + n0 + c4);
#pragma unroll
      for (int i = 0; i < 8; ++i) { const int kk = kr + 8 * i; const float gn = gain ? gain[k0 + kk] : 1.0f; LAS float* d = scr + kk * 33 + c4;
          d[0] = t[i].x * gn; d[1] = t[i].y * gn; d[2] = t[i].z * gn; d[3] = t[i].w * gn; } }
    LDS_WAIT(); asm volatile("" ::: "memory");
    const int c = lane & 7;
#pragma unroll
    for (int j = 0; j < 4; ++j) { const int n = (lane >> 3) + 8 * j; const LAS float* s = scr + (8 * c) * 33 + n;
        v4u o; o.x = pk2(s[0 * 33], s[1 * 33]); o.y = pk2(s[2 * 33], s[3 * 33]); o.z = pk2(s[4 * 33], s[5 * 33]); o.w = pk2(s[6 * 33], s[7 * 33]);
        *(GAS v4u*)(WT + (size_t)(drow0 + n) * K + k0 + 8 * c) = o; }
    LDS_WAIT(); asm volatile("" ::: "memory");
}
__device__ __forceinline__ void tr_item8(const float* W, int ldw, int Kb, unsigned char* WT, int k0, int n0, int drow0, LAS float* scr, int lane) {
    { f32x4 t[8]; const int kr = lane >> 3, c4 = 4 * (lane & 7);
#pragma unroll
      for (int i = 0; i < 8; ++i) t[i] = *(const GAS f32x4*)(W + (size_t)(k0 + kr + 8 * i) * ldw + n0 + c4);
#pragma unroll
      for (int i = 0; i < 8; ++i) { LAS float* d = scr + (kr + 8 * i) * 33 + c4;
          d[0] = t[i].x * pg8::W8_SCALE; d[1] = t[i].y * pg8::W8_SCALE; d[2] = t[i].z * pg8::W8_SCALE; d[3] = t[i].w * pg8::W8_SCALE; } }
    LDS_WAIT(); asm volatile("" ::: "memory");
#pragma unroll
    for (int j = 0; j < 2; ++j) { const int idx = lane + 64 * j, n = idx >> 2, c = idx & 3; const LAS float* s = scr + (16 * c) * 33 + n;
        v4u o; o.x = pg8::pk4_fp8(s[0 * 33], s[1 * 33], s[2 * 33], s[3 * 33]); o.y = pg8::pk4_fp8(s[4 * 33], s[5 * 33], s[6 * 33], s[7 * 33]);
        o.z = pg8::pk4_fp8(s[8 * 33], s[9 * 33], s[10 * 33], s[11 * 33]); o.w = pg8::pk4_fp8(s[12 * 33], s[13 * 33], s[14 * 33], s[15 * 33]);
        *(GAS v4u*)(WT + (size_t)(drow0 + n) * Kb + k0 + 16 * c) = o; }
    LDS_WAIT(); asm volatile("" ::: "memory");
}
struct TrItem { const float* W; const float* gain; unsigned char* WT; int ldw, Kb, k0, n0, drow0, fp8; };
__device__ __forceinline__ void tr_load(const TrItem& I, f32x4 (&t)[8], int lane) {
    const int kr = lane >> 3, c4 = 4 * (lane & 7);
#pragma unroll
    for (int i = 0; i < 8; ++i) t[i] = *(const GAS f32x4*)(I.W + (size_t)(I.k0 + kr + 8 * i) * I.ldw + I.n0 + c4);
}
__device__ __forceinline__ void tr_to_lds(const TrItem& I, const f32x4 (&t)[8], LAS float* scr, int lane) {
    const int kr = lane >> 3, c4 = 4 * (lane & 7); const float sc = (I.fp8 == 1) ? pg8::W8_SCALE : 1.0f;
#pragma unroll
    for (int i = 0; i < 8; ++i) { const int kk = kr + 8 * i; const float gn = I.gain ? I.gain[I.k0 + kk] * sc : sc; LAS float* d = scr + kk * 33 + c4;
        d[0] = t[i].x * gn; d[1] = t[i].y * gn; d[2] = t[i].z * gn; d[3] = t[i].w * gn; }
    LDS_WAIT(); asm volatile("" ::: "memory");
}
__device__ __forceinline__ void tr_store(const TrItem& I, LAS float* scr, int lane) {
    if (I.fp8 == 1) {
#pragma unroll
        for (int j = 0; j < 2; ++j) { const int idx = lane + 64 * j, n = idx >> 2, c = idx & 3; const LAS float* s = scr + (16 * c) * 33 + n;
            v4u o; o.x = pg8::pk4_fp8(s[0 * 33], s[1 * 33], s[2 * 33], s[3 * 33]); o.y = pg8::pk4_fp8(s[4 * 33], s[5 * 33], s[6 * 33], s[7 * 33]);
            o.z = pg8::pk4_fp8(s[8 * 33], s[9 * 33], s[10 * 33], s[11 * 33]); o.w = pg8::pk4_fp8(s[12 * 33], s[13 * 33], s[14 * 33], s[15 * 33]);
            *(GAS v4u*)(I.WT + (size_t)(I.drow0 + n) * I.Kb + I.k0 + 16 * c) = o; }
    } else {
        const int c = lane & 7;
#pragma unroll
        for (int j = 0; j < 4; ++j) { const int n = (lane >> 3) + 8 * j; const LAS float* s = scr + (8 * c) * 33 + n;
            v4u o;
            if (I.fp8 == 2) { o.x = pg8::pk2h(s[0 * 33], s[1 * 33]); o.y = pg8::pk2h(s[2 * 33], s[3 * 33]); o.z = pg8::pk2h(s[4 * 33], s[5 * 33]); o.w = pg8::pk2h(s[6 * 33], s[7 * 33]); }
            else { o.x = pk2(s[0 * 33], s[1 * 33]); o.y = pk2(s[2 * 33], s[3 * 33]); o.z = pk2(s[4 * 33], s[5 * 33]); o.w = pk2(s[6 * 33], s[7 * 33]); }
            *(GAS v4u*)(I.WT + (size_t)(I.drow0 + n) * I.Kb + (size_t)(I.k0 + 8 * c) * 2) = o; }
    }
    LDS_WAIT(); asm volatile("" ::: "memory");
}
__device__ __forceinline__ int map_gate(int n0) { return 256 * (n0 >> 7) + (n0 & 127); }
__device__ __forceinline__ int map_up(int n0) { return 256 * (n0 >> 7) + 128 + (n0 & 127); }

__device__ __forceinline__ void rms_row(const float* xrow, const f32x4 (&g)[4], f32x4 (&v)[4], int lane) {
    const GAS f32x4* xr = (const GAS f32x4*)xrow + lane; float s = 0.f;
#pragma unroll
    for (int j = 0; j < 4; ++j) { v[j] = xr[64 * j]; s += (v[j].x * v[j].x + v[j].y * v[j].y) + (v[j].z * v[j].z + v[j].w * v[j].w); }
    const float rstd = 1.0f / sqrtf(wave_sum(s) * (1.f / D) + RMS_EPS);
#pragma unroll
    for (int j = 0; j < 4; ++j) v[j] = v[j] * rstd * g[j];
}
__device__ __forceinline__ void rms_load(const float* xrow, f32x4 (&v)[4], int lane) {
    const GAS f32x4* xr = (const GAS f32x4*)xrow + lane;
#pragma unroll
    for (int j = 0; j < 4; ++j) v[j] = xr[64 * j];
}
__device__ __forceinline__ void rms_finish(const f32x4 (&g)[4], f32x4 (&v)[4]) {
    float s = 0.f;
#pragma unroll
    for (int j = 0; j < 4; ++j) s += (v[j].x * v[j].x + v[j].y * v[j].y) + (v[j].z * v[j].z + v[j].w * v[j].w);
    const float rstd = 1.0f / sqrtf(wave_sum(s) * (1.f / D) + RMS_EPS);
#pragma unroll
    for (int j = 0; j < 4; ++j) v[j] = v[j] * rstd * g[j];
}
__device__ __forceinline__ void load_row_h16(const bf16* hrow, f32x4 (&v)[4], int lane) {
    typedef unsigned u32x2 __attribute__((ext_vector_type(2)));
    const GAS u32x2* hr = (const GAS u32x2*)hrow + lane;
#pragma unroll
    for (int j = 0; j < 4; ++j) { const u32x2 w = hr[64 * j]; v[j] = (f32x4){pg8::h_lo(w.x), pg8::h_hi(w.x), pg8::h_lo(w.y), pg8::h_hi(w.y)}; }
}
__device__ __forceinline__ void store_row_bf16(bf16* orow, const f32x4 (&v)[4], int lane) {
    GAS unsigned long long* o8 = (GAS unsigned long long*)orow + lane;
#pragma unroll
    for (int j = 0; j < 4; ++j) o8[64 * j] = (unsigned long long)pk2(v[j].x, v[j].y) | ((unsigned long long)pk2(v[j].z, v[j].w) << 32);
}
__device__ __forceinline__ void load_gain(const float* gp, f32x4 (&g)[4], int lane) {
#pragma unroll
    for (int j = 0; j < 4; ++j) g[j] = ((const GAS f32x4*)gp)[lane + 64 * j];
}

__device__ __forceinline__ void p0_prologue(Frame& F) {
    constexpr int WFLD = 1032;
    LAS bf16* wf = (LAS bf16*)(F.lds + RING_OFF);
    LAS float* wtot = (LAS float*)(F.lds + RING_OFF + 40960);
    const float* Win = F.in[I_ATTN_WIN];
    for (int i = 0; i < 32; ++i) { const int k = (F.tid >> 4) + 32 * i, h = F.tid & 15; wf[h * WFLD + k] = (bf16)f2bf(Win[(size_t)k * NIN + NQKV + h]); }
    __syncthreads();
    bf16* XN = (bf16*)(F.ws + WS_XN); float* C2 = (float*)(F.ws + WS_C2); float* CTOT = (float*)(F.ws + WS_CTOT);
    f32x4 g[4]; load_gain(F.in[I_ATTN_NORM], g, F.lane);
    const int hh = F.lane & 15, q4 = F.lane >> 4; const float bfg = F.in[I_ATTN_BF][hh];
    for (int chunk = blockIdx.x; chunk < NCH; chunk += F.G) {
        const int r0 = chunk * 128 + F.wave * 16;
        for (int rr = 0; rr < 16; rr += 2) { f32x4 v[4], w[4];
            rms_load(F.in[I_X] + (size_t)(r0 + rr) * D, v, F.lane); rms_load(F.in[I_X] + (size_t)(r0 + rr + 1) * D, w, F.lane);
            rms_finish(g, v); rms_finish(g, w); store_row_bf16(XN + (size_t)(r0 + rr) * D, v, F.lane); store_row_bf16(XN + (size_t)(r0 + rr + 1) * D, w, F.lane); }
        VM_WAIT();
        f32x4 acc = (f32x4){0.f, 0.f, 0.f, 0.f};
        const bf16* arow = XN + (size_t)(r0 + hh) * D + 8 * q4; const LAS bf16* brow = wf + hh * WFLD + 8 * q4;
#pragma unroll 8
        for (int s = 0; s < 32; ++s) { const bf16x8 a = *(const GAS bf16x8*)(arow + 32 * s); const bf16x8 b = *(const LAS bf16x8*)(brow + 32 * s); acc = __builtin_amdgcn_mfma_f32_16x16x32_bf16(a, b, acc, 0, 0, 0); }
        float p[4], run = 0.f;
#pragma unroll
        for (int r = 0; r < 4; ++r) { const float x = acc[r] + bfg; const float ls = fminf(x, 0.f) - log1pf(expf(-fabsf(x))); run += ls; p[r] = run; }
        const float T0 = __shfl(run, hh), T1 = __shfl(run, hh + 16), T2 = __shfl(run, hh + 32), T3 = __shfl(run, hh + 48);
        const float excl = (q4 > 0 ? T0 : 0.f) + (q4 > 1 ? T1 : 0.f) + (q4 > 2 ? T2 : 0.f);
        if (q4 == 0) wtot[F.wave * 16 + hh] = (T0 + T1) + (T2 + T3);
        __syncthreads();
        float wp = 0.f, tot = 0.f;
#pragma unroll
        for (int i = 0; i < 8; ++i) { const float t = wtot[i * 16 + hh]; if (i < F.wave) wp += t; tot += t; }
        if (F.wave == 0 && q4 == 0) CTOT[chunk * 16 + hh] = tot;
        const int b = chunk / (SEQ / 128), t0 = (chunk % (SEQ / 128)) * 128 + F.wave * 16 + 4 * q4; const float base = wp + excl;
        *(GAS f32x4*)(C2 + (size_t)(b * H + hh) * SEQ + t0) = (f32x4){p[0] + base, p[1] + base, p[2] + base, p[3] + base};
        __syncthreads();
    }
}
constexpr int TI_QKV = (D / 64) * (NQKV / 32), TI_DD = (D / 64) * (D / 32), TI_DF = (D / 64) * (FF / 32), TI_FD = (FF / 64) * (D / 32);
constexpr int N_EARLY = TI_QKV + TI_DD, NITEMS = TI_QKV + TI_DD + 2 * TI_DF + TI_FD + TI_QKV + TI_DD + NE * (2 * TI_DF + TI_FD);
__device__ __forceinline__ void weight_copies(Frame& F, int it_lo, int it_hi, int cw, int ncw) {
    LAS float* scr = (LAS float*)(F.lds + RING_OFF + F.wave * 16384);
    constexpr int I_QKV = TI_QKV, I_DD = TI_DD, I_DF = TI_DF, I_FD = TI_FD;
    bf16* WQKV = (bf16*)(F.ws + WS_WQKV); bf16* WO = (bf16*)(F.ws + WS_WO); bf16* WGU = (bf16*)(F.ws + WS_WGU); bf16* WD = (bf16*)(F.ws + WS_WD);
    bf16* WCIN = (bf16*)(F.ws + WS_WCIN); bf16* WCO = (bf16*)(F.ws + WS_WCO); unsigned char* MGU = F.ws + WS_MGU8; unsigned char* MD = F.ws + WS_MD8;
    auto decode = [&](int it, TrItem& I) {
        int r = it; I.gain = nullptr; I.fp8 = 0;
        auto set = [&](const float* W, int ldw, int ncols, void* WT, int Kb) { const int nb = ncols / 32; I.W = W; I.ldw = ldw; I.WT = (unsigned char*)WT; I.Kb = Kb; I.k0 = 64 * (r / nb); I.n0 = 32 * (r % nb); I.drow0 = I.n0; };
        if (r < I_QKV) { set(F.in[I_ATTN_WIN], NIN, NQKV, WQKV, D * 2); return; } r -= I_QKV;
        if (r < I_DD) { set(F.in[I_ATTN_WOUT], D, D, WO, D * 2); return; } r -= I_DD;
        if (r < I_DF) { set(F.in[I_FFN_WG], FF, FF, WGU, D * 2); I.drow0 = map_gate(I.n0); I.gain = F.in[I_FFN_NORM]; I.fp8 = 2; return; } r -= I_DF;
        if (r < I_DF) { set(F.in[I_FFN_WU], FF, FF, WGU, D * 2); I.drow0 = map_up(I.n0); I.gain = F.in[I_FFN_NORM]; I.fp8 = 2; return; } r -= I_DF;
        if (r < I_FD) { set(F.in[I_FFN_WD], D, D, WD, FF * 2); return; } r -= I_FD;
        if (r < I_QKV) { set(F.in[I_CONV_WIN], NQKV, NQKV, WCIN, D * 2); const int n0 = I.n0;
            I.drow0 = n0 < D ? 2 * D + n0 : (n0 < 2 * D ? map_gate(n0 - D) : map_up(n0 - 2 * D)); I.gain = F.in[I_CONV_NORM]; I.fp8 = 2; return; } r -= I_QKV;
        if (r < I_DD) { set(F.in[I_CONV_WOUT], D, D, WCO, D * 2); return; } r -= I_DD;
        const int per_e = 2 * I_DF + I_FD, e = r / per_e; r -= e * per_e; I.fp8 = 1;
        if (r < I_DF) { set(F.in[I_MOE_WG] + (size_t)e * D * FF, FF, FF, MGU + (size_t)e * 2 * FF * D, D); I.drow0 = map_gate(I.n0); return; } r -= I_DF;
        if (r < I_DF) { set(F.in[I_MOE_WU] + (size_t)e * D * FF, FF, FF, MGU + (size_t)e * 2 * FF * D, D); I.drow0 = map_up(I.n0); return; } r -= I_DF;
        set(F.in[I_MOE_WD] + (size_t)e * FF * D, D, D, MD + (size_t)e * D * FF, FF);
    };
    TrItem cur, nxt; f32x4 t[8]; int it = it_lo + cw; bool have = it < it_hi;
    if (have) { decode(it, cur); tr_load(cur, t, F.lane); }
    while (have) {
        tr_to_lds(cur, t, scr, F.lane);
        const int itn = it + ncw; const bool hn = itn < it_hi;
        if (hn) { decode(itn, nxt); tr_load(nxt, t, F.lane); }
        tr_store(cur, scr, F.lane);
        cur = nxt; it = itn; have = hn;
    }
}
__device__ __forceinline__ void p1_scan_fixup(Frame& F) {
    LAS float* part = (LAS float*)(F.lds + RING_OFF); LAS float* pre = part + 512;
    float* C2 = (float*)(F.ws + WS_C2); const float* CTOT = (const float*)(F.ws + WS_CTOT);
    for (int chunk = blockIdx.x; chunk < NCH; chunk += F.G) {
        const int b = chunk / (SEQ / 128), cb = chunk % (SEQ / 128), hh = F.tid & 15, j = F.tid >> 4;
        float s = 0.f;
        if (j < cb) s += CTOT[(b * (SEQ / 128) + j) * 16 + hh];
        if (j + 32 < cb) s += CTOT[(b * (SEQ / 128) + j + 32) * 16 + hh];
        part[j * 16 + hh] = s;
        __syncthreads();
        if (F.tid < 16) { float t = 0.f; for (int i = 0; i < 32; ++i) t += part[i * 16 + F.tid]; pre[F.tid] = t; }
        __syncthreads();
        const int h2 = F.tid >> 5, t4 = (F.tid & 31) * 4;
        GAS f32x4* p = (GAS f32x4*)(C2 + (size_t)(b * H + h2) * SEQ + cb * 128 + t4);
        const float pr = pre[h2]; const f32x4 v = *p; *p = (f32x4){(v.x + pr) * LOG2E, (v.y + pr) * LOG2E, (v.z + pr) * LOG2E, (v.w + pr) * LOG2E};
        __syncthreads();
    }
}
__device__ __forceinline__ void norm_phase(Frame& F, const float* gain) {
    f32x4 g[4]; load_gain(gain, g, F.lane); bf16* XN = (bf16*)(F.ws + WS_XN);
    const int gw = F.vcu * NWAVES + F.wave, NGW = F.G * NWAVES;
    for (int m = gw; m < M; m += NGW) { f32x4 v[4]; rms_row(F.out + (size_t)m * D, g, v, F.lane); store_row_bf16(XN + (size_t)m * D, v, F.lane); }
}
__device__ __forceinline__ void final_norm_phase(Frame& F) {
    f32x4 g[4]; load_gain(F.in[I_FINAL_NORM], g, F.lane);
    const int gw = F.vcu * NWAVES + F.wave, NGW = F.G * NWAVES;
    for (int m = gw; m < M; m += NGW) { f32x4 v[4]; rms_row(F.out + (size_t)m * D, g, v, F.lane); GAS f32x4* o = (GAS f32x4*)(F.out + (size_t)m * D) + F.lane;
#pragma unroll
        for (int j = 0; j < 4; ++j) o[64 * j] = v[j]; }
}
__device__ __forceinline__ void conv_fixup(Frame& F, int pm) {
    if ((pm % (SEQ / 256)) == 0) return;
    typedef unsigned u32x2 __attribute__((ext_vector_type(2)));
    const bf16* U = (const bf16*)(F.ws + WS_K); bf16* Z = (bf16*)(F.ws + WS_V); const float* cw = F.in[I_CONV_W];
    const float* zp = (const float*)(F.ws + WS_ZP); const float* bgb = (const float*)(F.ws + WS_BGB);
    const int r = F.tid >> 8, c4 = (F.tid & 255) * 4; const size_t g = (size_t)pm * 256 + r, gt0 = (size_t)pm * 256;
    const f32x4 z0 = *(const GAS f32x4*)(zp + ((size_t)pm * 2 + r) * D + c4), gt = *(const GAS f32x4*)(bgb + ((size_t)pm * 2 + r) * D + c4);
    const f32x4 w0 = *(const GAS f32x4*)(cw + c4), w1 = *(const GAS f32x4*)(cw + D + c4);
    const u32x2 ua = *(const GAS u32x2*)(U + (gt0 - 1) * D + c4), ub = *(const GAS u32x2*)(U + (gt0 - 2) * D + c4);
    const f32x4 a = (f32x4){bf_lo(ua.x), bf_hi(ua.x), bf_lo(ua.y), bf_hi(ua.y)}, b = (f32x4){bf_lo(ub.x), bf_hi(ub.x), bf_lo(ub.y), bf_hi(ub.y)};
    const f32x4 z = (r == 0) ? z0 + gt * (w0 * b + w1 * a) : z0 + gt * (w0 * a);
    u32x2 o; o.x = pk2(z.x, z.y); o.y = pk2(z.z, z.w); *(GAS u32x2*)(Z + g * D + c4) = o;
}
__device__ __forceinline__ void store_row_fp8(unsigned char* orow, const f32x4 (&v)[4], int lane) {
    GAS unsigned* o = (GAS unsigned*)orow + lane;
#pragma unroll
    for (int j = 0; j < 4; ++j) o[64 * j] = pg8::pk4_fp8(v[j].x, v[j].y, v[j].z, v[j].w);
}
__device__ __forceinline__ void route_phase(Frame& F) {
    LAS float* wr = (LAS float*)(F.lds + RING_OFF);
    LAS int* sel = (LAS int*)(F.lds + RING_OFF + 32768);
    LAS float* gv = (LAS float*)(F.lds + RING_OFF + 32768 + 1024);
    LAS int* wcnt = (LAS int*)(F.lds + RING_OFF + 32768 + 2048);
    const float* Wr = F.in[I_MOE_WR];
    for (int i = F.tid; i < D * NE; i += NWAVES * 64) wr[(i & 7) * D + (i >> 3)] = Wr[i];
    __syncthreads();
    f32x4 g[4]; load_gain(F.in[I_MOE_NORM], g, F.lane); unsigned char* XN8 = F.ws + WS_XN8;
    int* LIST = (int*)(F.ws + WS_LIST); unsigned* INV = (unsigned*)(F.ws + WS_INV); float* GT = (float*)(F.ws + WS_GATE); const bf16* HBc = (const bf16*)(F.ws + WS_HB);
    for (int chunk = blockIdx.x; chunk < NCH; chunk += F.G) {
        f32x4 vnx[4]; load_row_h16(HBc + (size_t)(chunk * 128 + F.wave * 16) * D, vnx, F.lane);
        for (int rr = 0; rr < 16; ++rr) { const int rc = F.wave * 16 + rr, m = chunk * 128 + rc;
            f32x4 v[4];
#pragma unroll
            for (int j = 0; j < 4; ++j) v[j] = vnx[j];
            if (rr + 1 < 16) load_row_h16(HBc + (size_t)(m + 1) * D, vnx, F.lane);
            rms_finish(g, v); store_row_fp8(XN8 + (size_t)m * D, v, F.lane);
            float lg[NE];
#pragma unroll
            for (int e = 0; e < NE; ++e) { float p = 0.f;
#pragma unroll
                for (int j = 0; j < 4; ++j) { const f32x4 w = *(const LAS f32x4*)(wr + e * D + 4 * F.lane + 256 * j); p += (v[j].x * w.x + v[j].y * w.y) + (v[j].z * w.z + v[j].w * w.w); }
                lg[e] = wave_sum(p); }
            int e1 = 0; float v1 = lg[0];
#pragma unroll
            for (int e = 1; e < NE; ++e) if (lg[e] > v1) { v1 = lg[e]; e1 = e; }
            int e2 = -1; float v2 = -INFINITY;
#pragma unroll
            for (int e = 0; e < NE; ++e) if (e != e1 && lg[e] > v2) { v2 = lg[e]; e2 = e; }
            const float g1 = 1.0f / (1.0f + expf(v2 - v1));
            if (F.lane == 0) { sel[rc * 2] = e1; sel[rc * 2 + 1] = e2; gv[rc * 2] = g1; gv[rc * 2 + 1] = 1.0f - g1; } }
        __syncthreads();
        int my_e = -1, my_rank = 0;
        if (F.tid < 256) { my_e = sel[F.tid];
#pragma unroll
            for (int ex = 0; ex < NE; ++ex) { const unsigned long long mk = __ballot(my_e == ex); if (my_e == ex) my_rank = __popcll(mk & ((1ull << F.lane) - 1ull)); if (F.lane == 0) wcnt[F.wave * NE + ex] = __popcll(mk); } }
        __syncthreads();
        if (F.tid < NE) { const int c0 = wcnt[F.tid], c1 = wcnt[NE + F.tid], c2 = wcnt[2 * NE + F.tid], c3 = wcnt[3 * NE + F.tid], tot = c0 + c1 + c2 + c3;
            const int b = tot ? (int)__hip_atomic_fetch_add(F.ctl + CW_MOE + 64 * F.tid, (unsigned)tot, RLX_AGENT) : 0;
            wcnt[F.tid] = b; wcnt[NE + F.tid] = b + c0; wcnt[2 * NE + F.tid] = b + c0 + c1; wcnt[3 * NE + F.tid] = b + c0 + c1 + c2; }
        __syncthreads();
        if (F.tid < 256 && my_e >= 0) { const int pos = wcnt[F.wave * NE + my_e] + my_rank, tok = chunk * 128 + (F.tid >> 1);
            LIST[(size_t)my_e * M + pos] = tok; INV[tok * 2 + (F.tid & 1)] = ((unsigned)my_e << 20) | (unsigned)pos; GT[tok * 2 + (F.tid & 1)] = gv[F.tid]; }
        __syncthreads();
    }
}
__device__ __forceinline__ void moe_table(Frame& F) {
    LAS int* tab = (LAS int*)(F.lds + LDSCTL_OFF);
    if (F.tid == 0) { int ts = 0; for (int e = 0; e < NE; ++e) { const int c = (int)__hip_atomic_load(F.ctl + CW_MOE + 64 * e, RLX_AGENT); tab[e] = ts; tab[16 + e] = c; ts += (c + 255) >> 8; } tab[8] = ts; }
    __syncthreads();
}
__device__ __forceinline__ void final_phase(Frame& F) {
    typedef unsigned u32x2 __attribute__((ext_vector_type(2)));
    f32x4 g[4]; load_gain(F.in[I_FINAL_NORM], g, F.lane);
    const LAS int* tab = (const LAS int*)(F.lds + LDSCTL_OFF);
    const bf16* Y = (const bf16*)(F.ws + WS_Y); const bf16* HBc = (const bf16*)(F.ws + WS_HB); const unsigned* INV = (const unsigned*)(F.ws + WS_INV); const float* GT = (const float*)(F.ws + WS_GATE);
    const int gw = F.vcu * NWAVES + F.wave, NGW = F.G * NWAVES, nrow = (M - gw + NGW - 1) / NGW;
    for (int k0 = 0; k0 < nrow; k0 += 32) {
        const int kk = k0 + (F.lane >> 1); const bool okl = kk < nrow; const int ml = gw + kk * NGW;
        const unsigned ivl = okl ? INV[ml * 2 + (F.lane & 1)] : 0u; const float gtl = okl ? GT[ml * 2 + (F.lane & 1)] : 0.f;
        const int nb = (nrow - k0) < 32 ? (nrow - k0) : 32;
        u32x2 hw[4], ya[4], yb[4]; float g0 = 0.f, g1 = 0.f;
        auto issue = [&](int k, u32x2 (&h_)[4], u32x2 (&a_)[4], u32x2 (&b_)[4], float& g0_, float& g1_) {
            const unsigned i0 = __shfl(ivl, 2 * k), i1 = __shfl(ivl, 2 * k + 1); g0_ = __shfl(gtl, 2 * k); g1_ = __shfl(gtl, 2 * k + 1);
            const size_t r0 = (size_t)tab[i0 >> 20] * 256 + (i0 & 0xfffffu), r1 = (size_t)tab[i1 >> 20] * 256 + (i1 & 0xfffffu); const int m = gw + (k0 + k) * NGW;
            const GAS u32x2* xr = (const GAS u32x2*)(HBc + (size_t)m * D) + F.lane; const GAS u32x2* y0 = (const GAS u32x2*)(Y + r0 * D) + F.lane; const GAS u32x2* y1 = (const GAS u32x2*)(Y + r1 * D) + F.lane;
#pragma unroll
            for (int j = 0; j < 4; ++j) { h_[j] = xr[64 * j]; a_[j] = y0[64 * j]; b_[j] = y1[64 * j]; } };
        issue(0, hw, ya, yb, g0, g1);
        for (int k = 0; k < nb; ++k) {
            u32x2 hn[4] = {}, an[4] = {}, bn[4] = {}; float g0n = 0.f, g1n = 0.f;
            if (k + 1 < nb) issue(k + 1, hn, an, bn, g0n, g1n);
            f32x4 v[4]; float s = 0.f;
#pragma unroll
            for (int j = 0; j < 4; ++j) { const u32x2 a = ya[j], b = yb[j];
                v[j].x = pg8::h_lo(hw[j].x) + g0 * bf_lo(a.x) + g1 * bf_lo(b.x); v[j].y = pg8::h_hi(hw[j].x) + g0 * bf_hi(a.x) + g1 * bf_hi(b.x);
                v[j].z = pg8::h_lo(hw[j].y) + g0 * bf_lo(a.y) + g1 * bf_lo(b.y); v[j].w = pg8::h_hi(hw[j].y) + g0 * bf_hi(a.y) + g1 * bf_hi(b.y);
                s += (v[j].x * v[j].x + v[j].y * v[j].y) + (v[j].z * v[j].z + v[j].w * v[j].w); }
            const float rstd = 1.0f / sqrtf(wave_sum(s) * (1.f / D) + RMS_EPS);
            GAS f32x4* o = (GAS f32x4*)(F.out + (size_t)(gw + (k0 + k) * NGW) * D) + F.lane;
#pragma unroll
            for (int j = 0; j < 4; ++j) o[64 * j] = v[j] * rstd * g[j];
#pragma unroll
            for (int j = 0; j < 4; ++j) { hw[j] = hn[j]; ya[j] = an[j]; yb[j] = bn[j]; }
            g0 = g0n; g1 = g1n;
        }
    }
}
__device__ __forceinline__ int probe_two() { int n = 2; asm volatile("" : "+s"(n)); return n; }
struct Args { const float* in[19]; float* out; unsigned char* ws; int ph_lo, ph_hi; };
__global__ void __launch_bounds__(NWAVES * 64, 2) mk_fwd(Args args) {
    extern __shared__ __attribute__((aligned(16))) unsigned char lds[];
    Frame F;
    F.lds = (LAS unsigned char*)lds;
    F.MISC = (volatile LAS unsigned*)(F.lds + MISC_OFF);
    F.tid = threadIdx.x; F.lane = F.tid & 63; F.wave = __builtin_amdgcn_readfirstlane(F.tid >> 6);
    F.G = gridDim.x; { const int bx = blockIdx.x; F.vcu = (F.G % 8 == 0) ? (bx % 8) * (F.G / 8) + bx / 8 : bx; }
    F.ws = args.ws; F.out = args.out; F.ctl = (gu32*)(args.ws + WS_CTL);
    F.in = args.in;
    { int t0_ = F.tid; asm volatile("" : "+v"(t0_));
      for (int u = t0_; u < (LDS_BYTES - LDSCTL_OFF) / 4; u += NWAVES * 64) ((LAS unsigned*)(F.lds + LDSCTL_OFF))[u] = 0u; }
    __syncthreads();
    XcdBarrier bar; bar.bar = (unsigned*)(F.ctl + CW_BAR); bar.x = 0; bar.st = nullptr;
    if (!MK_PER_PHASE) bar = xcd_barrier_post((unsigned*)(F.ctl + CW_BAR), F.MISC + 8);
#define GRID_BAR() do { if (!MK_PER_PHASE) xcd_barrier(bar); } while (0)
    const int lo = args.ph_lo, hi = args.ph_hi;
#ifndef PH_MASK
#define PH_MASK 0x1ffff
#endif
#define IN(k) (((PH_MASK >> (k)) & 1) && lo <= (k) && (k) < hi)
#define BOTH(k) (IN(k) && IN((k) + 1))
#ifndef PROBE_PH
#define PROBE_PH (-1)
#endif
#define REP_BEGIN(k) for (int rep_ = 0, nrep_ = ((k) == PROBE_PH ? probe_two() : 1); rep_ < nrep_; ++rep_) {
#define REP_END(k) if (rep_ + 1 < nrep_) GRID_BAR(); }
    bf16* XN = (bf16*)(F.ws + WS_XN); bf16* QO = (bf16*)(F.ws + WS_QO); bf16* KB = (bf16*)(F.ws + WS_K); bf16* VB = (bf16*)(F.ws + WS_V); bf16* HID = (bf16*)(F.ws + WS_HID); bf16* OB = (bf16*)(F.ws + WS_O); bf16* HB = (bf16*)(F.ws + WS_HB);
    const int bx = (int)blockIdx.x;

    if (IN(0)) { REP_BEGIN(0) p0_prologue(F); __syncthreads(); weight_copies(F, 0, N_EARLY, F.vcu * NWAVES + F.wave, F.G * NWAVES); REP_END(0) if (BOTH(0)) GRID_BAR(); }
    if (IN(1)) {
        p1_scan_fixup(F);
        REP_BEGIN(1)
        typedef pg8::DenseSched<D, M / 256, NQKV / 256> Sc; typedef pg8::EpiBf16<D, D> Ep;
        Sc S{F.G, bx, (const char*)(F.ws + WS_WQKV)}; Ep E{QO, (size_t)(WS_K - WS_QO) / 2, QSCALE, (unsigned*)(F.ctl + CW_NRM), SEQ};
        pg8::gemm_phase<D, Ep, Sc, true, true>(F.lds + RING_OFF, (const char*)XN, S, E);
        REP_END(1)
        if (BOTH(1)) GRID_BAR();
    }
    if (IN(2)) {
        if (((bx >> 3) & 7) == 0 && F.G == 256) { weight_copies(F, N_EARLY, NITEMS, ((bx >> 6) * 8 + (bx & 7)) * NWAVES + F.wave, 32 * NWAVES); __syncthreads(); }
        else if (F.G != 256) { weight_copies(F, N_EARLY, NITEMS, F.vcu * NWAVES + F.wave, F.G * NWAVES); __syncthreads(); }
        REP_BEGIN(2)
        ATTN_PHASE_BODY
        REP_END(2)
        if (BOTH(2)) GRID_BAR();
    }
    if (IN(3)) {
        REP_BEGIN(3)
        typedef pg8::DenseSched<D, M / 256, D / 256> Sc; typedef pg8::EpiResH16<D, false, true> Ep;
        Sc S{F.G, bx, (const char*)(F.ws + WS_WO)}; Ep E{F.in[I_X], HB, (float*)(F.ws + WS_SS)};
        pg8::gemm_phase<D, Ep, Sc, true, true>(F.lds + RING_OFF, (const char*)OB, S, E);
        REP_END(3)
        if (BOTH(3)) GRID_BAR();
    }
    if (IN(5)) {
        REP_BEGIN(5)
        typedef pg8::DenseSched<D, M / 256, 2 * FF / 256> Sc; typedef pg8::EpiSwiGLU<FF, true> Ep;
        Sc S{F.G, bx, (const char*)(F.ws + WS_WGU)}; Ep E{HID, pg8::RowScale{(const float*)(F.ws + WS_SS), (PG8_LAS float*)(F.lds + RSTAB_OFF), -1, 1.0f / D, RMS_EPS}};
        pg8::gemm_phase<D, Ep, Sc, true, true, 2>(F.lds + RING_OFF, (const char*)HB, S, E);
        REP_END(5)
        if (BOTH(5)) GRID_BAR();
    }
    if (IN(6)) {
        typedef pg8::DenseSched<FF, M / 256, D / 256> Sc; typedef pg8::EpiResH16<D, true, true> Ep;
        Sc S{F.G, bx, (const char*)(F.ws + WS_WD)}; Ep E{HB, HB, (float*)(F.ws + WS_SS)};
        pg8::gemm_phase<FF, Ep, Sc, true, true>(F.lds + RING_OFF, (const char*)HID, S, E);
        if (BOTH(6)) GRID_BAR();
    }
    if (IN(8)) {
        REP_BEGIN(8)
        typedef pg8::ConvSched<D, M / 256, D, SEQ / 256> Sc; typedef pg8::EpiConvIn<D> Ep;
        Sc S{F.G, bx, (const char*)(F.ws + WS_WCIN), KB, QO, VB, F.in[I_CONV_W], (float*)(F.ws + WS_ZP), (float*)(F.ws + WS_BGB)}; Ep E{KB, QO, pg8::RowScale{(const float*)(F.ws + WS_SS), (PG8_LAS float*)(F.lds + RSTAB_OFF), -1, 1.0f / D, RMS_EPS}};
        pg8::gemm_phase<D, Ep, Sc, true, true, 2>(F.lds + RING_OFF, (const char*)HB, S, E);
        REP_END(8)
        if (BOTH(8)) GRID_BAR();
    }
    if (IN(10)) {
        { pg8::Unit u0_; pg8::DenseSched<D, M / 256, D / 256> S0{F.G, bx, nullptr}; for (int i = 0; S0.next(i, u0_); ++i) conv_fixup(F, u0_.pm); VM_WAIT(); __syncthreads(); }
        typedef pg8::DenseSched<D, M / 256, D / 256> Sc; typedef pg8::EpiResH16<D, true, false> Ep;
        Sc S{F.G, bx, (const char*)(F.ws + WS_WCO)}; Ep E{HB, HB, nullptr};
        pg8::gemm_phase<D, Ep, Sc, true, true>(F.lds + RING_OFF, (const char*)VB, S, E);
        if (BOTH(10)) GRID_BAR();
    }
    if (IN(11)) { route_phase(F); if (BOTH(11)) GRID_BAR(); }
    {
        const int* list = (const int*)(F.ws + WS_LIST); const PG8_LAS int* tab = (const PG8_LAS int*)(F.lds + LDSCTL_OFF);
        if (IN(12)) {
            moe_table(F);
            REP_BEGIN(12)
            typedef pg8::MoeSched<true, D / 2, 2 * FF / 256, M> Sc; typedef pg8::EpiSwiGLU8<FF> Ep;
            Sc S{F.G, bx, (const char*)(F.ws + WS_MGU8), tab, list, (const PG8_LAS unsigned short*)(F.lds + GTOK_OFF)}; Ep E{F.ws + WS_HID8};
            S.fill_gtok((PG8_LAS unsigned short*)(F.lds + GTOK_OFF), GTOK_UNITS);
            pg8::gemm_phase<D / 2, Ep, Sc, true, true, 1>(F.lds + RING_OFF, (const char*)(F.ws + WS_XN8), S, E);
            REP_END(12)
            if (BOTH(12)) GRID_BAR();
        }
        if (IN(13)) {
            moe_table(F);
            typedef pg8::MoeSched<false, FF / 2, D / 256, M> Sc; typedef pg8::EpiY8<D> Ep;
            Sc S{F.G, bx, (const char*)(F.ws + WS_MD8), tab, list, nullptr}; Ep E{(bf16*)(F.ws + WS_Y)};
            pg8::gemm_phase<FF / 2, Ep, Sc, true, true, 1>(F.lds + RING_OFF, (const char*)(F.ws + WS_HID8), S, E);
            if (BOTH(13)) GRID_BAR();
        }
    }
    if (IN(14)) { moe_table(F); final_phase(F); }
#undef IN
#undef BOTH
#undef GRID_BAR
}

extern "C" void kernel_launch(void* const* d_in, const int* in_sizes, int n_in, void* d_out, int out_size, void* d_ws, size_t ws_size, hipStream_t stream) {
    static int grid = 0;
    if (grid == 0) {
        if (n_in != 19 || in_sizes[0] != M * D || out_size != M * D || ws_size < WS_END) { fprintf(stderr, "kernel_launch: built for 19 inputs, x and out of %d floats, >= %zu bytes of workspace; got n_in %d, in0 %d, out %d, ws %zu; nothing launched\n", M * D, (size_t)WS_END, n_in, n_in > 0 ? in_sizes[0] : -1, out_size, ws_size); grid = -1; return; }
        int dev = 0, cus = 0, per_cu = 0;
        if (hipGetDevice(&dev) != hipSuccess || hipDeviceGetAttribute(&cus, hipDeviceAttributeMultiprocessorCount, dev) != hipSuccess) { fprintf(stderr, "kernel_launch: hipGetDevice / hipDeviceGetAttribute failed; nothing launched\n"); grid = -1; return; }
        if (hipFuncSetAttribute((const void*)mk_fwd, hipFuncAttributeMaxDynamicSharedMemorySize, LDS_BYTES) != hipSuccess) { fprintf(stderr, "kernel_launch: hipFuncSetAttribute failed; nothing launched\n"); grid = -1; return; }
        if (hipOccupancyMaxActiveBlocksPerMultiprocessor(&per_cu, (const void*)mk_fwd, NWAVES * 64, LDS_BYTES) != hipSuccess || per_cu < 1)
            fprintf(stderr, "kernel_launch: note: the occupancy query reports %d workgroups per CU\n", per_cu);
        (void)hipGetLastError();
        grid = cus;
    }
    if (grid < 0) return;
    if (hipMemsetAsync((char*)d_ws + WS_CTL, 0, CTL_ZERO_BYTES, stream) != hipSuccess) { fprintf(stderr, "kernel_launch: hipMemsetAsync of the control words failed; nothing launched\n"); return; }
    Args a{};
    for (int i = 0; i < 19; ++i) a.in[i] = (const float*)d_in[i];
    a.out = (float*)d_out; a.ws = (unsigned char*)d_ws;
    const int nl = MK_PER_PHASE ? N_PHASES : 1;
    for (int li = 0; li < nl; ++li) {
        a.ph_lo = MK_PER_PHASE ? li : 0; a.ph_hi = MK_PER_PHASE ? li + 1 : N_PHASES;
        hipLaunchKernelGGL(mk_fwd, dim3(grid), dim3(NWAVES * 64), LDS_BYTES, stream, a);
        const hipError_t le = hipPeekAtLastError();
        if (le != hipSuccess) { fprintf(stderr, "kernel_launch: launch %d failed: %s\n", li, hipGetErrorName(le)); break; }
    }
}
```

```cpp
#include <hip/hip_runtime.h>
#include <hip/hip_bf16.h>
#include <cstdio>
#include <cstdint>
#include <cmath>
namespace pg8 {
#define PG8_LAS __attribute__((address_space(3)))
typedef unsigned short bf16_t;
typedef short bf16x8 __attribute__((ext_vector_type(8)));
typedef float f32x4 __attribute__((ext_vector_type(4)));
typedef float f32x2 __attribute__((ext_vector_type(2)));
typedef unsigned u32x4 __attribute__((ext_vector_type(4)));
typedef int i32x4 __attribute__((ext_vector_type(4)));
typedef int i32x8 __attribute__((ext_vector_type(8)));
typedef _Float16 f16x8 __attribute__((ext_vector_type(8)));
typedef _Float16 f16x2 __attribute__((ext_vector_type(2)));
typedef unsigned u32x2 __attribute__((ext_vector_type(2)));
constexpr int BM = 256, BK = 64, HALF = 128, HTB = HALF * BK * 2  , STAGE_BYTES = 8 * HTB, NXCD = 8, WGM = 8;

__host__ __device__ __forceinline__ int lds_byte(int r, int c) { const int st = (r >> 4) * 2 + (c >> 5), rr = r & 15, cc = c & 31, ob = rr * 64 + cc * 2; return st * 1024 + (ob ^ (((ob >> 9) & 1) << 5)); }
__host__ __device__ __forceinline__ void stage_rc(int b, int& R, int& C) { const int st = b / 1024, sb = b % 1024, swz = sb ^ (((sb >> 9) & 1) << 5); R = (st >> 1) * 16 + swz / 64; C = (st & 1) * 32 + (swz % 64) / 2; }
__host__ __device__ __forceinline__ int perm32(int rho) { const int n = rho >> 4, i = rho & 15; return 8 * (i >> 2) + 4 * n + (i & 3); }

struct Unit { int pm, pn, e, lrow0, ui; };

__device__ __forceinline__ bool tile_order(int i, int G, int c, int nM, int nN, int& pm, int& pn) {
    const int nwg = nM * nN; const long L = (long)i * G + c; if (L >= nwg) return false;
    int wgid = (int)L; { const int q = nwg / NXCD, r = nwg % NXCD, xcd = wgid % NXCD, off = wgid / NXCD; wgid = (xcd < r ? xcd * (q + 1) : r * (q + 1) + (xcd - r) * q) + off; }
    const int nig = WGM * nN, gid = wgid / nig, fm = gid * WGM, gsz = (nM - fm) < WGM ? (nM - fm) : WGM;
    pm = fm + ((wgid % nig) % gsz); pn = (wgid % nig) / gsz; return true;
}
template <int K, int nM, int nN> struct DenseSched {
    int G, c; const char* Bt;
    __device__ __forceinline__ bool next(int i, Unit& u) const { u.e = 0; u.lrow0 = 0; u.ui = i; return tile_order(i, G, c, nM, nN, u.pm, u.pn); }
    __device__ __forceinline__ unsigned a_off(const Unit& u, int r) const { return (unsigned)(u.pm * BM + r) * (unsigned)(K * 2); }
    __device__ __forceinline__ const char* b_ptr(const Unit& u) const { return Bt + (size_t)u.pn * BM * K * 2; }
    __device__ __forceinline__ void a_ready(const Unit&) const {}
    __device__ __forceinline__ void done(const Unit&) const {}
};
__device__ __forceinline__ unsigned cvt_pk_bf16(float lo, float hi);
template <int K, int nM, int ldc, int tiles_per_seq> struct ConvSched {
    int G, c; const char* Bt; const bf16_t* U; const bf16_t* Bg; bf16_t* Z; const float* cw; float* zp; float* bgb;
    __device__ __forceinline__ bool next(int i, Unit& u) const { const int tr = i / 3, sub = i - 3 * tr; int pm, a; if (!tile_order(tr, G, c, nM, 4, pm, a)) return false;
        u.pm = pm; u.pn = sub < 2 ? 2 * a + sub : 8 + a; u.e = 0; u.lrow0 = 0; u.ui = i; return true; }
    __device__ __forceinline__ unsigned a_off(const Unit& u, int r) const { return (unsigned)(u.pm * BM + r) * (unsigned)(K * 2); }
    __device__ __forceinline__ const char* b_ptr(const Unit& u) const { return Bt + (size_t)u.pn * BM * K * 2; }
    __device__ __forceinline__ void a_ready(const Unit&) const {}
    __device__ __forceinline__ void done(const Unit& u) const {
        if (u.pn < 8) return;
        asm volatile("s_waitcnt vmcnt(0)" ::: "memory"); __builtin_amdgcn_s_barrier(); asm volatile("" ::: "memory");
        int t = threadIdx.x; asm volatile("" : "+v"(t));
        const int cg = t & 31, rsl = t >> 5, col = (u.pn - 8) * BM + 8 * cg, r0 = 16 * rsl; const size_t g0 = (size_t)u.pm * BM + r0;
        const bool seam = (u.pm % tiles_per_seq) != 0;
        float w0[8], w1[8], w2[8];
#pragma unroll
        for (int i = 0; i < 8; ++i) { w0[i] = cw[col + i]; w1[i] = cw[ldc + col + i]; w2[i] = cw[2 * ldc + col + i]; }
        u32x4 u1 = (u32x4){0u, 0u, 0u, 0u}, u2 = (u32x4){0u, 0u, 0u, 0u};
        if (r0 > 0) { u1 = *(const u32x4*)(U + (g0 - 1) * ldc + col); u2 = *(const u32x4*)(U + (g0 - 2) * ldc + col); }
#pragma unroll 1
        for (int rb = 0; rb < 16; rb += 4) { u32x4 uu[4], bb[4];
#pragma unroll
            for (int k = 0; k < 4; ++k) { uu[k] = *(const u32x4*)(U + (g0 + rb + k) * ldc + col); bb[k] = *(const u32x4*)(Bg + (g0 + rb + k) * ldc + col); }
#pragma unroll
            for (int k = 0; k < 4; ++k) { float zf[8], gf[8]; u32x4 o;
#pragma unroll
                for (int j = 0; j < 4; ++j) {
                    const float b0 = __uint_as_float(bb[k][j] << 16), b1 = __uint_as_float(bb[k][j] & 0xffff0000u);
                    const float c0 = w0[2 * j] * __uint_as_float(u2[j] << 16) + w1[2 * j] * __uint_as_float(u1[j] << 16) + w2[2 * j] * __uint_as_float(uu[k][j] << 16);
                    const float c1 = w0[2 * j + 1] * __uint_as_float(u2[j] & 0xffff0000u) + w1[2 * j + 1] * __uint_as_float(u1[j] & 0xffff0000u) + w2[2 * j + 1] * __uint_as_float(uu[k][j] & 0xffff0000u);
                    zf[2 * j] = b0 * c0; zf[2 * j + 1] = b1 * c1; gf[2 * j] = b0; gf[2 * j + 1] = b1; o[j] = cvt_pk_bf16(zf[2 * j], zf[2 * j + 1]); }
                *(u32x4*)(Z + (g0 + rb + k) * ldc + col) = o;
                if (seam && r0 + rb + k < 2) { float* p = zp + ((size_t)u.pm * 2 + rb + k) * ldc + col; float* q = bgb + ((size_t)u.pm * 2 + rb + k) * ldc + col;
                    *(f32x4*)p = (f32x4){zf[0], zf[1], zf[2], zf[3]}; *(f32x4*)(p + 4) = (f32x4){zf[4], zf[5], zf[6], zf[7]}; *(f32x4*)q = (f32x4){gf[0], gf[1], gf[2], gf[3]}; *(f32x4*)(q + 4) = (f32x4){gf[4], gf[5], gf[6], gf[7]}; }
                u2 = u1; u1 = uu[k]; } }
    }
};
template <bool GATHER, int K, int nN, int ntok> struct MoeSched {
    static constexpr size_t estride = (size_t)nN * BM * K * 2;
    int G, c; const char* Bt; const PG8_LAS int* tab; const int* list; const PG8_LAS unsigned short* gtok;
    __device__ __forceinline__ bool next(int i, Unit& u) const {
        const int nM = __builtin_amdgcn_readfirstlane(tab[8]); if (!tile_order(i, G, c, nM, nN, u.pm, u.pn)) return false;
        int e = 0;
#pragma unroll
        for (int j = 1; j < 8; ++j) e += (u.pm >= __builtin_amdgcn_readfirstlane(tab[j])) ? 1 : 0;
        u.e = e; u.lrow0 = (u.pm - __builtin_amdgcn_readfirstlane(tab[e])) * BM; u.ui = i; return true;
    }
    __device__ __forceinline__ unsigned a_off(const Unit& u, int r) const {
        if (GATHER) return (unsigned)gtok[u.ui * BM + r] * (unsigned)(K * 2);
        return (unsigned)(u.pm * BM + r) * (unsigned)(K * 2);
    }
    __device__ __forceinline__ const char* b_ptr(const Unit& u) const { return Bt + (size_t)u.e * estride + (size_t)u.pn * BM * K * 2; }
    __device__ __forceinline__ void a_ready(const Unit&) const {}
    __device__ __forceinline__ void done(const Unit&) const {}
    __device__ __forceinline__ void fill_gtok(PG8_LAS unsigned short* g, int max_units) const {
        const int t = (int)threadIdx.x & (BM - 1), par = __builtin_amdgcn_readfirstlane((int)threadIdx.x >> 8);
        for (int i0 = 0; i0 < max_units; i0 += 16) { int v[8]; bool okk[8];
#pragma unroll
            for (int k = 0; k < 8; ++k) { Unit u; const int i = i0 + 2 * k + par; okk[k] = i < max_units && next(i, u); v[k] = 0;
                if (okk[k]) { const int cnt = __builtin_amdgcn_readfirstlane(tab[16 + u.e]); const int lr = u.lrow0 + t; if (lr < cnt) v[k] = list[(size_t)u.e * ntok + lr]; } }
#pragma unroll
            for (int k = 0; k < 8; ++k) if (okk[k]) g[(i0 + 2 * k + par) * BM + t] = (unsigned short)v[k]; }
        __syncthreads();
    }
};

__device__ __forceinline__ unsigned cvt_pk_bf16(float lo, float hi) { unsigned r; asm volatile("v_cvt_pk_bf16_f32 %0, %1, %2" : "=v"(r) : "v"(lo), "v"(hi)); return r; }
__device__ __forceinline__ unsigned pk2h(float lo, float hi) { const f16x2 v = {(_Float16)lo, (_Float16)hi}; return __builtin_bit_cast(unsigned, v); }
__device__ __forceinline__ float h_lo(unsigned w) { return (float)__builtin_bit_cast(f16x2, w)[0]; }
__device__ __forceinline__ float h_hi(unsigned w) { return (float)__builtin_bit_cast(f16x2, w)[1]; }
__device__ __forceinline__ float swiglu_raw(float ag, float au, float c1, float c2) { const float e = __builtin_amdgcn_exp2f(ag * c1); return (ag * au) * __builtin_amdgcn_rcpf(__builtin_fmaf(e, c2, c2)); }
__device__ __forceinline__ float silu_f(float g) { return g * __builtin_amdgcn_rcpf(1.0f + __builtin_amdgcn_exp2f(-1.4426950408889634f * g)); }

template <int ldc, int split_cols> struct EpiBf16 {
    static constexpr bool PERM = true;
    bf16_t* O; size_t split_stride; float scale0;
    unsigned* nrm; int rows_per_batch;
    __device__ __forceinline__ void operator()(const f32x4 (&acc)[2][2][4][2], const Unit& u, int wr, int wc, int fr, int fq) const {
        const int row0 = u.pm * BM + wr * 64 + fr; int colt = u.pn * BM; bf16_t* base = O; int tsel = 0;
        float sc = 1.f; if (split_cols) { const int t = colt / split_cols; tsel = t; base += (size_t)t * split_stride; colt -= t * split_cols; if (t == 0) sc = scale0; }
        const int col0 = colt + wc * 32 + 8 * fq;
        if (nrm && tsel < 2) {
#pragma unroll
            for (int bj = 0; bj < 2; ++bj) { float mx = 0.f;
#pragma unroll
                for (int ai = 0; ai < 2; ++ai)
#pragma unroll
                    for (int m = 0; m < 4; ++m) { const f32x4 v0 = acc[ai][bj][m][0] * sc, v1 = acc[ai][bj][m][1] * sc;
                        float s2 = ((v0[0] * v0[0] + v0[1] * v0[1]) + (v0[2] * v0[2] + v0[3] * v0[3])) + ((v1[0] * v1[0] + v1[1] * v1[1]) + (v1[2] * v1[2] + v1[3] * v1[3]));
                        s2 += __shfl_xor(s2, 16); s2 += __shfl_xor(s2, 32); mx = fmaxf(mx, s2); }
                mx = fmaxf(mx, __shfl_xor(mx, 1)); mx = fmaxf(mx, __shfl_xor(mx, 2)); mx = fmaxf(mx, __shfl_xor(mx, 4)); mx = fmaxf(mx, __shfl_xor(mx, 8));
                const int head = (colt + bj * HALF + wc * 32) >> 6, b = (u.pm * BM) / rows_per_batch;
                if ((fr | fq) == 0) __hip_atomic_fetch_max(nrm + ((tsel * 64 + b * 16 + head) * 2 + (wc & 1)), __float_as_uint(mx), __ATOMIC_RELAXED, __HIP_MEMORY_SCOPE_AGENT); }
        }
#pragma unroll
        for (int ai = 0; ai < 2; ++ai)
#pragma unroll
            for (int m = 0; m < 4; ++m) { bf16_t* rowp = base + (size_t)(row0 + ai * HALF + m * 16) * ldc + col0;
#pragma unroll
                for (int bj = 0; bj < 2; ++bj) { const f32x4 v0 = acc[ai][bj][m][0] * sc, v1 = acc[ai][bj][m][1] * sc;
                    u32x4 w; w.x = cvt_pk_bf16(v0[0], v0[1]); w.y = cvt_pk_bf16(v0[2], v0[3]); w.z = cvt_pk_bf16(v1[0], v1[1]); w.w = cvt_pk_bf16(v1[2], v1[3]);
                    *(u32x4*)(rowp + bj * HALF) = w; } }
    }
};
struct RowScale {
    const float* ss; PG8_LAS float* tab; int last_pm; float inv_n, eps;
    __device__ __forceinline__ void prepare(int pm) {
        if (pm == last_pm) return;
        last_pm = pm;
        const int t = threadIdx.x, row = t >> 1, h = t & 1;
        const f32x4* p = (const f32x4*)(ss + ((size_t)pm * BM + row) * 16 + h * 8);
        const f32x4 a = p[0], b = p[1]; float s = ((a[0] + a[1]) + (a[2] + a[3])) + ((b[0] + b[1]) + (b[2] + b[3]));
        s += __shfl_xor(s, 1);
        asm volatile("s_waitcnt lgkmcnt(0)" ::: "memory"); __builtin_amdgcn_s_barrier(); asm volatile("" ::: "memory");
        if (h == 0) tab[row] = 1.0f / sqrtf(s * inv_n + eps);
        asm volatile("s_waitcnt lgkmcnt(0)" ::: "memory"); __builtin_amdgcn_s_barrier(); asm volatile("" ::: "memory");
    }
    __device__ __forceinline__ float get(int r) const { return tab[r]; }
};
__device__ __forceinline__ unsigned pk4_fp8(float a, float b, float c, float d) { int p = __builtin_amdgcn_cvt_pk_fp8_f32(a, b, 0, false); p = __builtin_amdgcn_cvt_pk_fp8_f32(c, d, p, true); return (unsigned)p; }
constexpr float W8_SCALE = 256.f, H8_SCALE = 4.f;
template <int ldh> struct EpiSwiGLU8 {
    static constexpr bool PERM = true;
    unsigned char* H;
    __device__ __forceinline__ void operator()(const f32x4 (&acc)[2][2][4][2], const Unit& u, int wr, int wc, int fr, int fq) {
        const int row0 = u.pm * BM + wr * 64 + fr + (fq & 1) * 16, col0 = u.pn * HALF + wc * 32 + 16 * (fq >> 1); const float c1 = -1.4426950408889634f / W8_SCALE, c2 = W8_SCALE * W8_SCALE / H8_SCALE;
#pragma unroll
        for (int ai = 0; ai < 2; ++ai)
#pragma unroll
            for (int p = 0; p < 2; ++p) { u32x2 w[2];
#pragma unroll
                for (int q = 0; q < 2; ++q) { const int m = 2 * p + q;
                    const f32x4 g0 = acc[ai][0][m][0], g1 = acc[ai][0][m][1], u0 = acc[ai][1][m][0], u1 = acc[ai][1][m][1];
                    w[q].x = pk4_fp8(swiglu_raw(g0[0], u0[0], c1, c2), swiglu_raw(g0[1], u0[1], c1, c2), swiglu_raw(g0[2], u0[2], c1, c2), swiglu_raw(g0[3], u0[3], c1, c2));
                    w[q].y = pk4_fp8(swiglu_raw(g1[0], u1[0], c1, c2), swiglu_raw(g1[1], u1[1], c1, c2), swiglu_raw(g1[2], u1[2], c1, c2), swiglu_raw(g1[3], u1[3], c1, c2)); }
                const auto r0 = __builtin_amdgcn_permlane16_swap(w[0].x, w[1].x, false, false), r1 = __builtin_amdgcn_permlane16_swap(w[0].y, w[1].y, false, false);
                u32x4 o; o.x = r0[0]; o.y = r1[0]; o.z = r0[1]; o.w = r1[1];
                *(u32x4*)(H + (size_t)(row0 + ai * HALF + p * 32) * ldh + col0) = o; }
    }
};
template <int ldc> struct EpiY8 {
    static constexpr bool PERM = true;
    bf16_t* Y;
    __device__ __forceinline__ void operator()(const f32x4 (&acc)[2][2][4][2], const Unit& u, int wr, int wc, int fr, int fq) {
        const int row0 = u.pm * BM + wr * 64 + fr, col0 = u.pn * BM + wc * 32 + 8 * fq; const float sc = 1.0f / (W8_SCALE * H8_SCALE);
#pragma unroll
        for (int ai = 0; ai < 2; ++ai)
#pragma unroll
            for (int m = 0; m < 4; ++m) { bf16_t* rowp = Y + (size_t)(row0 + ai * HALF + m * 16) * ldc + col0;
#pragma unroll
                for (int bj = 0; bj < 2; ++bj) { const f32x4 v0 = acc[ai][bj][m][0] * sc, v1 = acc[ai][bj][m][1] * sc;
                    u32x4 w; w.x = cvt_pk_bf16(v0[0], v0[1]); w.y = cvt_pk_bf16(v0[2], v0[3]); w.z = cvt_pk_bf16(v1[0], v1[1]); w.w = cvt_pk_bf16(v1[2], v1[3]);
                    *(u32x4*)(rowp + bj * HALF) = w; } }
    }
};
template <int ldh, bool SCALED = false> struct EpiSwiGLU {
    static constexpr bool PERM = true;
    bf16_t* H; RowScale rs;
    __device__ __forceinline__ void operator()(const f32x4 (&acc)[2][2][4][2], const Unit& u, int wr, int wc, int fr, int fq) {
        const int row0 = u.pm * BM + wr * 64 + fr, col0 = u.pn * HALF + wc * 32 + 8 * fq;
        if (SCALED) rs.prepare(u.pm);
#pragma unroll
        for (int ai = 0; ai < 2; ++ai)
#pragma unroll
            for (int m = 0; m < 4; ++m) { bf16_t* rowp = H + (size_t)(row0 + ai * HALF + m * 16) * ldh + col0;
                const float r = SCALED ? rs.get(ai * HALF + wr * 64 + m * 16 + fr) : 1.0f, c1 = -1.4426950408889634f * r, c2 = __builtin_amdgcn_rcpf(r * r);
                const f32x4 g0 = acc[ai][0][m][0], g1 = acc[ai][0][m][1], u0 = acc[ai][1][m][0], u1 = acc[ai][1][m][1];
                u32x4 w; w.x = cvt_pk_bf16(swiglu_raw(g0[0], u0[0], c1, c2), swiglu_raw(g0[1], u0[1], c1, c2)); w.y = cvt_pk_bf16(swiglu_raw(g0[2], u0[2], c1, c2), swiglu_raw(g0[3], u0[3], c1, c2));
                w.z = cvt_pk_bf16(swiglu_raw(g1[0], u1[0], c1, c2), swiglu_raw(g1[1], u1[1], c1, c2)); w.w = cvt_pk_bf16(swiglu_raw(g1[2], u1[2], c1, c2), swiglu_raw(g1[3], u1[3], c1, c2));
                *(u32x4*)rowp = w; }
    }
};
template <int ldc> struct EpiConvIn {
    static constexpr bool PERM = true;
    bf16_t* U; bf16_t* Bg; RowScale rs;
    __device__ __forceinline__ void operator()(const f32x4 (&acc)[2][2][4][2], const Unit& u, int wr, int wc, int fr, int fq) {
        const int row0 = u.pm * BM + wr * 64 + fr;
        rs.prepare(u.pm);
        if (u.pn < 8) {
            const int col0 = u.pn * HALF + wc * 32 + 8 * fq;
#pragma unroll
            for (int ai = 0; ai < 2; ++ai)
#pragma unroll
                for (int m = 0; m < 4; ++m) { bf16_t* rowp = U + (size_t)(row0 + ai * HALF + m * 16) * ldc + col0;
                    const float r = rs.get(ai * HALF + wr * 64 + m * 16 + fr), r2 = r * r;
                    const f32x4 a0 = acc[ai][0][m][0] * acc[ai][1][m][0] * r2, a1 = acc[ai][0][m][1] * acc[ai][1][m][1] * r2;
                    u32x4 w; w.x = cvt_pk_bf16(a0[0], a0[1]); w.y = cvt_pk_bf16(a0[2], a0[3]); w.z = cvt_pk_bf16(a1[0], a1[1]); w.w = cvt_pk_bf16(a1[2], a1[3]);
                    *(u32x4*)rowp = w; }
        } else {
            const int col0 = (u.pn - 8) * BM + wc * 32 + 8 * fq;
#pragma unroll
            for (int ai = 0; ai < 2; ++ai)
#pragma unroll
                for (int m = 0; m < 4; ++m) { bf16_t* rowp = Bg + (size_t)(row0 + ai * HALF + m * 16) * ldc + col0; const float r = rs.get(ai * HALF + wr * 64 + m * 16 + fr);
#pragma unroll
                    for (int bj = 0; bj < 2; ++bj) { const f32x4 v0 = acc[ai][bj][m][0] * r, v1 = acc[ai][bj][m][1] * r;
                        u32x4 w; w.x = cvt_pk_bf16(v0[0], v0[1]); w.y = cvt_pk_bf16(v0[2], v0[3]); w.z = cvt_pk_bf16(v1[0], v1[1]); w.w = cvt_pk_bf16(v1[2], v1[3]);
                        *(u32x4*)(rowp + bj * HALF) = w; } }
        }
    }
};
template <int ldc, bool BASE16, bool STATS> struct EpiResH16 {
    static constexpr bool PERM = true;
    const void* base; unsigned short* hb; float* ss;
    __device__ __forceinline__ void operator()(f32x4 (&acc)[2][2][4][2], const Unit& u, int wr, int wc, int fr, int fq) const {
        const int row0 = u.pm * BM + wr * 64 + fr, col0 = u.pn * BM + wc * 32 + 8 * fq;
#pragma unroll
        for (int ai = 0; ai < 2; ++ai) { f32x4 pre[4][2][2];
#pragma unroll
            for (int m = 0; m < 4; ++m)
#pragma unroll
                for (int bj = 0; bj < 2; ++bj) { const size_t off = (size_t)(row0 + ai * HALF + m * 16) * ldc + col0 + bj * HALF;
                    if (BASE16) pre[m][bj][0] = __builtin_bit_cast(f32x4, *(const u32x4*)((const unsigned short*)base + off));
                    else { pre[m][bj][0] = *(const f32x4*)((const float*)base + off); pre[m][bj][1] = *(const f32x4*)((const float*)base + off + 4); } }
            asm volatile("s_waitcnt vmcnt(0)" ::: "memory");
#pragma unroll
            for (int m = 0; m < 4; ++m) { const int row = row0 + ai * HALF + m * 16; const size_t off = (size_t)row * ldc + col0; float s = 0.f;
#pragma unroll
                for (int bj = 0; bj < 2; ++bj) { f32x4 b0, b1;
                    if (BASE16) { const u32x4 w = __builtin_bit_cast(u32x4, pre[m][bj][0]); b0 = (f32x4){h_lo(w.x), h_hi(w.x), h_lo(w.y), h_hi(w.y)}; b1 = (f32x4){h_lo(w.z), h_hi(w.z), h_lo(w.w), h_hi(w.w)}; }
                    else { b0 = pre[m][bj][0]; b1 = pre[m][bj][1]; }
                    const f32x4 v0 = b0 + acc[ai][bj][m][0], v1 = b1 + acc[ai][bj][m][1];
                    if (STATS) s += ((v0[0] * v0[0] + v0[1] * v0[1]) + (v0[2] * v0[2] + v0[3] * v0[3])) + ((v1[0] * v1[0] + v1[1] * v1[1]) + (v1[2] * v1[2] + v1[3] * v1[3]));
                    u32x4 w; w.x = pk2h(v0[0], v0[1]); w.y = pk2h(v0[2], v0[3]); w.z = pk2h(v1[0], v1[1]); w.w = pk2h(v1[2], v1[3]);
                    *(u32x4*)(hb + off + bj * HALF) = w; }
                if (STATS) { s += __shfl_xor(s, 16); s += __shfl_xor(s, 32); if (fq == 0) ss[(size_t)row * 16 + u.pn * 4 + wc] = s; } }
            asm volatile("" ::: "memory"); }
    }
};
template <int ldc, int ntok> struct EpiMoeDown {
    static constexpr bool PERM = false;
    float* out; const int* list; const float* glist; const PG8_LAS int* tab;
    __device__ __forceinline__ void operator()(const f32x4 (&acc)[2][2][4][2], const Unit& u, int wr, int wc, int fr, int fq) const {
        const int col0 = u.pn * BM + wc * 32 + 4 * fq, cnt = __builtin_amdgcn_readfirstlane(tab[16 + u.e]); const size_t lb = (size_t)u.e * ntok;
#pragma unroll
        for (int ai = 0; ai < 2; ++ai)
#pragma unroll
            for (int m = 0; m < 4; ++m) { const int lr = u.lrow0 + ai * HALF + wr * 64 + m * 16 + fr;
                if (lr < cnt) { const int tok = list[lb + lr]; const float g = glist[lb + lr]; const size_t off = (size_t)tok * ldc + col0;
#pragma unroll
                    for (int bj = 0; bj < 2; ++bj)
#pragma unroll
                        for (int n = 0; n < 2; ++n) { const f32x4 b = *(const f32x4*)(out + off + bj * HALF + n * 16); *(f32x4*)(out + off + bj * HALF + n * 16) = b + acc[ai][bj][m][n] * g; } }
                asm volatile("" ::: "memory"); }
    }
};

template <int K, class Epi, class Sched, bool ALIGN_EPI = false, bool SP2 = false, int DT = 0>
__device__ __forceinline__ void gemm_phase(PG8_LAS unsigned char* lds, const char* Abase, const Sched& S, Epi& E) {
    constexpr bool FP8 = (DT == 1);
    const int tid = threadIdx.x, wid = __builtin_amdgcn_readfirstlane(tid >> 6), lane = tid & 63, wr = wid >> 2, wc = wid & 3, fr = lane & 15, fq = lane >> 4;
    constexpr int nt = K / BK; static_assert(K % (2 * BK) == 0 && K >= 4 * BK, "K: a multiple of 128, at least 256");
    int RA[2]; unsigned cofA[2], voffB[2];
#pragma unroll
    for (int i = 0; i < 2; ++i) { int R, C; stage_rc(tid * 16 + i * 8192, R, C); const int Rb = Epi::PERM ? ((R & ~31) + perm32(R & 31)) : R;
        RA[i] = R; cofA[i] = (unsigned)C * 2u; voffB[i] = (unsigned)(Rb * K + C) * 2u; }
    const size_t kstep = (size_t)(BK * 2);
    const size_t hstep = (size_t)HALF * K * 2;
    const unsigned ldsw = (unsigned)wid * 1024u;
    const int aoff = lds_byte(wr * 64 + fr, fq * 8), boff = lds_byte(wc * 32 + fr, fq * 8);
#define PG8_SA(b, h) (((b) * 2 + (h)) * HTB)
#define PG8_SB(b, h) ((4 + (b) * 2 + (h)) * HTB)
#define PG8_STAGE(bufoff, gbase, voff) do { _Pragma("unroll") for (int _i = 0; _i < 2; ++_i) \
        __builtin_amdgcn_global_load_lds((const unsigned*)((const char*)(gbase) + (voff)[_i]), (PG8_LAS unsigned*)(lds + (bufoff) + ldsw + _i * 8192), 16, 0, 0); } while (0)
#define PG8_LD16(off) (*(const PG8_LAS i32x4*)(lds + (off)))
#define PG8_LDA(dst, b, h) do { _Pragma("unroll") for (int m = 0; m < 4; ++m) { const i32x4 lo_ = PG8_LD16(PG8_SA(b, h) + aoff + m * 2048), hi_ = PG8_LD16(PG8_SA(b, h) + aoff + m * 2048 + 1024); \
        if constexpr (FP8) dst##8[m] = __builtin_shufflevector(lo_, hi_, 0, 1, 2, 3, 4, 5, 6, 7); else { dst[m][0] = __builtin_bit_cast(bf16x8, lo_); dst[m][1] = __builtin_bit_cast(bf16x8, hi_); } } } while (0)
#define PG8_LDB(dst, b, h) do { _Pragma("unroll") for (int n = 0; n < 2; ++n) { const i32x4 lo_ = PG8_LD16(PG8_SB(b, h) + boff + n * 2048), hi_ = PG8_LD16(PG8_SB(b, h) + boff + n * 2048 + 1024); \
        if constexpr (FP8) dst##8[n] = __builtin_shufflevector(lo_, hi_, 0, 1, 2, 3, 4, 5, 6, 7); else { dst[n][0] = __builtin_bit_cast(bf16x8, lo_); dst[n][1] = __builtin_bit_cast(bf16x8, hi_); } } } while (0)
#define PG8_MFMA_ASM(OP, ACC, B_, A_, Z) do { if constexpr (Z) asm volatile(OP " %0, %1, %2, 0" : "=&v"(ACC) : "v"(B_), "v"(A_)); else asm volatile(OP " %0, %1, %2, %0" : "+v"(ACC) : "v"(B_), "v"(A_)); } while (0)
#define PG8_MMA(ai, bj, At, Bt, Z) do { __builtin_amdgcn_s_setprio(1); \
        if constexpr (FP8) { _Pragma("unroll") for (int m = 0; m < 4; ++m) _Pragma("unroll") for (int n = 0; n < 2; ++n) PG8_MFMA_ASM("v_mfma_f32_16x16x128_f8f6f4", acc[ai][bj][m][n], Bt##8[n], At##8[m], Z); } \
        else if constexpr (DT == 2) { _Pragma("unroll") for (int m = 0; m < 4; ++m) _Pragma("unroll") for (int n = 0; n < 2; ++n) PG8_MFMA_ASM("v_mfma_f32_16x16x32_f16", acc[ai][bj][m][n], Bt[n][0], At[m][0], Z); \
                                      _Pragma("unroll") for (int m = 0; m < 4; ++m) _Pragma("unroll") for (int n = 0; n < 2; ++n) PG8_MFMA_ASM("v_mfma_f32_16x16x32_f16", acc[ai][bj][m][n], Bt[n][1], At[m][1], false); } \
        else { _Pragma("unroll") for (int m = 0; m < 4; ++m) _Pragma("unroll") for (int n = 0; n < 2; ++n) PG8_MFMA_ASM("v_mfma_f32_16x16x32_bf16", acc[ai][bj][m][n], Bt[n][0], At[m][0], Z); \
               _Pragma("unroll") for (int m = 0; m < 4; ++m) _Pragma("unroll") for (int n = 0; n < 2; ++n) PG8_MFMA_ASM("v_mfma_f32_16x16x32_bf16", acc[ai][bj][m][n], Bt[n][1], At[m][1], false); } \
        __builtin_amdgcn_s_setprio(0); } while (0)
#define PG8_WAIT_V(n) asm volatile("s_waitcnt vmcnt(" #n ")" ::: "memory")
#define PG8_WAIT_L(n) asm volatile("s_waitcnt lgkmcnt(" #n ")" ::: "memory")
#define PG8_BAR __builtin_amdgcn_s_barrier()
#define PG8_SCHED __builtin_amdgcn_sched_barrier(0)
    Unit cur, nxt; int ui = 0;
    if (!S.next(0, cur)) return;
    f32x4 acc[2][2][4][2];
    bf16x8 At[4][2], B0[2][2], B1[2][2]; i32x8 At8[4], B08[2], B18[2];
    unsigned c0[2], c1[2], n0[2], n1[2];
#pragma unroll
    for (int i = 0; i < 2; ++i) { c0[i] = S.a_off(cur, RA[i]) + cofA[i]; c1[i] = S.a_off(cur, HALF + RA[i]) + cofA[i]; }
    const char* cB = S.b_ptr(cur);
    S.a_ready(cur);
    if constexpr (SP2) {
        PG8_STAGE(PG8_SB(0, 0), cB, voffB); PG8_STAGE(PG8_SB(0, 1), cB + hstep, voffB); PG8_STAGE(PG8_SA(0, 0), Abase, c0); PG8_STAGE(PG8_SA(0, 1), Abase, c1);
        PG8_STAGE(PG8_SB(1, 0), cB + kstep, voffB); PG8_STAGE(PG8_SA(1, 0), Abase + kstep, c0); PG8_STAGE(PG8_SB(1, 1), cB + hstep + kstep, voffB);
        if (wr == 1) PG8_BAR;
        PG8_WAIT_V(6); PG8_BAR;
        PG8_BAR;
    } else {
        PG8_STAGE(PG8_SB(0, 0), cB, voffB); PG8_STAGE(PG8_SA(0, 0), Abase, c0); PG8_STAGE(PG8_SB(0, 1), cB + hstep, voffB); PG8_STAGE(PG8_SA(0, 1), Abase, c1);
        if (wr == 1) PG8_BAR;
        PG8_WAIT_V(4); PG8_BAR;
        PG8_STAGE(PG8_SB(1, 0), cB + kstep, voffB); PG8_STAGE(PG8_SA(1, 0), Abase + kstep, c0); PG8_STAGE(PG8_SB(1, 1), cB + hstep + kstep, voffB);
        PG8_WAIT_V(6); PG8_BAR;
    }
    for (;;) {
        const bool has_next = S.next(ui + 1, nxt);
        const char* nB = cB;
#pragma unroll
        for (int i = 0; i < 2; ++i) { n0[i] = c0[i]; n1[i] = c1[i]; }
        if (has_next) { nB = S.b_ptr(nxt);
#pragma unroll
            for (int i = 0; i < 2; ++i) { n0[i] = S.a_off(nxt, RA[i]) + cofA[i]; n1[i] = S.a_off(nxt, HALF + RA[i]) + cofA[i]; } }
        static_assert(SP2, "only the two-blocks-per-barrier-pair schedule is kept");
#define PG8_ITER(T_, Z_) do { const int t = (T_); const bool last = (t == nt - 2); \
            const char* a1 = Abase + (size_t)(t + 1) * kstep;                                            \
            const char* a2 = last ? Abase : Abase + (size_t)(t + 2) * kstep; const char* b2 = last ? nB : cB + (size_t)(t + 2) * kstep;     \
            const char* a3 = a2 + kstep; const char* b3 = b2 + kstep;                                    \
            unsigned x0[2], x1[2];                                                                       \
            _Pragma("unroll") for (int i = 0; i < 2; ++i) { x0[i] = last ? n0[i] : c0[i]; x1[i] = last ? n1[i] : c1[i]; } \
            if (last && has_next) S.a_ready(nxt); \
            PG8_LDB(B0, 0, 0); PG8_LDB(B1, 0, 1); PG8_SCHED; PG8_LDA(At, 0, 0); PG8_STAGE(PG8_SA(1, 1), a1, c1); \
            PG8_WAIT_V(8); PG8_WAIT_L(0); PG8_BAR; PG8_MMA(0, 0, At, B0, Z_); PG8_MMA(0, 1, At, B1, Z_); PG8_BAR; PG8_SCHED; \
            PG8_LDA(At, 0, 1); PG8_STAGE(PG8_SB(0, 0), b2, voffB); PG8_STAGE(PG8_SB(0, 1), b2 + hstep, voffB); PG8_STAGE(PG8_SA(0, 0), a2, x0); \
            PG8_WAIT_V(8); PG8_WAIT_L(0); PG8_BAR; PG8_MMA(1, 0, At, B0, Z_); PG8_MMA(1, 1, At, B1, Z_); PG8_BAR; PG8_SCHED; \
            PG8_LDB(B0, 1, 0); PG8_LDB(B1, 1, 1); PG8_SCHED; PG8_LDA(At, 1, 0); PG8_STAGE(PG8_SA(0, 1), a2, x1); \
            PG8_WAIT_V(8); PG8_WAIT_L(0); PG8_BAR; PG8_MMA(0, 0, At, B0, false); PG8_MMA(0, 1, At, B1, false); PG8_BAR; PG8_SCHED; \
            PG8_LDA(At, 1, 1); PG8_STAGE(PG8_SB(1, 0), b3, voffB); PG8_STAGE(PG8_SB(1, 1), b3 + hstep, voffB); PG8_STAGE(PG8_SA(1, 0), a3, x0); \
            PG8_WAIT_V(8); PG8_WAIT_L(0); PG8_BAR; PG8_MMA(1, 0, At, B0, false); PG8_MMA(1, 1, At, B1, false); PG8_BAR; PG8_SCHED; } while (0)
        PG8_ITER(0, true);
#pragma unroll 1
        for (int tt = 2; tt < nt; tt += 2) PG8_ITER(tt, false);
#undef PG8_ITER
        if constexpr (ALIGN_EPI) { if (wr == 0) PG8_BAR; }
        asm volatile("s_nop 15\n\ts_nop 15" ::: "memory");
        E(acc, cur, wr, wc, fr, fq); S.done(cur);
        if (!has_next) break;
        cur = nxt; cB = nB; ++ui;
#pragma unroll
        for (int i = 0; i < 2; ++i) { c0[i] = n0[i]; c1[i] = n1[i]; }
        if constexpr (ALIGN_EPI) { if (wr == 1) PG8_BAR; }
    }
    PG8_WAIT_V(0);
    if constexpr (!ALIGN_EPI) { if (wr == 0) PG8_BAR; }
    PG8_BAR;
#undef PG8_SA
#undef PG8_SB
#undef PG8_STAGE
#undef PG8_LDA
#undef PG8_LDB
#undef PG8_MMA
#undef PG8_MFMA_ASM
#undef PG8_LD16
#undef PG8_WAIT_V
#undef PG8_WAIT_L
#undef PG8_BAR
#undef PG8_SCHED
}
}
#include <hip/hip_bf16.h>
#include <cmath>
namespace attn_body {
using bf16=__hip_bfloat16;
using bf16x8=__attribute__((ext_vector_type(8)))short;
using s16x4=__attribute__((ext_vector_type(4)))short;
using f32x16=__attribute__((ext_vector_type(16)))float;
using u32x4=__attribute__((ext_vector_type(4)))unsigned;
using f32x4_t=__attribute__((ext_vector_type(4)))float;
constexpr int BATCH=4,NHEAD=16,SEQ=8192,D=64,DM=NHEAD*D;
constexpr int NW=8,QBLK=32,QB=QBLK*NW,KVBLK=64,NQB=SEQ/QB;
constexpr int ATTN_PITCH=DM, ATTN_UNIT_ROWS=QB;
__device__ __forceinline__ int crow(int r,int hi){return (r&3)+8*(r>>2)+4*hi;}
#define SBAR() __builtin_amdgcn_sched_barrier(0)
__device__ __forceinline__ void cmask(f32x16&p0,f32x16&p1,int jb,int qrel,int hi){
  const float NEG=-INFINITY; int kb=64*jb+4*hi;
  #pragma unroll
  for(int r=0;r<16;++r){int kv=kb+(r&3)+8*(r>>2); if(kv>qrel)p0[r]=NEG; if(kv+32>qrel)p1[r]=NEG;}
}

constexpr int NSLOT=3, SLOTB=8192;
constexpr int LDS_K=0, LDS_V=NSLOT*SLOTB, LDS_WS=2*NSLOT*SLOTB, LDS_OST=LDS_WS+NW*64*4, LDS_CB=LDS_OST+NW*4096, LDS_Q=LDS_CB+SEQ*4, LDS_OK=LDS_Q+16, LDS_BYTES=LDS_OK+48;
constexpr float C2=0.125f*1.4426950408889634f;
__device__ __forceinline__ void glds16(const void*gsrc,unsigned lds_dst){unsigned keep;
  asm volatile("s_mov_b32 %0, m0\n\ts_mov_b32 m0, %2\n\ts_nop 0\n\tglobal_load_lds_dwordx4 %1, off\n\ts_mov_b32 m0, %0":"=&s"(keep):"v"(gsrc),"s"(lds_dst):"memory");}
__device__ __forceinline__ float max3f(float a,float b,float c){float r;asm("v_max3_f32 %0, %1, %2, %3":"=v"(r):"v"(a),"v"(b),"v"(c));return r;}
__device__ __forceinline__ float max2f(float a,float b){float r;asm("v_max_f32_e32 %0, %1, %2":"=v"(r):"v"(a),"v"(b));return r;}
__device__ __forceinline__ float fadd_s(float a,float b){float r;asm("v_add_f32_e32 %0, %1, %2":"=v"(r):"v"(a),"v"(b));return r;}
__device__ __forceinline__ float fsub_s(float a,float b){float r;asm("v_sub_f32_e32 %0, %1, %2":"=v"(r):"v"(a),"v"(b));return r;}
typedef float f32x2_t __attribute__((ext_vector_type(2))); typedef __bf16 bf16x2_t __attribute__((ext_vector_type(2)));
__device__ __forceinline__ unsigned cvtpk_s(float lo,float hi){f32x2_t v={lo,hi};bf16x2_t b=__builtin_convertvector(v,bf16x2_t);return __builtin_bit_cast(unsigned,b);}
#define WAIT_BAR(N) asm volatile("s_waitcnt vmcnt(" #N ") lgkmcnt(0)\n\ts_barrier":::"memory")

__device__ __forceinline__ void qkt(f32x16&p0,f32x16&p1,const char*Kslot,const bf16x8*qr,int r32,int hi){
  const char*kb=Kslot+hi*1024+r32*16;
  #pragma unroll
  for(int d0=0;d0<4;++d0){
    const bf16x8 b0=*reinterpret_cast<const bf16x8*>(kb+d0*2048);
    const bf16x8 b1=*reinterpret_cast<const bf16x8*>(kb+d0*2048+512);
    p0=__builtin_amdgcn_mfma_f32_32x32x16_bf16(b0,qr[d0],p0,0,0,0);p1=__builtin_amdgcn_mfma_f32_32x32x16_bf16(b1,qr[d0],p1,0,0,0);}
}
typedef __attribute__((address_space(3))) const char* lds_cptr;
typedef short v4i16_t __attribute__((ext_vector_type(4)));
__device__ __forceinline__ void kload8(bf16x8*kf,lds_cptr kp){
  kf[0]=*(const __attribute__((address_space(3))) bf16x8*)(kp);      kf[1]=*(const __attribute__((address_space(3))) bf16x8*)(kp+512);
  kf[2]=*(const __attribute__((address_space(3))) bf16x8*)(kp+2048); kf[3]=*(const __attribute__((address_space(3))) bf16x8*)(kp+2560);
  kf[4]=*(const __attribute__((address_space(3))) bf16x8*)(kp+4096); kf[5]=*(const __attribute__((address_space(3))) bf16x8*)(kp+4608);
  kf[6]=*(const __attribute__((address_space(3))) bf16x8*)(kp+6144); kf[7]=*(const __attribute__((address_space(3))) bf16x8*)(kp+6656);
}
__device__ __forceinline__ void kload2(bf16x8*kf,lds_cptr kp,int j){ kf[2*j]=*(const __attribute__((address_space(3))) bf16x8*)(kp+j*2048); kf[2*j+1]=*(const __attribute__((address_space(3))) bf16x8*)(kp+j*2048+512); }
__device__ __forceinline__ s16x4 vtr(lds_cptr p){ return __builtin_bit_cast(s16x4,__builtin_amdgcn_ds_read_tr16_b64_v4i16((__attribute__((address_space(3))) v4i16_t*)p)); }
__device__ __forceinline__ float rowmax(const f32x16&p0,const f32x16&p1){
  float a=max3f(p0[0],p0[1],p1[0]),b=max3f(p0[2],p0[3],p1[1]);a=max3f(a,p1[2],p1[3]);
  #pragma unroll
  for(int r=4;r<16;r+=4){a=max3f(a,p0[r],p0[r+1]);b=max3f(b,p0[r+2],p0[r+3]);a=max3f(a,p1[r],p1[r+1]);b=max3f(b,p1[r+2],p1[r+3]);}
  const float m=max2f(a,b);
  auto rr=__builtin_amdgcn_permlane32_swap(__float_as_uint(m),__float_as_uint(m),false,false);
  return max2f(__uint_as_float(rr[0]),__uint_as_float(rr[1]));
}
__device__ __forceinline__ void pv(f32x16*o,int vb,bf16x8 pa0,bf16x8 pa1,bf16x8 pa2,bf16x8 pa3){
  #pragma unroll
  for(int d0=0;d0<2;++d0){s16x4 lo[4],hi[4];
    #pragma unroll
    for(int ks=0;ks<4;++ks){
      asm volatile("ds_read_b64_tr_b16 %0,%1 offset:%c2":"=&v"(lo[ks]):"v"(vb),"i"(d0*4096+ks*1024):"memory");
      asm volatile("ds_read_b64_tr_b16 %0,%1 offset:%c2":"=&v"(hi[ks]):"v"(vb),"i"(d0*4096+ks*1024+512):"memory");}
    asm volatile("s_waitcnt lgkmcnt(0)":::"memory");SBAR();
    #define PK(k) (bf16x8){lo[k][0],lo[k][1],lo[k][2],lo[k][3],hi[k][0],hi[k][1],hi[k][2],hi[k][3]}
    o[d0]=__builtin_amdgcn_mfma_f32_32x32x16_bf16(pa0,PK(0),o[d0],0,0,0);
    o[d0]=__builtin_amdgcn_mfma_f32_32x32x16_bf16(pa1,PK(1),o[d0],0,0,0);
    o[d0]=__builtin_amdgcn_mfma_f32_32x32x16_bf16(pa2,PK(2),o[d0],0,0,0);
    o[d0]=__builtin_amdgcn_mfma_f32_32x32x16_bf16(pa3,PK(3),o[d0],0,0,0);
    #undef PK
  }
}

#ifndef ATTN_STORE16
#define ATTN_STORE16(p,v) (*(u32x4*)(p)=(v))
#endif
constexpr float GUARD_B=96.f;
constexpr float SKIP_TH=200.f, SKIP_MARGIN=42.f, SKIP_G=10.f, SKIP_LMIN=0.0009765625f  ;
template<int THRL> __device__ __forceinline__ bool attn_unit(int b,int h,int qb,int t0s,bool guard,f32x4_t cbv0,f32x4_t cbv1,f32x4_t cbv2,f32x4_t cbv3,unsigned*tctr,bool redo,unsigned&nraw,const bf16*Q,const bf16*__restrict__ K,const bf16*__restrict__ V,bf16*O,const float*Cb,char*shm){
  int tid_=threadIdx.x; asm volatile("":"+v"(tid_));
  const int tid=tid_,lane=tid&63,r32=lane&31,hi=lane>>5; const int wid=__builtin_amdgcn_readfirstlane(tid>>6);
  const long rowbase=(long)b*SEQ; const int q0=qb*QB;
  const bf16*Qw=Q+(rowbase+q0+wid*QBLK)*DM+h*D;
  const bf16*Kh=K+(rowbase+(long)t0s*KVBLK)*DM+h*D,*Vh=V+(rowbase+(long)t0s*KVBLK)*DM+h*D;
  const unsigned lds0=(unsigned)(uintptr_t)shm;
  float*wsf=(float*)(shm+LDS_WS)+wid*64;
  const bf16*ksrc=Kh+(long)lane*DM+wid*8;
  const bf16*vsrc=Vh+(long)(16*(wid&3)+(lane>>2))*DM+(wid>>2)*32+(lane&3)*8;
  const unsigned kdst=lds0+LDS_K+wid*1024, vdst=lds0+LDS_V+wid*1024;
  #define DMA_K(t,slot) glds16(ksrc+(long)(t)*KVBLK*DM,(unsigned)__builtin_amdgcn_readfirstlane(kdst+(slot)))
  #define DMA_V(t,slot) glds16(vsrc+(long)(t)*KVBLK*DM,(unsigned)__builtin_amdgcn_readfirstlane(vdst+(slot)))
  const int vb0=(int)(lds0+LDS_V)+((lane>>4)&1)*32+(lane&3)*8+(4*hi+((lane&15)>>2))*64;
  const char*Kbase=shm+LDS_K; bf16x8 kf[8];
  const lds_cptr shm3=(lds_cptr)shm; const lds_cptr kp0=shm3+LDS_K+hi*1024+r32*16; const lds_cptr vp0=shm3+LDS_V+((lane>>4)&1)*32+(lane&3)*8+(4*hi+((lane&15)>>2))*64;
  const int NT=(q0+QB)/KVBLK-t0s;
  typedef __attribute__((address_space(3))) f32x4_t* lds_f4ptr; typedef __attribute__((address_space(3))) const f32x4_t* lds_cf4ptr;
  { const int n4=(q0+QB)/4; lds_f4ptr cl=(lds_f4ptr)((lds_cptr)shm+LDS_CB);
    if(tid<n4)cl[tid]=cbv0; if(tid+512<n4)cl[tid+512]=cbv1; if(tid+1024<n4)cl[tid+1024]=cbv2; if(tid+1536<n4)cl[tid+1536]=cbv3; }
  const lds_cf4ptr cbp=(lds_cf4ptr)((lds_cptr)shm+LDS_CB)+hi+16*t0s;
  #define CI4(PX,t_,g_,o_,nm_) do{ const f32x4_t z_=cbp[16*(t_)+(o_)+2*(g_)]; PX[4*(g_)]=(nm_)-z_.x; PX[4*(g_)+1]=(nm_)-z_.y; PX[4*(g_)+2]=(nm_)-z_.z; PX[4*(g_)+3]=(nm_)-z_.w; }while(0)
  #define CI16(PX,t_,o_,nm_) do{ CI4(PX,t_,0,o_,nm_); CI4(PX,t_,1,o_,nm_); CI4(PX,t_,2,o_,nm_); CI4(PX,t_,3,o_,nm_); }while(0)
  DMA_K(0,0);DMA_V(0,0);DMA_K(1,SLOTB);
  bf16x8 qr[4];
  #pragma unroll
  for(int d0=0;d0<4;++d0)qr[d0]=*reinterpret_cast<const bf16x8*>(&Qw[(long)r32*DM+d0*16+hi*8]);
  float mhat=0.f,l_reg=0.f;f32x16 o[2];o[0]=f32x16{};o[1]=f32x16{};
  const int qrel=wid*QBLK+r32;
  #define CMASK(P0,P1,t) do{int jb_=(t)-(NT-4); if(jb_>=0)cmask(P0,P1,jb_,qrel,hi);}while(0)
  bool resc=false;
  #define START(P0,P1) do{ const float rm=rowmax(P0,P1); resc=false; \
    if(__builtin_expect(__any(rm>(float)THRL),0)){ const float dl=__builtin_fmaxf(rm,0.f); mhat=fadd_s(mhat,dl); \
      _Pragma("unroll") for(int r=0;r<16;++r){P0[r]=fsub_s(P0[r],dl);P1[r]=fsub_s(P1[r],dl);} } \
    _Pragma("unroll") for(int r=0;r<16;++r)P0[r]=__builtin_amdgcn_exp2f(P0[r]); }while(0)
  #define RESC() do{ if(resc){ asm volatile("s_waitcnt lgkmcnt(0)":::"memory"); \
      _Pragma("unroll") for(int d_=0;d_<2;++d_) _Pragma("unroll") for(int r=0;r<16;++r)o[d_][r]*=wsf[crow(r,hi)]; } }while(0)
  f32x16 pA0,pA1,pB0,pB1;
  int sl_prev=0,sl_cur=0,sl_next=SLOTB;
  #define ROT() do{sl_prev=sl_cur;sl_cur=sl_next;sl_next=(sl_next==(NSLOT-1)*SLOTB)?0:sl_next+SLOTB;}while(0)
  DMA_K(2,2*SLOTB);
  if(!redo&&tid==0)nraw=__hip_atomic_fetch_add(tctr,1u,__ATOMIC_RELAXED,__HIP_MEMORY_SCOPE_AGENT);
  WAIT_BAR(3);
  const float qb2=*((const __attribute__((address_space(3))) float*)((lds_cptr)shm+LDS_CB)+q0+qrel);
  CI16(pA0,0,0,qb2); CI16(pA1,0,8,qb2);
  qkt(pA0,pA1,Kbase,qr,r32,hi);asm volatile("s_nop 15\n\ts_nop 7":"+v"(pA0),"+v"(pA1));CMASK(pA0,pA1,0);
  START(pA0,pA1);
  _Pragma("unroll") for(int r=0;r<16;++r)pA1[r]=__builtin_amdgcn_exp2f(pA1[r]);
  WAIT_BAR(0);
  if(tid==0)*((volatile __attribute__((address_space(3))) unsigned*)((lds_cptr)shm+LDS_Q)+1)=nraw;
  DMA_K(3,0);DMA_V(1,SLOTB);
  ROT();
  kload8(kf,kp0+sl_cur);
  WAIT_BAR(2);
  s16x4 vlo[8],vhi[8]; u32x4 pw0,pw1,pw2,pw3;
  #define PKW(P,B) cvtpk_s(P[B],P[B+1])
  #define PAF(k) __builtin_bit_cast(bf16x8,pw##k)
  #define VFR(i) (bf16x8){vlo[i][0],vlo[i][1],vlo[i][2],vlo[i][3],vhi[i][0],vhi[i][1],vhi[i][2],vhi[i][3]}
  #define PIN(x) asm volatile("":"+v"(x))
  #define MX3(a,b,c) __builtin_fmaxf(__builtin_fmaxf((a),(b)),(c))
  #define GAPA(MF,A0,A1,A2,A3,W0,W1,PW) do{ MF; sacc+=A0; sacc+=A1; sacc+=A2; sacc+=A3; PIN(sacc); W0; W1; PIN(PW); SBAR(); }while(0)
  #define EX(v) __builtin_amdgcn_exp2f(v)
  #define GAPB(MF,X,B,GI,PX,tn_,g_,o_) do{ MF; X[B]=EX(X[B]); X[B+1]=EX(X[B+1]); X[B+2]=EX(X[B+2]); X[B+3]=EX(X[B+3]); PIN(X); SBAR(); }while(0)
  #define VRD(i) do{ vlo[i]=vtr(vp_+(((i)>>2)*4096+((i)&3)*1024)); vhi[i]=vtr(vp_+(((i)>>2)*4096+((i)&3)*1024+512)); }while(0)
  #define KRD(G,j) do{ if(G){ kload2(kf,kp0+sl_next,j); SBAR(); } }while(0)
  #define STEP(C0,C1,P0,P1,t,GK,GV,GL,GI) do{ SBAR(); const float nm1_=qb2-mhat; CI16(C0,t,0,nm1_); SBAR(); \
    const lds_cptr vp_=vp0+sl_prev; \
    VRD(0); SBAR(); float sacc=(P0[0]+P0[1]); \
    GAPA(C0=__builtin_amdgcn_mfma_f32_32x32x16_bf16(kf[0],qr[0],C0,0,0,0), P0[2],P0[3],P0[4],P0[5],     pw0[0]=PKW(P0,0), pw0[1]=PKW(P0,2), pw0); \
    CI16(C1,t,8,nm1_); PIN(C1); SBAR(); \
    VRD(4); SBAR(); GAPA(C1=__builtin_amdgcn_mfma_f32_32x32x16_bf16(kf[1],qr[0],C1,0,0,0), P0[6],P0[7],P0[8],P0[9],     pw0[2]=PKW(P0,4), pw0[3]=PKW(P0,6), pw0); \
    VRD(1); SBAR(); GAPA(C0=__builtin_amdgcn_mfma_f32_32x32x16_bf16(kf[2],qr[1],C0,0,0,0),   P0[10],P0[11],P0[12],P0[13], pw1[0]=PKW(P0,8), pw1[1]=PKW(P0,10), pw1); \
    VRD(5); SBAR(); GAPA(C1=__builtin_amdgcn_mfma_f32_32x32x16_bf16(kf[3],qr[1],C1,0,0,0),   P0[14],P0[15],P1[0],P1[1],   pw1[2]=PKW(P0,12),pw1[3]=PKW(P0,14), pw1); \
    VRD(2); SBAR(); GAPA(C0=__builtin_amdgcn_mfma_f32_32x32x16_bf16(kf[4],qr[2],C0,0,0,0),   P1[2],P1[3],P1[4],P1[5],     pw2[0]=PKW(P1,0), pw2[1]=PKW(P1,2), pw2); \
    VRD(6); SBAR(); GAPA(C1=__builtin_amdgcn_mfma_f32_32x32x16_bf16(kf[5],qr[2],C1,0,0,0),   P1[6],P1[7],P1[8],P1[9],     pw2[2]=PKW(P1,4), pw2[3]=PKW(P1,6), pw2); \
    VRD(3); SBAR(); GAPA(C0=__builtin_amdgcn_mfma_f32_32x32x16_bf16(kf[6],qr[3],C0,0,0,0),   P1[10],P1[11],P1[12],P1[13], pw3[0]=PKW(P1,8), pw3[1]=PKW(P1,10), pw3); \
    VRD(7); SBAR(); GAPA(C1=__builtin_amdgcn_mfma_f32_32x32x16_bf16(kf[7],qr[3],C1,0,0,0),   P1[14],P1[15],0.f,0.f,       pw3[2]=PKW(P1,12),pw3[3]=PKW(P1,14), pw3); \
    l_reg+=sacc; \
    if(GK){DMA_K((t)+3,sl_cur);} if(GV){DMA_V((t)+1,sl_next);} \
    CMASK(C0,C1,t); \
    resc=false; \
    if(guard){ float a=MX3(C0[0],C0[1],C1[0]),b=MX3(C0[2],C0[3],C1[1]); a=MX3(a,C1[2],C1[3]); \
      _Pragma("unroll") for(int r=4;r<16;r+=4){a=MX3(a,C0[r],C0[r+1]);b=MX3(b,C0[r+2],C0[r+3]);a=MX3(a,C1[r],C1[r+1]);b=MX3(b,C1[r+2],C1[r+3]);} \
      float rm=__builtin_fmaxf(a,b); { auto rr=__builtin_amdgcn_permlane32_swap(__float_as_uint(rm),__float_as_uint(rm),false,false); rm=__builtin_fmaxf(__uint_as_float(rr[0]),__uint_as_float(rr[1])); } \
      if(__builtin_expect(__any(rm>(float)THRL),0)){ const float dl=__builtin_fmaxf(rm,0.f); mhat+=dl; \
        _Pragma("unroll") for(int r=0;r<16;++r){C0[r]-=dl;C1[r]-=dl;} \
        const float f=__builtin_amdgcn_exp2f(-dl); l_reg*=f; if(hi==0)wsf[r32]=f; resc=true; } } \
    SBAR(); \
    GAPB(o[0]=__builtin_amdgcn_mfma_f32_32x32x16_bf16(PAF(0),VFR(0),o[0],0,0,0), C0,0,  GI,P0,(t)+1,0,0); \
    GAPB(o[1]=__builtin_amdgcn_mfma_f32_32x32x16_bf16(PAF(0),VFR(4),o[1],0,0,0), C0,4,  GI,P0,(t)+1,1,0); \
    KRD(GL,0); GAPB(o[0]=__builtin_amdgcn_mfma_f32_32x32x16_bf16(PAF(1),VFR(1),o[0],0,0,0), C0,8,  GI,P0,(t)+1,2,0); \
    KRD(GL,1); GAPB(o[1]=__builtin_amdgcn_mfma_f32_32x32x16_bf16(PAF(1),VFR(5),o[1],0,0,0), C0,12, GI,P0,(t)+1,3,0); \
    KRD(GL,2); GAPB(o[0]=__builtin_amdgcn_mfma_f32_32x32x16_bf16(PAF(2),VFR(2),o[0],0,0,0), C1,0,  GI,P1,(t)+1,0,8); \
    KRD(GL,3); GAPB(o[1]=__builtin_amdgcn_mfma_f32_32x32x16_bf16(PAF(2),VFR(6),o[1],0,0,0), C1,4,  GI,P1,(t)+1,1,8); \
    GAPB(o[0]=__builtin_amdgcn_mfma_f32_32x32x16_bf16(PAF(3),VFR(3),o[0],0,0,0), C1,8,  GI,P1,(t)+1,2,8); \
    GAPB(o[1]=__builtin_amdgcn_mfma_f32_32x32x16_bf16(PAF(3),VFR(7),o[1],0,0,0), C1,12, GI,P1,(t)+1,3,8); \
    }while(0)
  int t=1;
  #undef CMASK
  #define CMASK(P0,P1,t) do{}while(0)
  for(;t+5<NT;t+=2){
    STEP(pB0,pB1,pA0,pA1,t,true,true,true,true);     WAIT_BAR(2); RESC(); ROT();
    STEP(pA0,pA1,pB0,pB1,t+1,true,true,true,true);   WAIT_BAR(2); RESC(); ROT();
  }
  #undef CMASK
  #define CMASK(P0,P1,t) do{int jb_=(t)-(NT-4); if(jb_>=0)cmask(P0,P1,jb_,qrel,hi);}while(0)
  #define ENDW(tt) do{ if((tt)+3<NT){WAIT_BAR(2);} else if((tt)+2<NT){WAIT_BAR(1);} else {WAIT_BAR(0);} }while(0)
  for(;t+1<NT;t+=2){
    STEP(pB0,pB1,pA0,pA1,t,(t+3<NT),(t+1<NT),(t+1<NT),true);       ENDW(t);   RESC(); ROT();
    STEP(pA0,pA1,pB0,pB1,t+1,(t+4<NT),(t+2<NT),(t+2<NT),true);     ENDW(t+1); RESC(); ROT();
  }
  STEP(pB0,pB1,pA0,pA1,NT-1,false,false,false,false); RESC();
  { float sacc=pB0[0]+pB0[1]; _Pragma("unroll") for(int r=2;r<16;++r)sacc+=pB0[r]; _Pragma("unroll") for(int r=0;r<16;++r)sacc+=pB1[r]; l_reg+=sacc;
    pw0=(u32x4){PKW(pB0,0),PKW(pB0,2),PKW(pB0,4),PKW(pB0,6)};pw1=(u32x4){PKW(pB0,8),PKW(pB0,10),PKW(pB0,12),PKW(pB0,14)};pw2=(u32x4){PKW(pB1,0),PKW(pB1,2),PKW(pB1,4),PKW(pB1,6)};pw3=(u32x4){PKW(pB1,8),PKW(pB1,10),PKW(pB1,12),PKW(pB1,14)};
    SBAR(); pv(o,vb0+sl_cur,PAF(0),PAF(1),PAF(2),PAF(3)); }
  #undef PKW
  #undef PAF
  #undef VFR
  #undef PIN
  #undef MX3
  #undef GAPA
  #undef GAPB
  #undef EX
  #undef VRD
  #undef KRD
  #undef STEP
  #undef ENDW
  {auto rr=__builtin_amdgcn_permlane32_swap(__float_as_uint(l_reg),__float_as_uint(l_reg),false,false);l_reg=__uint_as_float(rr[0])+__uint_as_float(rr[1]);}
  { const bool okw_=__all(l_reg>=SKIP_LMIN); if(lane==0)*((volatile __attribute__((address_space(3))) unsigned*)((lds_cptr)shm+LDS_OK)+wid)=okw_?1u:0u; }
  if(hi==0)wsf[32+r32]=l_reg;asm volatile("s_waitcnt lgkmcnt(0)":::"memory");
  float rli[16];
  #pragma unroll
  for(int r=0;r<16;++r)rli[r]=__builtin_amdgcn_rcpf(wsf[32+crow(r,hi)]);
  bf16*Ow=O+(rowbase+q0+wid*QBLK)*DM+h*D;
  { bf16*stg=(bf16*)(shm+LDS_OST)+wid*2048;
    #pragma unroll
    for(int r=0;r<16;++r){const int orow=crow(r,hi);
      #pragma unroll
      for(int d0=0;d0<2;++d0)stg[orow*64+d0*32+r32]=__float2bfloat16(o[d0][r]*rli[r]);}
    asm volatile("s_waitcnt lgkmcnt(0)":::"memory");
    #pragma unroll
    for(int i=0;i<4;++i){const int row=i*8+(lane>>3),ch=lane&7; const u32x4 v=*(const u32x4*)(stg+row*64+ch*8); ATTN_STORE16(Ow+(long)row*DM+ch*8,v);} }
  asm volatile("s_waitcnt lgkmcnt(0)\n\ts_barrier":::"memory");
  { const volatile __attribute__((address_space(3))) unsigned*okp_=(const volatile __attribute__((address_space(3))) unsigned*)((lds_cptr)shm+LDS_OK);
    return (okp_[0]&okp_[1]&okp_[2]&okp_[3]&okp_[4]&okp_[5]&okp_[6]&okp_[7])!=0u; }
  #undef CI4
  #undef CI16
  #undef DMA_K
  #undef DMA_V
  #undef CMASK
  #undef START
  #undef RESC
  #undef ROT
}
constexpr int ATTN_LDS_BYTES=LDS_BYTES;
struct AttnTensors { const bf16* Q; const bf16* K; const bf16* V; bf16* O; const float* Cb; };
__device__ __forceinline__ unsigned aq_grab_from(unsigned*ctr,unsigned q0_){
  for(unsigned qq=0;qq<8;++qq){ const unsigned q=(q0_+qq)&7u; const unsigned r=__hip_atomic_fetch_add(ctr+64*q,1u,__ATOMIC_RELAXED,__HIP_MEMORY_SCOPE_AGENT); if(r<256u)return (q<<16)|r; }
  return 0xffffffffu; }
template<int THRL=8> __device__ __forceinline__ void attn_phase(char*lds,const AttnTensors&T,unsigned*ctr,unsigned xcc,const unsigned*nrm){
  const int tid=threadIdx.x,lane_=tid&63;
  volatile __attribute__((address_space(3))) unsigned*qw=(volatile __attribute__((address_space(3))) unsigned*)((lds_cptr)lds+LDS_Q);
  if(tid==0)qw[0]=aq_grab_from(ctr,xcc&7u);
  asm volatile("s_waitcnt lgkmcnt(0)\n\ts_barrier":::"memory");
  bool redo=false; unsigned nraw=0u;
  unsigned pk=__builtin_amdgcn_readfirstlane(qw[0]);
  for(;;){
    if(pk==0xffffffffu)break;
    const unsigned q=pk>>16,idx=pk&0xffffu; const int bh=(int)(q+8u*(idx&7u)),qb=31-(int)(idx>>3);
    int t0s=0,t0a=0;
    int lane=lane_; asm volatile("":"+v"(lane));
    const float*cg=T.Cb+(size_t)bh*SEQ; const int ntabs=4*qb+4;
    const unsigned nw=__hip_atomic_load(nrm+(((lane>>1)&1)*64+bh)*2+(lane&1),__ATOMIC_RELAXED,__HIP_MEMORY_SCOPE_AGENT);
    float e0=0.f,e1=0.f; if(qb>0){ e0=cg[64*lane+63]; e1=(lane+64<ntabs)?cg[64*(lane+64)+63]:0.f; }
    f32x4_t cb0=f32x4_t{},cb1=f32x4_t{},cb2=f32x4_t{},cb3=f32x4_t{};
    { int tt=tid; asm volatile("":"+v"(tt)); const f32x4_t*cg4=(const f32x4_t*)cg; const int n4=ntabs*16;
      if(tt<n4)cb0=cg4[tt]; if(tt+512<n4)cb1=cg4[tt+512]; if(tt+1024<n4)cb2=cg4[tt+1024]; if(tt+1536<n4)cb3=cg4[tt+1536]; }
    const float nv=__uint_as_float(nw); const float q2=__shfl(nv,0)+__shfl(nv,1), k2=__shfl(nv,2)+__shfl(nv,3);
    const float bnd=1.02f*sqrtf(q2*k2);
    const bool guard=__builtin_amdgcn_readfirstlane((bnd<GUARD_B)?0:1)!=0;
    if(qb>0){
      const float th=fminf(SKIP_TH,SKIP_MARGIN+2.f*bnd), tha=fminf(th,SKIP_MARGIN+bnd+SKIP_G);
      const int tq=4*qb-1; const float ref=__shfl((tq<64)?e0:e1,tq&63);
      const unsigned long long m0=__ballot((lane<ntabs)&&((e0-ref)>th)), m1=__ballot((lane+64<ntabs)&&((e1-ref)>th));
      const int nskip=__popcll(m0)+__popcll(m1); t0s=nskip&~1; if(t0s>ntabs-4)t0s=ntabs-4; t0s=__builtin_amdgcn_readfirstlane(t0s);
      const unsigned long long a0=__ballot((lane<ntabs)&&((e0-ref)>tha)), a1=__ballot((lane+64<ntabs)&&((e1-ref)>tha));
      const int nska=__popcll(a0)+__popcll(a1); t0a=nska&~1; if(t0a>ntabs-4)t0a=ntabs-4; t0a=__builtin_amdgcn_readfirstlane(t0a); }
    const int t0u=redo?t0s:t0a;
    const bool ok=attn_unit<THRL>(bh/NHEAD,bh%NHEAD,qb,t0u,guard,cb0,cb1,cb2,cb3,ctr+64*q,redo,nraw,T.Q,T.K,T.V,T.O,T.Cb,lds);
    if(!ok&&t0u!=t0s){ redo=true; continue; }
    redo=false;
    const unsigned nr=__builtin_amdgcn_readfirstlane(qw[1]);
    if(nr<256u)pk=(q<<16)|nr;
    else{ if(tid==0)qw[0]=aq_grab_from(ctr,(q+1u)&7u); asm volatile("s_waitcnt lgkmcnt(0)\n\ts_barrier":::"memory"); pk=__builtin_amdgcn_readfirstlane(qw[0]); }
  }
}
#undef SBAR
#undef WAIT_BAR
}
#define ATTN_PHASE_BODY { static_assert(attn_body::ATTN_LDS_BYTES <= RING_BYTES && attn_body::ATTN_PITCH == D, "attention body geometry vs frame"); \
    const attn_body::AttnTensors AT{(const attn_body::bf16*)QO, (const attn_body::bf16*)KB, (const attn_body::bf16*)VB, (attn_body::bf16*)OB, (const float*)(F.ws + WS_C2)}; \
    attn_body::attn_phase<8>((char*)lds + RING_OFF, AT, (unsigned*)(F.ctl + CW_AQ), xb_xcc_id(), (const unsigned*)(F.ctl + CW_NRM)); }
constexpr int NWAVES = 8;
#ifndef MK_PER_PHASE
#define MK_PER_PHASE 0
#endif
constexpr int N_PHASES = 15;

constexpr int BATCH = 4, SEQ = 8192, D = 1024, H = 16, HD = 64, FF = 2816, NE = 8;
constexpr int M = BATCH * SEQ;
constexpr int NQKV = 3 * D, NIN = 3 * D + H;
constexpr int NCH = M / 128;
constexpr int TMAX = 2 * M / 256 + NE;
constexpr int HROWS = TMAX * 256;
constexpr float RMS_EPS = 1e-6f;
constexpr float QSCALE = 0.125f * 1.4426950408889634f;
constexpr float LOG2E = 1.4426950408889634f;

constexpr size_t MiB = 1u << 20;
constexpr size_t WS_CTL = 0, CTL_ZERO_BYTES = 1 * MiB;
constexpr size_t WS_CTOT = 1 * MiB;
constexpr size_t WS_WQKV = 2 * MiB, WS_WO = 8 * MiB, WS_WGU = 10 * MiB, WS_WD = 21 * MiB, WS_WCIN = 27 * MiB, WS_WCO = 33 * MiB;
constexpr size_t WS_MGU8 = 35 * MiB, WS_MD8 = 79 * MiB;
constexpr size_t WS_XN8 = 2 * MiB;
constexpr size_t WS_HB = 101 * MiB;
constexpr size_t WS_ZP = 165 * MiB, WS_BGB = 166 * MiB;
constexpr size_t WS_C2 = 167 * MiB;
constexpr size_t WS_LIST = 169 * MiB;
constexpr size_t WS_INV = 170 * MiB, WS_GATE = 170 * MiB + 512 * 1024;
constexpr size_t WS_SS = 173 * MiB;
constexpr size_t WS_XN = 176 * MiB;
constexpr size_t WS_QO = 240 * MiB, WS_K = 304 * MiB, WS_V = 368 * MiB;
constexpr size_t WS_HID = 240 * MiB;
constexpr size_t WS_HID8 = 176 * MiB, WS_Y = 358 * MiB;
constexpr size_t WS_O = 432 * MiB;
constexpr size_t WS_END = 496 * MiB;
static_assert(WS_WD + (size_t)D * FF * 2 <= WS_WCIN && WS_MGU8 + (size_t)NE * 2 * FF * D <= WS_MD8 && WS_MD8 + (size_t)NE * D * FF <= WS_HB && WS_HB + (size_t)M * D * 2 <= WS_ZP && WS_ZP + (size_t)(M / 256) * 2 * D * 4 <= WS_BGB && WS_BGB + (size_t)(M / 256) * 2 * D * 4 <= WS_C2 && WS_XN8 + (size_t)M * D <= WS_MGU8 && WS_LIST + (size_t)NE * M * 4 <= WS_INV && WS_GATE + (size_t)M * 8 <= WS_SS && WS_SS + (size_t)M * 16 * 4 <= WS_XN, "d_ws map (weights)");
static_assert(WS_HID + (size_t)M * FF * 2 <= WS_O && WS_HID8 + (size_t)HROWS * FF <= WS_Y && WS_Y + (size_t)HROWS * D * 2 <= WS_END && WS_V + (size_t)M * D * 2 <= WS_O && WS_O + (size_t)M * D * 2 <= WS_END && WS_V - WS_K == WS_K - WS_QO, "d_ws map (activations)");
constexpr int CW_TMO = 0, CW_CODE = 1;
constexpr int CW_BAR = 4096;
constexpr int CW_AQ = 12288;
constexpr int CW_NRM = 2048;
constexpr int CW_MOE = 8192;
constexpr int RING_OFF = 0, RING_BYTES = 131072;
constexpr int RSTAB_OFF = RING_BYTES + 1024;
constexpr int GTOK_OFF = RING_BYTES + 2048, GTOK_UNITS = 24;
constexpr int LDSCTL_OFF = RING_BYTES, MISC_OFF = LDSCTL_OFF + 320;
constexpr int LDS_BYTES = 147456;
static_assert(MISC_OFF + 128 <= RSTAB_OFF && GTOK_OFF + GTOK_UNITS * 512 <= LDS_BYTES && M <= 65536, "LDS map");

#define GAS __attribute__((address_space(1)))
#define LAS __attribute__((address_space(3)))
typedef unsigned short bf16;
typedef unsigned v4u __attribute__((ext_vector_type(4)));
typedef float f32x4 __attribute__((ext_vector_type(4)));
typedef short bf16x8 __attribute__((ext_vector_type(8)));
typedef GAS unsigned gu32;
typedef GAS unsigned long long gu64;
#define RLX_AGENT __ATOMIC_RELAXED, __HIP_MEMORY_SCOPE_AGENT
#define LDS_WAIT() asm volatile("s_waitcnt lgkmcnt(0)" ::: "memory")
#define VM_WAIT() asm volatile("s_waitcnt vmcnt(0)" ::: "memory")
__device__ __forceinline__ unsigned f2bf(float f) { unsigned u = __builtin_bit_cast(unsigned, f); return (u + 0x7fffu + ((u >> 16) & 1u)) >> 16; }
__device__ __forceinline__ unsigned pk2(float lo, float hi) { return f2bf(lo) | (f2bf(hi) << 16); }
__device__ __forceinline__ float bf_lo(unsigned w) { return __uint_as_float(w << 16); }
__device__ __forceinline__ float bf_hi(unsigned w) { return __uint_as_float(w & 0xffff0000u); }

#define XB_TMO      128
#define XB_XCNT(j)  (256  + 64 * (j))
#define XB_XSUB(j)  (1280 + 64 * (j))
#define XB_XGEN(j)  (2304 + 64 * (j))
#define XB_TOP      3328
#define XB_TOPGEN   3392
#define XCD_BAR_WORDS 3456
#define XB_SPIN_CAP (1u << 18)

__device__ __forceinline__ unsigned xb_ld(unsigned* p)              { return __hip_atomic_load(p, __ATOMIC_RELAXED, __HIP_MEMORY_SCOPE_AGENT); }
__device__ __forceinline__ unsigned xb_add(unsigned* p, unsigned v) { return __hip_atomic_fetch_add(p, v, __ATOMIC_RELAXED, __HIP_MEMORY_SCOPE_AGENT); }
__device__ __forceinline__ unsigned xb_xcc_id() { return (unsigned)__builtin_amdgcn_s_getreg((3 << 11) | 20) & 0xFu; }
#define XB_SPIN(cond, bar) do { unsigned _sp = 0; while (cond) { __builtin_amdgcn_s_sleep(1); \
    if ((++_sp & 255u) == 0u) { if (xb_ld(&(bar)[XB_TMO])) break; if (_sp > XB_SPIN_CAP) { atomicAdd(&(bar)[XB_TMO], 1u); break; } } } } while (0)

struct XcdBarrier {
    unsigned* bar; unsigned x;
    volatile LAS unsigned* st;
};

__device__ __forceinline__ XcdBarrier xcd_barrier_post(unsigned* bar, volatile LAS unsigned* st) {
    XcdBarrier b; b.bar = bar; b.x = xb_xcc_id(); b.st = st;
    if (threadIdx.x == 0) (void)xb_add(&bar[XB_XCNT(b.x)], 1u);
    return b;
}
__device__ __forceinline__ void xcd_barrier_complete(unsigned* bar, unsigned x, unsigned& nloc, unsigned& nx) {
    const unsigned G = gridDim.x * gridDim.y * gridDim.z;
    unsigned sum, cnt, mine, sp = 0u;
    for (;;) {
        sum = 0u; cnt = 0u; mine = 0u;
#pragma unroll
        for (unsigned j = 0; j < 16; ++j) { const unsigned c = xb_ld(&bar[XB_XCNT(j)]); sum += c; cnt += (c > 0u) ? 1u : 0u; mine = (j == x) ? c : mine; }
        if (sum == G) break;
        __builtin_amdgcn_s_sleep(1);
        if ((++sp & 255u) == 0u) { if (xb_ld(&bar[XB_TMO])) break; if (sp > XB_SPIN_CAP) { atomicAdd(&bar[XB_TMO], 1u); break; } }
    }
    nloc = mine > 0u ? mine : 1u; nx = cnt > 0u ? cnt : 1u;
}

__device__ __forceinline__ void xcd_barrier(const XcdBarrier& b) {
    asm volatile("s_waitcnt vmcnt(0)" ::: "memory");
    __syncthreads();
    if (threadIdx.x == 0) {
        unsigned* bar = b.bar;
        __builtin_amdgcn_s_waitcnt(0);
        unsigned nloc = b.st[0], nx = b.st[1];
        if (nloc == 0u) { xcd_barrier_complete(bar, b.x, nloc, nx); b.st[0] = nloc; b.st[1] = nx; }
        const unsigned old = xb_add(&bar[XB_XSUB(b.x)], 1u);
        const unsigned gen = old / nloc;
        if (old + 1u == (gen + 1u) * nloc) {
            __builtin_amdgcn_fence(__ATOMIC_RELEASE, "agent");
            asm volatile("s_waitcnt vmcnt(0)" ::: "memory");
            const unsigned og = xb_add(&bar[XB_TOP], 1u);
            const unsigned tg = og / nx;
            if (og + 1u == (tg + 1u) * nx) xb_add(&bar[XB_TOPGEN], 1u);
            else XB_SPIN(xb_ld(&bar[XB_TOPGEN]) == tg, bar);
            __builtin_amdgcn_fence(__ATOMIC_ACQUIRE, "agent");
            xb_add(&bar[XB_XGEN(b.x)], 1u);
            asm volatile("s_waitcnt vmcnt(0)" ::: "memory");
        } else {
            XB_SPIN(xb_ld(&bar[XB_XGEN(b.x)]) == gen, bar);
            __builtin_amdgcn_fence(__ATOMIC_ACQUIRE, "agent");
            asm volatile("s_waitcnt vmcnt(0)" ::: "memory");
        }
    }
    __syncthreads();
}

struct Frame {
    LAS unsigned char* lds;
    volatile LAS unsigned* MISC;
    gu32* ctl;
    int tid, lane, wave;
    int vcu, G;
    const float* const* in; float* out; unsigned char* ws;
};
enum { I_X = 0, I_ATTN_NORM, I_ATTN_WIN, I_ATTN_BF, I_ATTN_WOUT, I_FFN_NORM, I_FFN_WG, I_FFN_WU, I_FFN_WD, I_CONV_NORM, I_CONV_WIN, I_CONV_W, I_CONV_WOUT, I_MOE_NORM, I_MOE_WR, I_MOE_WG, I_MOE_WU, I_MOE_WD, I_FINAL_NORM };

__device__ __forceinline__ float wave_sum(float v) {
#pragma unroll
    for (int o = 1; o < 64; o <<= 1) v += __shfl_xor(v, o);
    return v;
}
__device__ __forceinline__ void tr_item(const float* W, int ldw, int K, bf16* WT, int k0, int n0, int drow0, LAS float* scr, int lane, const float* gain = nullptr) {
    { f32x4 t[8]; const int kr = lane >> 3, c4 = 4 * (lane & 7);
#pragma unroll
      for (int i = 0; i < 8; ++i) t[i] = *(const GAS f32x4*)(W + (size_t)(k0 + kr + 8 * i) * ldw + n0 + c4);
#pragma unroll
      for (int i = 0; i < 8; ++i) { const int kk = kr + 8 * i; const float gn = gain ? gain[k0 + kk] : 1.0f; LAS float* d = scr + kk * 33 + c4;
          d[0] = t[i].x * gn; d[1] = t[i].y * gn; d[2] = t[i].z * gn; d[3] = t[i].w * gn; } }
    LDS_WAIT(); asm volatile("" ::: "memory");
    const int c = lane & 7;
#pragma unroll
    for (int j = 0; j < 4; ++j) { const int n = (lane >> 3) + 8 * j; const LAS float* s = scr + (8 * c) * 33 + n;
        v4u o; o.x = pk2(s[0 * 33], s[1 * 33]); o.y = pk2(s[2 * 33], s[3 * 33]); o.z = pk2(s[4 * 33], s[5 * 33]); o.w = pk2(s[6 * 33], s[7 * 33]);
        *(GAS v4u*)(WT + (size_t)(drow0 + n) * K + k0 + 8 * c) = o; }
    LDS_WAIT(); asm volatile("" ::: "memory");
}
__device__ __forceinline__ void tr_item8(const float* W, int ldw, int Kb, unsigned char* WT, int k0, int n0, int drow0, LAS float* scr, int lane) {
    { f32x4 t[8]; const int kr = lane >> 3, c4 = 4 * (lane & 7);
#pragma unroll
      for (int i = 0; i < 8; ++i) t[i] = *(const GAS f32x4*)(W + (size_t)(k0 + kr + 8 * i) * ldw + n0 + c4);
#pragma unroll
      for (int i = 0; i < 8; ++i) { LAS float* d = scr + (kr + 8 * i) * 33 + c4;
          d[0] = t[i].x * pg8::W8_SCALE; d[1] = t[i].y * pg8::W8_SCALE; d[2] = t[i].z * pg8::W8_SCALE; d[3] = t[i].w * pg8::W8_SCALE; } }
    LDS_WAIT(); asm volatile("" ::: "memory");
#pragma unroll
    for (int j = 0; j < 2; ++j) { const int idx = lane + 64 * j, n = idx >> 2, c = idx & 3; const LAS float* s = scr + (16 * c) * 33 + n;
        v4u o; o.x = pg8::pk4_fp8(s[0 * 33], s[1 * 33], s[2 * 33], s[3 * 33]); o.y = pg8::pk4_fp8(s[4 * 33], s[5 * 33], s[6 * 33], s[7 * 33]);
        o.z = pg8::pk4_fp8(s[8 * 33], s[9 * 33], s[10 * 33], s[11 * 33]); o.w = pg8::pk4_fp8(s[12 * 33], s[13 * 33], s[14 * 33], s[15 * 33]);
        *(GAS v4u*)(WT + (size_t)(drow0 + n) * Kb + k0 + 16 * c) = o; }
    LDS_WAIT(); asm volatile("" ::: "memory");
}
struct TrItem { const float* W; const float* gain; unsigned char* WT; int ldw, Kb, k0, n0, drow0, fp8; };
__device__ __forceinline__ void tr_load(const TrItem& I, f32x4 (&t)[8], float (&gq)[8], int lane) {
    const int kr = lane >> 3, c4 = 4 * (lane & 7);
#pragma unroll
    for (int i = 0; i < 8; ++i) t[i] = *(const GAS f32x4*)(I.W + (size_t)(I.k0 + kr + 8 * i) * I.ldw + I.n0 + c4);
#pragma unroll
    for (int i = 0; i < 8; ++i) gq[i] = I.gain ? I.gain[I.k0 + kr + 8 * i] : 1.0f;
}
__device__ __forceinline__ void tr_to_lds(const TrItem& I, const f32x4 (&t)[8], const float (&gq)[8], LAS float* scr, int lane) {
    const int kr = lane >> 3, c4 = 4 * (lane & 7); const float sc = (I.fp8 == 1) ? pg8::W8_SCALE : 1.0f;
#pragma unroll
    for (int i = 0; i < 8; ++i) { const int kk = kr + 8 * i; const float gn = gq[i] * sc; LAS float* d = scr + kk * 33 + c4;
        d[0] = t[i].x * gn; d[1] = t[i].y * gn; d[2] = t[i].z * gn; d[3] = t[i].w * gn; }
    LDS_WAIT(); asm volatile("" ::: "memory");
}
__device__ __forceinline__ void tr_store(const TrItem& I, LAS float* scr, int lane) {
    if (I.fp8 == 1) {
#pragma unroll
        for (int j = 0; j < 2; ++j) { const int idx = lane + 64 * j, n = idx >> 2, c = idx & 3; const LAS float* s = scr + (16 * c) * 33 + n;
            v4u o; o.x = pg8::pk4_fp8(s[0 * 33], s[1 * 33], s[2 * 33], s[3 * 33]); o.y = pg8::pk4_fp8(s[4 * 33], s[5 * 33], s[6 * 33], s[7 * 33]);
            o.z = pg8::pk4_fp8(s[8 * 33], s[9 * 33], s[10 * 33], s[11 * 33]); o.w = pg8::pk4_fp8(s[12 * 33], s[13 * 33], s[14 * 33], s[15 * 33]);
            *(GAS v4u*)(I.WT + (size_t)(I.drow0 + n) * I.Kb + I.k0 + 16 * c) = o; }
    } else {
        const int c = lane & 7;
#pragma unroll
        for (int j = 0; j < 4; ++j) { const int n = (lane >> 3) + 8 * j; const LAS float* s = scr + (8 * c) * 33 + n;
            v4u o;
            if (I.fp8 == 2) { o.x = pg8::pk2h(s[0 * 33], s[1 * 33]); o.y = pg8::pk2h(s[2 * 33], s[3 * 33]); o.z = pg8::pk2h(s[4 * 33], s[5 * 33]); o.w = pg8::pk2h(s[6 * 33], s[7 * 33]); }
            else { o.x = pk2(s[0 * 33], s[1 * 33]); o.y = pk2(s[2 * 33], s[3 * 33]); o.z = pk2(s[4 * 33], s[5 * 33]); o.w = pk2(s[6 * 33], s[7 * 33]); }
            *(GAS v4u*)(I.WT + (size_t)(I.drow0 + n) * I.Kb + (size_t)(I.k0 + 8 * c) * 2) = o; }
    }
    LDS_WAIT(); asm volatile("" ::: "memory");
}
__device__ __forceinline__ int map_gate(int n0) { return 256 * (n0 >> 7) + (n0 & 127); }
__device__ __forceinline__ int map_up(int n0) { return 256 * (n0 >> 7) + 128 + (n0 & 127); }

__device__ __forceinline__ void rms_row(const float* xrow, const f32x4 (&g)[4], f32x4 (&v)[4], int lane) {
    const GAS f32x4* xr = (const GAS f32x4*)xrow + lane; float s = 0.f;
#pragma unroll
    for (int j = 0; j < 4; ++j) { v[j] = xr[64 * j]; s += (v[j].x * v[j].x + v[j].y * v[j].y) + (v[j].z * v[j].z + v[j].w * v[j].w); }
    const float rstd = 1.0f / sqrtf(wave_sum(s) * (1.f / D) + RMS_EPS);
#pragma unroll
    for (int j = 0; j < 4; ++j) v[j] = v[j] * rstd * g[j];
}
__device__ __forceinline__ void rms_load(const float* xrow, f32x4 (&v)[4], int lane) {
    const GAS f32x4* xr = (const GAS f32x4*)xrow + lane;
#pragma unroll
    for (int j = 0; j < 4; ++j) v[j] = xr[64 * j];
}
__device__ __forceinline__ void rms_finish(const f32x4 (&g)[4], f32x4 (&v)[4]) {
    float s = 0.f;
#pragma unroll
    for (int j = 0; j < 4; ++j) s += (v[j].x * v[j].x + v[j].y * v[j].y) + (v[j].z * v[j].z + v[j].w * v[j].w);
    const float rstd = 1.0f / sqrtf(wave_sum(s) * (1.f / D) + RMS_EPS);
#pragma unroll
    for (int j = 0; j < 4; ++j) v[j] = v[j] * rstd * g[j];
}
__device__ __forceinline__ void load_row_h16(const bf16* hrow, f32x4 (&v)[4], int lane) {
    typedef unsigned u32x2 __attribute__((ext_vector_type(2)));
    const GAS u32x2* hr = (const GAS u32x2*)hrow + lane;
#pragma unroll
    for (int j = 0; j < 4; ++j) { const u32x2 w = hr[64 * j]; v[j] = (f32x4){pg8::h_lo(w.x), pg8::h_hi(w.x), pg8::h_lo(w.y), pg8::h_hi(w.y)}; }
}
__device__ __forceinline__ void store_row_bf16(bf16* orow, const f32x4 (&v)[4], int lane) {
    GAS unsigned long long* o8 = (GAS unsigned long long*)orow + lane;
#pragma unroll
    for (int j = 0; j < 4; ++j) o8[64 * j] = (unsigned long long)pk2(v[j].x, v[j].y) | ((unsigned long long)pk2(v[j].z, v[j].w) << 32);
}
__device__ __forceinline__ void load_gain(const float* gp, f32x4 (&g)[4], int lane) {
#pragma unroll
    for (int j = 0; j < 4; ++j) g[j] = ((const GAS f32x4*)gp)[lane + 64 * j];
}

__device__ __forceinline__ void p0_prologue(Frame& F) {
    constexpr int WFLD = 1032;
    LAS bf16* wf = (LAS bf16*)(F.lds + RING_OFF);
    LAS float* wtot = (LAS float*)(F.lds + RING_OFF + 40960);
    const float* Win = F.in[I_ATTN_WIN];
    for (int i = 0; i < 32; ++i) { const int k = (F.tid >> 4) + 32 * i, h = F.tid & 15; wf[h * WFLD + k] = (bf16)f2bf(Win[(size_t)k * NIN + NQKV + h]); }
    __syncthreads();
    bf16* XN = (bf16*)(F.ws + WS_XN); float* C2 = (float*)(F.ws + WS_C2); float* CTOT = (float*)(F.ws + WS_CTOT);
    f32x4 g[4]; load_gain(F.in[I_ATTN_NORM], g, F.lane);
    const int hh = F.lane & 15, q4 = F.lane >> 4; const float bfg = F.in[I_ATTN_BF][hh];
    for (int chunk = blockIdx.x; chunk < NCH; chunk += F.G) {
        const int r0 = chunk * 128 + F.wave * 16;
        for (int rr = 0; rr < 16; rr += 2) { f32x4 v[4], w[4];
            rms_load(F.in[I_X] + (size_t)(r0 + rr) * D, v, F.lane); rms_load(F.in[I_X] + (size_t)(r0 + rr + 1) * D, w, F.lane);
            rms_finish(g, v); rms_finish(g, w); store_row_bf16(XN + (size_t)(r0 + rr) * D, v, F.lane); store_row_bf16(XN + (size_t)(r0 + rr + 1) * D, w, F.lane); }
        VM_WAIT();
        f32x4 acc = (f32x4){0.f, 0.f, 0.f, 0.f};
        const bf16* arow = XN + (size_t)(r0 + hh) * D + 8 * q4; const LAS bf16* brow = wf + hh * WFLD + 8 * q4;
#pragma unroll 8
        for (int s = 0; s < 32; ++s) { const bf16x8 a = *(const GAS bf16x8*)(arow + 32 * s); const bf16x8 b = *(const LAS bf16x8*)(brow + 32 * s); acc = __builtin_amdgcn_mfma_f32_16x16x32_bf16(a, b, acc, 0, 0, 0); }
        float p[4], run = 0.f;
#pragma unroll
        for (int r = 0; r < 4; ++r) { const float x = acc[r] + bfg; const float ls = fminf(x, 0.f) - log1pf(expf(-fabsf(x))); run += ls; p[r] = run; }
        const float T0 = __shfl(run, hh), T1 = __shfl(run, hh + 16), T2 = __shfl(run, hh + 32), T3 = __shfl(run, hh + 48);
        const float excl = (q4 > 0 ? T0 : 0.f) + (q4 > 1 ? T1 : 0.f) + (q4 > 2 ? T2 : 0.f);
        if (q4 == 0) wtot[F.wave * 16 + hh] = (T0 + T1) + (T2 + T3);
        __syncthreads();
        float wp = 0.f, tot = 0.f;
#pragma unroll
        for (int i = 0; i < 8; ++i) { const float t = wtot[i * 16 + hh]; if (i < F.wave) wp += t; tot += t; }
        if (F.wave == 0 && q4 == 0) CTOT[chunk * 16 + hh] = tot;
        const int b = chunk / (SEQ / 128), t0 = (chunk % (SEQ / 128)) * 128 + F.wave * 16 + 4 * q4; const float base = wp + excl;
        *(GAS f32x4*)(C2 + (size_t)(b * H + hh) * SEQ + t0) = (f32x4){p[0] + base, p[1] + base, p[2] + base, p[3] + base};
        __syncthreads();
    }
}
constexpr int TI_QKV = (D / 64) * (NQKV / 32), TI_DD = (D / 64) * (D / 32), TI_DF = (D / 64) * (FF / 32), TI_FD = (FF / 64) * (D / 32);
constexpr int N_EARLY = TI_QKV + TI_DD, NITEMS = TI_QKV + TI_DD + 2 * TI_DF + TI_FD + TI_QKV + TI_DD + NE * (2 * TI_DF + TI_FD);
__device__ __forceinline__ void weight_copies(Frame& F, int it_lo, int it_hi, int cw, int ncw) {
    LAS float* scr = (LAS float*)(F.lds + RING_OFF + F.wave * 16384);
    constexpr int I_QKV = TI_QKV, I_DD = TI_DD, I_DF = TI_DF, I_FD = TI_FD;
    bf16* WQKV = (bf16*)(F.ws + WS_WQKV); bf16* WO = (bf16*)(F.ws + WS_WO); bf16* WGU = (bf16*)(F.ws + WS_WGU); bf16* WD = (bf16*)(F.ws + WS_WD);
    bf16* WCIN = (bf16*)(F.ws + WS_WCIN); bf16* WCO = (bf16*)(F.ws + WS_WCO); unsigned char* MGU = F.ws + WS_MGU8; unsigned char* MD = F.ws + WS_MD8;
    auto decode = [&](int it, TrItem& I) {
        int r = it; I.gain = nullptr; I.fp8 = 0;
        auto set = [&](const float* W, int ldw, int ncols, void* WT, int Kb) { const int nb = ncols / 32; I.W = W; I.ldw = ldw; I.WT = (unsigned char*)WT; I.Kb = Kb; I.k0 = 64 * (r / nb); I.n0 = 32 * (r % nb); I.drow0 = I.n0; };
        if (r < I_QKV) { set(F.in[I_ATTN_WIN], NIN, NQKV, WQKV, D * 2); return; } r -= I_QKV;
        if (r < I_DD) { set(F.in[I_ATTN_WOUT], D, D, WO, D * 2); return; } r -= I_DD;
        if (r < I_DF) { set(F.in[I_FFN_WG], FF, FF, WGU, D * 2); I.drow0 = map_gate(I.n0); I.gain = F.in[I_FFN_NORM]; I.fp8 = 2; return; } r -= I_DF;
        if (r < I_DF) { set(F.in[I_FFN_WU], FF, FF, WGU, D * 2); I.drow0 = map_up(I.n0); I.gain = F.in[I_FFN_NORM]; I.fp8 = 2; return; } r -= I_DF;
        if (r < I_FD) { set(F.in[I_FFN_WD], D, D, WD, FF * 2); return; } r -= I_FD;
        if (r < I_QKV) { set(F.in[I_CONV_WIN], NQKV, NQKV, WCIN, D * 2); const int n0 = I.n0;
            I.drow0 = n0 < D ? 2 * D + n0 : (n0 < 2 * D ? map_gate(n0 - D) : map_up(n0 - 2 * D)); I.gain = F.in[I_CONV_NORM]; I.fp8 = 2; return; } r -= I_QKV;
        if (r < I_DD) { set(F.in[I_CONV_WOUT], D, D, WCO, D * 2); return; } r -= I_DD;
        const int per_e = 2 * I_DF + I_FD, e = r / per_e; r -= e * per_e; I.fp8 = 1;
        if (r < I_DF) { set(F.in[I_MOE_WG] + (size_t)e * D * FF, FF, FF, MGU + (size_t)e * 2 * FF * D, D); I.drow0 = map_gate(I.n0); I.gain = F.in[I_MOE_NORM]; return; } r -= I_DF;
        if (r < I_DF) { set(F.in[I_MOE_WU] + (size_t)e * D * FF, FF, FF, MGU + (size_t)e * 2 * FF * D, D); I.drow0 = map_up(I.n0); I.gain = F.in[I_MOE_NORM]; return; } r -= I_DF;
        set(F.in[I_MOE_WD] + (size_t)e * FF * D, D, D, MD + (size_t)e * D * FF, FF);
    };
    f32x4 ta[8], tb[8], tc[8], td[8]; float ga[8], gb[8], gc[8], gd[8]; TrItem I; int itA = it_lo + cw; const int step = 4 * ncw;
#define WC_FIRST(T_, G_, OFF_) do { if (itA + (OFF_) < it_hi) { decode(itA + (OFF_), I); tr_load(I, T_, G_, F.lane); } } while (0)
#define WC_STEP(T_, G_, OFF_) do { if (itA + (OFF_) < it_hi) { decode(itA + (OFF_), I); tr_to_lds(I, T_, G_, scr, F.lane); \
            if (itA + (OFF_) + step < it_hi) { decode(itA + (OFF_) + step, I); tr_load(I, T_, G_, F.lane); } \
            decode(itA + (OFF_), I); tr_store(I, scr, F.lane); } } while (0)
    WC_FIRST(ta, ga, 0); WC_FIRST(tb, gb, ncw); WC_FIRST(tc, gc, 2 * ncw); WC_FIRST(td, gd, 3 * ncw);
    while (itA < it_hi) { WC_STEP(ta, ga, 0); WC_STEP(tb, gb, ncw); WC_STEP(tc, gc, 2 * ncw); WC_STEP(td, gd, 3 * ncw); itA += step; }
#undef WC_FIRST
#undef WC_STEP
}
__device__ __forceinline__ void p1_scan_fixup(Frame& F) {
    LAS float* part = (LAS float*)(F.lds + RING_OFF); LAS float* pre = part + 512;
    float* C2 = (float*)(F.ws + WS_C2); const float* CTOT = (const float*)(F.ws + WS_CTOT);
    for (int chunk = blockIdx.x; chunk < NCH; chunk += F.G) {
        const int b = chunk / (SEQ / 128), cb = chunk % (SEQ / 128), hh = F.tid & 15, j = F.tid >> 4;
        float s = 0.f;
        if (j < cb) s += CTOT[(b * (SEQ / 128) + j) * 16 + hh];
        if (j + 32 < cb) s += CTOT[(b * (SEQ / 128) + j + 32) * 16 + hh];
        part[j * 16 + hh] = s;
        __syncthreads();
        if (F.tid < 16) { float t = 0.f; for (int i = 0; i < 32; ++i) t += part[i * 16 + F.tid]; pre[F.tid] = t; }
        __syncthreads();
        const int h2 = F.tid >> 5, t4 = (F.tid & 31) * 4;
        GAS f32x4* p = (GAS f32x4*)(C2 + (size_t)(b * H + h2) * SEQ + cb * 128 + t4);
        const float pr = pre[h2]; const f32x4 v = *p; *p = (f32x4){(v.x + pr) * LOG2E, (v.y + pr) * LOG2E, (v.z + pr) * LOG2E, (v.w + pr) * LOG2E};
        __syncthreads();
    }
}
__device__ __forceinline__ void norm_phase(Frame& F, const float* gain) {
    f32x4 g[4]; load_gain(gain, g, F.lane); bf16* XN = (bf16*)(F.ws + WS_XN);
    const int gw = F.vcu * NWAVES + F.wave, NGW = F.G * NWAVES;
    for (int m = gw; m < M; m += NGW) { f32x4 v[4]; rms_row(F.out + (size_t)m * D, g, v, F.lane); store_row_bf16(XN + (size_t)m * D, v, F.lane); }
}
__device__ __forceinline__ void final_norm_phase(Frame& F) {
    f32x4 g[4]; load_gain(F.in[I_FINAL_NORM], g, F.lane);
    const int gw = F.vcu * NWAVES + F.wave, NGW = F.G * NWAVES;
    for (int m = gw; m < M; m += NGW) { f32x4 v[4]; rms_row(F.out + (size_t)m * D, g, v, F.lane); GAS f32x4* o = (GAS f32x4*)(F.out + (size_t)m * D) + F.lane;
#pragma unroll
        for (int j = 0; j < 4; ++j) o[64 * j] = v[j]; }
}
__device__ __forceinline__ void conv_fixup(Frame& F, int pm) {
    if ((pm % (SEQ / 256)) == 0) return;
    typedef unsigned u32x2 __attribute__((ext_vector_type(2)));
    const bf16* U = (const bf16*)(F.ws + WS_K); bf16* Z = (bf16*)(F.ws + WS_V); const float* cw = F.in[I_CONV_W];
    const float* zp = (const float*)(F.ws + WS_ZP); const float* bgb = (const float*)(F.ws + WS_BGB);
    const int r = F.tid >> 8, c4 = (F.tid & 255) * 4; const size_t g = (size_t)pm * 256 + r, gt0 = (size_t)pm * 256;
    const f32x4 z0 = *(const GAS f32x4*)(zp + ((size_t)pm * 2 + r) * D + c4), gt = *(const GAS f32x4*)(bgb + ((size_t)pm * 2 + r) * D + c4);
    const f32x4 w0 = *(const GAS f32x4*)(cw + c4), w1 = *(const GAS f32x4*)(cw + D + c4);
    const u32x2 ua = *(const GAS u32x2*)(U + (gt0 - 1) * D + c4), ub = *(const GAS u32x2*)(U + (gt0 - 2) * D + c4);
    const f32x4 a = (f32x4){bf_lo(ua.x), bf_hi(ua.x), bf_lo(ua.y), bf_hi(ua.y)}, b = (f32x4){bf_lo(ub.x), bf_hi(ub.x), bf_lo(ub.y), bf_hi(ub.y)};
    const f32x4 z = (r == 0) ? z0 + gt * (w0 * b + w1 * a) : z0 + gt * (w0 * a);
    u32x2 o; o.x = pk2(z.x, z.y); o.y = pk2(z.z, z.w); *(GAS u32x2*)(Z + g * D + c4) = o;
}
__device__ __forceinline__ void store_row_fp8(unsigned char* orow, const f32x4 (&v)[4], int lane) {
    GAS unsigned* o = (GAS unsigned*)orow + lane;
#pragma unroll
    for (int j = 0; j < 4; ++j) o[64 * j] = pg8::pk4_fp8(v[j].x, v[j].y, v[j].z, v[j].w);
}
__device__ __forceinline__ void route_phase(Frame& F) {
    constexpr int WLD = 1032;
    LAS _Float16* wh = (LAS _Float16*)(F.lds + RING_OFF);
    LAS _Float16* wl = wh + NE * WLD;
    LAS int* sel = (LAS int*)(F.lds + RING_OFF + 34816);
    LAS float* gv = (LAS float*)(F.lds + RING_OFF + 34816 + 1024);
    LAS int* wcnt = (LAS int*)(F.lds + RING_OFF + 34816 + 2048);
    static_assert(2 * NE * WLD * 2 <= 34816, "router tables");
    static_assert(D * NE == 16 * NWAVES * 64, "router table fill");
    float rw[16], rg[16];
    { const float* Wr = F.in[I_MOE_WR]; const float* gn = F.in[I_MOE_NORM];
#pragma unroll
      for (int j = 0; j < 16; ++j) { const int i = F.tid + j * NWAVES * 64; rw[j] = Wr[i]; rg[j] = gn[i >> 3]; } }
    unsigned char* XN8 = F.ws + WS_XN8;
    int* LIST = (int*)(F.ws + WS_LIST); unsigned* INV = (unsigned*)(F.ws + WS_INV); float* GT = (float*)(F.ws + WS_GATE); const bf16* HBc = (const bf16*)(F.ws + WS_HB);
    const int r = F.lane & 15, q = F.lane >> 4;
    for (int chunk = blockIdx.x; chunk < NCH; chunk += F.G) {
        const int rc = F.wave * 16 + r, m = chunk * 128 + rc;
        pg8::u32x4 hv[16][2]; { const GAS pg8::u32x4* hp = (const GAS pg8::u32x4*)(HBc + (size_t)m * D + 16 * q);
#pragma unroll
          for (int j = 0; j < 16; ++j) { hv[j][0] = hp[8 * j]; hv[j][1] = hp[8 * j + 1]; } }
        if (chunk == (int)blockIdx.x) {
#pragma unroll
            for (int j = 0; j < 16; ++j) { const int i = F.tid + j * NWAVES * 64, k = i >> 3, e = i & 7; const float w = rw[j] * rg[j]; const _Float16 hi = (_Float16)w;
                wh[e * WLD + k] = hi; wl[e * WLD + k] = (_Float16)((w - (float)hi) * 2048.f); }
            __syncthreads(); }
        pg8::f32x4 aH = (pg8::f32x4){0.f, 0.f, 0.f, 0.f}, aL = aH, aN = aH;
        const LAS _Float16* whp = wh + (r & 7) * WLD + 16 * q; const LAS _Float16* wlp = wl + (r & 7) * WLD + 16 * q;
#pragma unroll
        for (int j = 0; j < 16; ++j)
#pragma unroll
            for (int hf = 0; hf < 2; ++hf) { const pg8::f16x8 x = __builtin_bit_cast(pg8::f16x8, hv[j][hf]);
                const pg8::f16x8 wa = *(const LAS pg8::f16x8*)(whp + 64 * j + 8 * hf), wb = *(const LAS pg8::f16x8*)(wlp + 64 * j + 8 * hf);
                aH = __builtin_amdgcn_mfma_f32_16x16x32_f16(wa, x, aH, 0, 0, 0);
                aL = __builtin_amdgcn_mfma_f32_16x16x32_f16(wb, x, aL, 0, 0, 0);
                aN = __builtin_amdgcn_mfma_f32_16x16x32_f16(x, x, aN, 0, 0, 0); }
        const float dsel = (r & 3) == 0 ? aN[0] : ((r & 3) == 1 ? aN[1] : ((r & 3) == 2 ? aN[2] : aN[3]));
        const float rstd = 1.0f / sqrtf(__shfl(dsel, r + 16 * (r >> 2)) * (1.f / D) + RMS_EPS);
#pragma unroll
        for (int j = 0; j < 16; ++j) { const pg8::u32x4 a = hv[j][0], b = hv[j][1]; pg8::u32x4 o;
            o.x = pg8::pk4_fp8(pg8::h_lo(a.x) * rstd, pg8::h_hi(a.x) * rstd, pg8::h_lo(a.y) * rstd, pg8::h_hi(a.y) * rstd); o.y = pg8::pk4_fp8(pg8::h_lo(a.z) * rstd, pg8::h_hi(a.z) * rstd, pg8::h_lo(a.w) * rstd, pg8::h_hi(a.w) * rstd);
            o.z = pg8::pk4_fp8(pg8::h_lo(b.x) * rstd, pg8::h_hi(b.x) * rstd, pg8::h_lo(b.y) * rstd, pg8::h_hi(b.y) * rstd); o.w = pg8::pk4_fp8(pg8::h_lo(b.z) * rstd, pg8::h_hi(b.z) * rstd, pg8::h_lo(b.w) * rstd, pg8::h_hi(b.w) * rstd);
            *(GAS pg8::u32x4*)(XN8 + (size_t)m * D + 16 * (q + 4 * j)) = o; }
        float own[4], oth[4], lg[NE];
#pragma unroll
        for (int i = 0; i < 4; ++i) { own[i] = (aH[i] + aL[i] * (1.f / 2048.f)) * rstd; oth[i] = __shfl_xor(own[i], 16); }
#pragma unroll
        for (int i = 0; i < 4; ++i) { lg[i] = (q & 1) ? oth[i] : own[i]; lg[4 + i] = (q & 1) ? own[i] : oth[i]; }
        int e1 = 0; float v1 = lg[0];
#pragma unroll
        for (int e = 1; e < NE; ++e) if (lg[e] > v1) { v1 = lg[e]; e1 = e; }
        int e2 = -1; float v2 = -INFINITY;
#pragma unroll
        for (int e = 0; e < NE; ++e) if (e != e1 && lg[e] > v2) { v2 = lg[e]; e2 = e; }
        const float g1 = 1.0f / (1.0f + expf(v2 - v1));
        if (q == 0) { sel[rc * 2] = e1; sel[rc * 2 + 1] = e2; gv[rc * 2] = g1; gv[rc * 2 + 1] = 1.0f - g1; }
        __syncthreads();
        int my_e = -1, my_rank = 0;
        if (F.tid < 256) { my_e = sel[F.tid];
#pragma unroll
            for (int ex = 0; ex < NE; ++ex) { const unsigned long long mk = __ballot(my_e == ex); if (my_e == ex) my_rank = __popcll(mk & ((1ull << F.lane) - 1ull)); if (F.lane == 0) wcnt[F.wave * NE + ex] = __popcll(mk); } }
        __syncthreads();
        if (F.tid < NE) { const int c0 = wcnt[F.tid], c1 = wcnt[NE + F.tid], c2 = wcnt[2 * NE + F.tid], c3 = wcnt[3 * NE + F.tid], tot = c0 + c1 + c2 + c3;
            const int b = tot ? (int)__hip_atomic_fetch_add(F.ctl + CW_MOE + 64 * F.tid, (unsigned)tot, RLX_AGENT) : 0;
            wcnt[F.tid] = b; wcnt[NE + F.tid] = b + c0; wcnt[2 * NE + F.tid] = b + c0 + c1; wcnt[3 * NE + F.tid] = b + c0 + c1 + c2; }
        __syncthreads();
        if (F.tid < 256 && my_e >= 0) { const int pos = wcnt[F.wave * NE + my_e] + my_rank, tok = chunk * 128 + (F.tid >> 1);
            LIST[(size_t)my_e * M + pos] = tok; INV[tok * 2 + (F.tid & 1)] = ((unsigned)my_e << 20) | (unsigned)pos; GT[tok * 2 + (F.tid & 1)] = gv[F.tid]; }
        __syncthreads();
    }
}
__device__ __forceinline__ void moe_table(Frame& F) {
    LAS int* tab = (LAS int*)(F.lds + LDSCTL_OFF);
    if (F.tid < NE) tab[16 + F.tid] = (int)__hip_atomic_load(F.ctl + CW_MOE + 64 * F.tid, RLX_AGENT);
    __syncthreads();
    if (F.tid == 0) { int ts = 0; for (int e = 0; e < NE; ++e) { const int c = tab[16 + e]; tab[e] = ts; ts += (c + 255) >> 8; } tab[8] = ts; }
    __syncthreads();
}
__device__ __forceinline__ void final_phase(Frame& F) {
    typedef unsigned u32x2 __attribute__((ext_vector_type(2)));
    f32x4 g[4]; load_gain(F.in[I_FINAL_NORM], g, F.lane);
    const LAS int* tab = (const LAS int*)(F.lds + LDSCTL_OFF);
    const bf16* Y = (const bf16*)(F.ws + WS_Y); const bf16* HBc = (const bf16*)(F.ws + WS_HB); const unsigned* INV = (const unsigned*)(F.ws + WS_INV); const float* GT = (const float*)(F.ws + WS_GATE);
    const int gw = F.vcu * NWAVES + F.wave, NGW = F.G * NWAVES, nrow = (M - gw + NGW - 1) / NGW;
    for (int k0 = 0; k0 < nrow; k0 += 32) {
        const int kk = k0 + (F.lane >> 1); const bool okl = kk < nrow; const int ml = gw + kk * NGW;
        const unsigned ivl = okl ? INV[ml * 2 + (F.lane & 1)] : 0u; const float gtl = okl ? GT[ml * 2 + (F.lane & 1)] : 0.f;
        const int nb = (nrow - k0) < 32 ? (nrow - k0) : 32;
        u32x2 hw[4], ya[4], yb[4]; float g0 = 0.f, g1 = 0.f;
        auto issue = [&](int k, u32x2 (&h_)[4], u32x2 (&a_)[4], u32x2 (&b_)[4], float& g0_, float& g1_) {
            const unsigned i0 = __shfl(ivl, 2 * k), i1 = __shfl(ivl, 2 * k + 1); g0_ = __shfl(gtl, 2 * k); g1_ = __shfl(gtl, 2 * k + 1);
            const size_t r0 = (size_t)tab[i0 >> 20] * 256 + (i0 & 0xfffffu), r1 = (size_t)tab[i1 >> 20] * 256 + (i1 & 0xfffffu); const int m = gw + (k0 + k) * NGW;
            const GAS u32x2* xr = (const GAS u32x2*)(HBc + (size_t)m * D) + F.lane; const GAS u32x2* y0 = (const GAS u32x2*)(Y + r0 * D) + F.lane; const GAS u32x2* y1 = (const GAS u32x2*)(Y + r1 * D) + F.lane;
#pragma unroll
            for (int j = 0; j < 4; ++j) { h_[j] = xr[64 * j]; a_[j] = y0[64 * j]; b_[j] = y1[64 * j]; } };
        issue(0, hw, ya, yb, g0, g1);
        for (int k = 0; k < nb; ++k) {
            u32x2 hn[4] = {}, an[4] = {}, bn[4] = {}; float g0n = 0.f, g1n = 0.f;
            if (k + 1 < nb) issue(k + 1, hn, an, bn, g0n, g1n);
            f32x4 v[4]; float s = 0.f;
#pragma unroll
            for (int j = 0; j < 4; ++j) { const u32x2 a = ya[j], b = yb[j];
                v[j].x = pg8::h_lo(hw[j].x) + g0 * bf_lo(a.x) + g1 * bf_lo(b.x); v[j].y = pg8::h_hi(hw[j].x) + g0 * bf_hi(a.x) + g1 * bf_hi(b.x);
                v[j].z = pg8::h_lo(hw[j].y) + g0 * bf_lo(a.y) + g1 * bf_lo(b.y); v[j].w = pg8::h_hi(hw[j].y) + g0 * bf_hi(a.y) + g1 * bf_hi(b.y);
                s += (v[j].x * v[j].x + v[j].y * v[j].y) + (v[j].z * v[j].z + v[j].w * v[j].w); }
            const float rstd = 1.0f / sqrtf(wave_sum(s) * (1.f / D) + RMS_EPS);
            GAS f32x4* o = (GAS f32x4*)(F.out + (size_t)(gw + (k0 + k) * NGW) * D) + F.lane;
#pragma unroll
            for (int j = 0; j < 4; ++j) o[64 * j] = v[j] * rstd * g[j];
#pragma unroll
            for (int j = 0; j < 4; ++j) { hw[j] = hn[j]; ya[j] = an[j]; yb[j] = bn[j]; }
            g0 = g0n; g1 = g1n;
        }
    }
}
__device__ __forceinline__ int probe_two() { int n = 2; asm volatile("" : "+s"(n)); return n; }
struct Args { const float* in[19]; float* out; unsigned char* ws; int ph_lo, ph_hi; };
__global__ void __launch_bounds__(NWAVES * 64, 2) mk_fwd(Args args) {
    extern __shared__ __attribute__((aligned(16))) unsigned char lds[];
    Frame F;
    F.lds = (LAS unsigned char*)lds;
    F.MISC = (volatile LAS unsigned*)(F.lds + MISC_OFF);
    F.tid = threadIdx.x; F.lane = F.tid & 63; F.wave = __builtin_amdgcn_readfirstlane(F.tid >> 6);
    F.G = gridDim.x; { const int bx = blockIdx.x; F.vcu = (F.G % 8 == 0) ? (bx % 8) * (F.G / 8) + bx / 8 : bx; }
    F.ws = args.ws; F.out = args.out; F.ctl = (gu32*)(args.ws + WS_CTL);
    F.in = args.in;
    { int t0_ = F.tid; asm volatile("" : "+v"(t0_));
      for (int u = t0_; u < (LDS_BYTES - LDSCTL_OFF) / 4; u += NWAVES * 64) ((LAS unsigned*)(F.lds + LDSCTL_OFF))[u] = 0u; }
    __syncthreads();
    XcdBarrier bar; bar.bar = (unsigned*)(F.ctl + CW_BAR); bar.x = 0; bar.st = nullptr;
    if (!MK_PER_PHASE) bar = xcd_barrier_post((unsigned*)(F.ctl + CW_BAR), F.MISC + 8);
#define GRID_BAR() do { if (!MK_PER_PHASE) xcd_barrier(bar); } while (0)
    const int lo = args.ph_lo, hi = args.ph_hi;
#ifndef PH_MASK
#define PH_MASK 0x1ffff
#endif
#define IN(k) (((PH_MASK >> (k)) & 1) && lo <= (k) && (k) < hi)
#define BOTH(k) (IN(k) && IN((k) + 1))
#ifndef PROBE_PH
#define PROBE_PH (-1)
#endif
#define REP_BEGIN(k) for (int rep_ = 0, nrep_ = ((k) == PROBE_PH ? probe_two() : 1); rep_ < nrep_; ++rep_) {
#define REP_END(k) if (rep_ + 1 < nrep_) GRID_BAR(); }
    bf16* XN = (bf16*)(F.ws + WS_XN); bf16* QO = (bf16*)(F.ws + WS_QO); bf16* KB = (bf16*)(F.ws + WS_K); bf16* VB = (bf16*)(F.ws + WS_V); bf16* HID = (bf16*)(F.ws + WS_HID); bf16* OB = (bf16*)(F.ws + WS_O); bf16* HB = (bf16*)(F.ws + WS_HB);
    const int bx = (int)blockIdx.x;
#ifndef PROBE_T
#define PROBE_T (-1)
#endif
#ifndef PROBE_MULT
#define PROBE_MULT 8
#endif
    unsigned long long pt0_ = 0ull;
#define PH_T0(k) do { if ((k) == PROBE_T) pt0_ = __builtin_amdgcn_s_memrealtime(); } while (0)
#define PH_SPIN(k) do { if ((k) == PROBE_T) { const unsigned long long d_ = __builtin_amdgcn_s_memrealtime() - pt0_; while (__builtin_amdgcn_s_memrealtime() - pt0_ < (1ull + PROBE_MULT) * d_) __builtin_amdgcn_s_sleep(8); } } while (0)
#define REFRESH_F() do { int t_ = threadIdx.x; asm volatile("" : "+v"(t_)); F.tid = t_; F.lane = t_ & 63; } while (0)

    if (IN(0)) { PH_T0(0); REP_BEGIN(0) p0_prologue(F); __syncthreads(); weight_copies(F, 0, N_EARLY, F.vcu * NWAVES + F.wave, F.G * NWAVES); REP_END(0) PH_SPIN(0); if (BOTH(0)) GRID_BAR(); }
    if (IN(1)) {
        PH_T0(1); p1_scan_fixup(F);
        REP_BEGIN(1)
        typedef pg8::DenseSched<D, M / 256, NQKV / 256> Sc; typedef pg8::EpiBf16<D, D> Ep;
        Sc S{F.G, bx, (const char*)(F.ws + WS_WQKV)}; Ep E{QO, (size_t)(WS_K - WS_QO) / 2, QSCALE, (unsigned*)(F.ctl + CW_NRM), SEQ};
        pg8::gemm_phase<D, Ep, Sc, true, true>(F.lds + RING_OFF, (const char*)XN, S, E);
        REP_END(1)
        PH_SPIN(1); if (BOTH(1)) GRID_BAR();
    }
    if (IN(2)) {
        PH_T0(2);
        if (((bx >> 3) & 7) == 0 && F.G == 256) { weight_copies(F, N_EARLY, NITEMS, ((bx >> 6) * 8 + (bx & 7)) * NWAVES + F.wave, 32 * NWAVES); __syncthreads(); }
        else if (F.G != 256) { weight_copies(F, N_EARLY, NITEMS, F.vcu * NWAVES + F.wave, F.G * NWAVES); __syncthreads(); }
        REP_BEGIN(2)
        ATTN_PHASE_BODY
        REP_END(2)
        PH_SPIN(2); if (BOTH(2)) GRID_BAR();
    }
    if (IN(3)) {
        PH_T0(3);
        REP_BEGIN(3)
        typedef pg8::DenseSched<D, M / 256, D / 256> Sc; typedef pg8::EpiResH16<D, false, true> Ep;
        Sc S{F.G, bx, (const char*)(F.ws + WS_WO)}; Ep E{F.in[I_X], HB, (float*)(F.ws + WS_SS)};
        pg8::gemm_phase<D, Ep, Sc, true, true>(F.lds + RING_OFF, (const char*)OB, S, E);
        REP_END(3)
        PH_SPIN(3); if (BOTH(3)) GRID_BAR();
    }
    if (IN(5)) {
        PH_T0(5);
        REP_BEGIN(5)
        typedef pg8::DenseSched<D, M / 256, 2 * FF / 256> Sc; typedef pg8::EpiSwiGLU<FF, true> Ep;
        Sc S{F.G, bx, (const char*)(F.ws + WS_WGU)}; Ep E{HID, pg8::RowScale{(const float*)(F.ws + WS_SS), (PG8_LAS float*)(F.lds + RSTAB_OFF), -1, 1.0f / D, RMS_EPS}};
        pg8::gemm_phase<D, Ep, Sc, true, true, 2>(F.lds + RING_OFF, (const char*)HB, S, E);
        REP_END(5)
        PH_SPIN(5); if (BOTH(5)) GRID_BAR();
    }
    if (IN(6)) {
        PH_T0(6);
        typedef pg8::DenseSched<FF, M / 256, D / 256> Sc; typedef pg8::EpiResH16<D, true, true> Ep;
        Sc S{F.G, bx, (const char*)(F.ws + WS_WD)}; Ep E{HB, HB, (float*)(F.ws + WS_SS)};
        pg8::gemm_phase<FF, Ep, Sc, true, true>(F.lds + RING_OFF, (const char*)HID, S, E);
        PH_SPIN(6); if (BOTH(6)) GRID_BAR();
    }
    if (IN(8)) {
        PH_T0(8);
        REP_BEGIN(8)
        typedef pg8::ConvSched<D, M / 256, D, SEQ / 256> Sc; typedef pg8::EpiConvIn<D> Ep;
        Sc S{F.G, bx, (const char*)(F.ws + WS_WCIN), KB, QO, VB, F.in[I_CONV_W], (float*)(F.ws + WS_ZP), (float*)(F.ws + WS_BGB)}; Ep E{KB, QO, pg8::RowScale{(const float*)(F.ws + WS_SS), (PG8_LAS float*)(F.lds + RSTAB_OFF), -1, 1.0f / D, RMS_EPS}};
        pg8::gemm_phase<D, Ep, Sc, true, true, 2>(F.lds + RING_OFF, (const char*)HB, S, E);
        REP_END(8)
        PH_SPIN(8); if (BOTH(8)) GRID_BAR();
    }
    if (IN(10)) {
        PH_T0(10); REFRESH_F();
        { pg8::Unit u0_; pg8::DenseSched<D, M / 256, D / 256> S0{F.G, bx, nullptr}; for (int i = 0; S0.next(i, u0_); ++i) conv_fixup(F, u0_.pm); VM_WAIT(); __syncthreads(); }
        typedef pg8::DenseSched<D, M / 256, D / 256> Sc; typedef pg8::EpiResH16<D, true, false> Ep;
        Sc S{F.G, bx, (const char*)(F.ws + WS_WCO)}; Ep E{HB, HB, nullptr};
        pg8::gemm_phase<D, Ep, Sc, true, true>(F.lds + RING_OFF, (const char*)VB, S, E);
        PH_SPIN(10); if (BOTH(10)) GRID_BAR();
    }
    if (IN(11)) { PH_T0(11); REFRESH_F(); route_phase(F); PH_SPIN(11); if (BOTH(11)) GRID_BAR(); }
    {
        const int* list = (const int*)(F.ws + WS_LIST); const PG8_LAS int* tab = (const PG8_LAS int*)(F.lds + LDSCTL_OFF);
        if (IN(12)) {
            PH_T0(12); REFRESH_F(); moe_table(F);
            REP_BEGIN(12)
            typedef pg8::MoeSched<true, D / 2, 2 * FF / 256, M> Sc; typedef pg8::EpiSwiGLU8<FF> Ep;
            Sc S{F.G, bx, (const char*)(F.ws + WS_MGU8), tab, list, (const PG8_LAS unsigned short*)(F.lds + GTOK_OFF)}; Ep E{F.ws + WS_HID8};
            S.fill_gtok((PG8_LAS unsigned short*)(F.lds + GTOK_OFF), GTOK_UNITS);
            pg8::gemm_phase<D / 2, Ep, Sc, true, true, 1>(F.lds + RING_OFF, (const char*)(F.ws + WS_XN8), S, E);
            REP_END(12)
            PH_SPIN(12); if (BOTH(12)) GRID_BAR();
        }
        if (IN(13)) {
            PH_T0(13); REFRESH_F(); moe_table(F);
            typedef pg8::MoeSched<false, FF / 2, D / 256, M> Sc; typedef pg8::EpiY8<D> Ep;
            Sc S{F.G, bx, (const char*)(F.ws + WS_MD8), tab, list, nullptr}; Ep E{(bf16*)(F.ws + WS_Y)};
            pg8::gemm_phase<FF / 2, Ep, Sc, true, true, 1>(F.lds + RING_OFF, (const char*)(F.ws + WS_HID8), S, E);
            PH_SPIN(13); if (BOTH(13)) GRID_BAR();
        }
    }
    if (IN(14)) { PH_T0(14); REFRESH_F(); moe_table(F); final_phase(F); PH_SPIN(14); }
#undef IN
#undef BOTH
#undef GRID_BAR
}

extern "C" void kernel_launch(void* const* d_in, const int* in_sizes, int n_in, void* d_out, int out_size, void* d_ws, size_t ws_size, hipStream_t stream) {
    static int grid = 0;
    if (grid == 0) {
        if (n_in != 19 || in_sizes[0] != M * D || out_size != M * D || ws_size < WS_END) { fprintf(stderr, "kernel_launch: built for 19 inputs, x and out of %d floats, >= %zu bytes of workspace; got n_in %d, in0 %d, out %d, ws %zu; nothing launched\n", M * D, (size_t)WS_END, n_in, n_in > 0 ? in_sizes[0] : -1, out_size, ws_size); grid = -1; return; }
        int dev = 0, cus = 0, per_cu = 0;
        if (hipGetDevice(&dev) != hipSuccess || hipDeviceGetAttribute(&cus, hipDeviceAttributeMultiprocessorCount, dev) != hipSuccess) { fprintf(stderr, "kernel_launch: hipGetDevice / hipDeviceGetAttribute failed; nothing launched\n"); grid = -1; return; }
        if (hipFuncSetAttribute((const void*)mk_fwd, hipFuncAttributeMaxDynamicSharedMemorySize, LDS_BYTES) != hipSuccess) { fprintf(stderr, "kernel_launch: hipFuncSetAttribute failed; nothing launched\n"); grid = -1; return; }
        if (hipOccupancyMaxActiveBlocksPerMultiprocessor(&per_cu, (const void*)mk_fwd, NWAVES * 64, LDS_BYTES) != hipSuccess || per_cu < 1)
            fprintf(stderr, "kernel_launch: note: the occupancy query reports %d workgroups per CU\n", per_cu);
        (void)hipGetLastError();
        grid = cus;
    }
    if (grid < 0) return;
    if (hipMemsetAsync((char*)d_ws + WS_CTL, 0, CTL_ZERO_BYTES, stream) != hipSuccess) { fprintf(stderr, "kernel_launch: hipMemsetAsync of the control words failed; nothing launched\n"); return; }
    Args a{};
    for (int i = 0; i < 19; ++i) a.in[i] = (const float*)d_in[i];
    a.out = (float*)d_out; a.ws = (unsigned char*)d_ws;
    const int nl = MK_PER_PHASE ? N_PHASES : 1;
    for (int li = 0; li < nl; ++li) {
        a.ph_lo = MK_PER_PHASE ? li : 0; a.ph_hi = MK_PER_PHASE ? li + 1 : N_PHASES;
        hipLaunchKernelGGL(mk_fwd, dim3(grid), dim3(NWAVES * 64), LDS_BYTES, stream, a);
        const hipError_t le = hipPeekAtLastError();
        if (le != hipSuccess) { fprintf(stderr, "kernel_launch: launch %d failed: %s\n", li, hipGetErrorName(le)); break; }
    }
}
```

```cpp
#include <hip/hip_runtime.h>
#include <hip/hip_bf16.h>
#include <cstdio>
#include <cstdint>
#include <cmath>
namespace pg8 {
#define PG8_LAS __attribute__((address_space(3)))
typedef unsigned short bf16_t;
typedef short bf16x8 __attribute__((ext_vector_type(8)));
typedef float f32x4 __attribute__((ext_vector_type(4)));
typedef float f32x2 __attribute__((ext_vector_type(2)));
typedef unsigned u32x4 __attribute__((ext_vector_type(4)));
typedef int i32x4 __attribute__((ext_vector_type(4)));
typedef int i32x8 __attribute__((ext_vector_type(8)));
typedef _Float16 f16x8 __attribute__((ext_vector_type(8)));
typedef _Float16 f16x2 __attribute__((ext_vector_type(2)));
typedef unsigned u32x2 __attribute__((ext_vector_type(2)));
constexpr int BM = 256, BK = 64, HALF = 128, HTB = HALF * BK * 2  , STAGE_BYTES = 8 * HTB, NXCD = 8, WGM = 8;

__host__ __device__ __forceinline__ int lds_byte(int r, int c) { const int st = (r >> 4) * 2 + (c >> 5), rr = r & 15, cc = c & 31, ob = rr * 64 + cc * 2; return st * 1024 + (ob ^ (((ob >> 9) & 1) << 5)); }
__host__ __device__ __forceinline__ void stage_rc(int b, int& R, int& C) { const int st = b / 1024, sb = b % 1024, swz = sb ^ (((sb >> 9) & 1) << 5); R = (st >> 1) * 16 + swz / 64; C = (st & 1) * 32 + (swz % 64) / 2; }
__host__ __device__ __forceinline__ int perm32(int rho) { const int n = rho >> 4, i = rho & 15; return 8 * (i >> 2) + 4 * n + (i & 3); }

struct Unit { int pm, pn, e, lrow0, ui; };

__device__ __forceinline__ bool tile_order(int i, int G, int c, int nM, int nN, int& pm, int& pn) {
    const int nwg = nM * nN; const long L = (long)i * G + c; if (L >= nwg) return false;
    int wgid = (int)L; { const int q = nwg / NXCD, r = nwg % NXCD, xcd = wgid % NXCD, off = wgid / NXCD; wgid = (xcd < r ? xcd * (q + 1) : r * (q + 1) + (xcd - r) * q) + off; }
    const int nig = WGM * nN, gid = wgid / nig, fm = gid * WGM, gsz = (nM - fm) < WGM ? (nM - fm) : WGM;
    pm = fm + ((wgid % nig) % gsz); pn = (wgid % nig) / gsz; return true;
}
template <int K, int nM, int nN> struct DenseSched {
    int G, c; const char* Bt;
    __device__ __forceinline__ bool next(int i, Unit& u) const { u.e = 0; u.lrow0 = 0; u.ui = i; return tile_order(i, G, c, nM, nN, u.pm, u.pn); }
    __device__ __forceinline__ unsigned a_off(const Unit& u, int r) const { return (unsigned)(u.pm * BM + r) * (unsigned)(K * 2); }
    __device__ __forceinline__ const char* b_ptr(const Unit& u) const { return Bt + (size_t)u.pn * BM * K * 2; }
    __device__ __forceinline__ void a_ready(const Unit&) const {}
    __device__ __forceinline__ void done(const Unit&) const {}
};
__device__ __forceinline__ unsigned cvt_pk_bf16(float lo, float hi);
template <int K, int nM, int ldc, int tiles_per_seq> struct ConvSched {
    int G, c; const char* Bt; const bf16_t* U; const bf16_t* Bg; bf16_t* Z; const float* cw; float* zp; float* bgb;
    __device__ __forceinline__ bool next(int i, Unit& u) const { const int tr = i / 3, sub = i - 3 * tr; int pm, a; if (!tile_order(tr, G, c, nM, 4, pm, a)) return false;
        u.pm = pm; u.pn = sub < 2 ? 2 * a + sub : 8 + a; u.e = 0; u.lrow0 = 0; u.ui = i; return true; }
    __device__ __forceinline__ unsigned a_off(const Unit& u, int r) const { return (unsigned)(u.pm * BM + r) * (unsigned)(K * 2); }
    __device__ __forceinline__ const char* b_ptr(const Unit& u) const { return Bt + (size_t)u.pn * BM * K * 2; }
    __device__ __forceinline__ void a_ready(const Unit&) const {}
    __device__ __forceinline__ void done(const Unit& u) const {
        if (u.pn < 8) return;
        asm volatile("s_waitcnt vmcnt(0)" ::: "memory"); __builtin_amdgcn_s_barrier(); asm volatile("" ::: "memory");
        int t = threadIdx.x; asm volatile("" : "+v"(t));
        const int cg = t & 31, rsl = t >> 5, col = (u.pn - 8) * BM + 8 * cg, r0 = 16 * rsl; const size_t g0 = (size_t)u.pm * BM + r0;
        const bool seam = (u.pm % tiles_per_seq) != 0;
        float w0[8], w1[8], w2[8];
#pragma unroll
        for (int i = 0; i < 8; ++i) { w0[i] = cw[col + i]; w1[i] = cw[ldc + col + i]; w2[i] = cw[2 * ldc + col + i]; }
        u32x4 u1 = (u32x4){0u, 0u, 0u, 0u}, u2 = (u32x4){0u, 0u, 0u, 0u};
        if (r0 > 0) { u1 = *(const u32x4*)(U + (g0 - 1) * ldc + col); u2 = *(const u32x4*)(U + (g0 - 2) * ldc + col); }
#pragma unroll 1
        for (int rb = 0; rb < 16; rb += 4) { u32x4 uu[4], bb[4];
#pragma unroll
            for (int k = 0; k < 4; ++k) { uu[k] = *(const u32x4*)(U + (g0 + rb + k) * ldc + col); bb[k] = *(const u32x4*)(Bg + (g0 + rb + k) * ldc + col); }
#pragma unroll
            for (int k = 0; k < 4; ++k) { float zf[8], gf[8]; u32x4 o;
#pragma unroll
                for (int j = 0; j < 4; ++j) {
                    const float b0 = __uint_as_float(bb[k][j] << 16), b1 = __uint_as_float(bb[k][j] & 0xffff0000u);
                    const float c0 = w0[2 * j] * __uint_as_float(u2[j] << 16) + w1[2 * j] * __uint_as_float(u1[j] << 16) + w2[2 * j] * __uint_as_float(uu[k][j] << 16);
                    const float c1 = w0[2 * j + 1] * __uint_as_float(u2[j] & 0xffff0000u) + w1[2 * j + 1] * __uint_as_float(u1[j] & 0xffff0000u) + w2[2 * j + 1] * __uint_as_float(uu[k][j] & 0xffff0000u);
                    zf[2 * j] = b0 * c0; zf[2 * j + 1] = b1 * c1; gf[2 * j] = b0; gf[2 * j + 1] = b1; o[j] = cvt_pk_bf16(zf[2 * j], zf[2 * j + 1]); }
                *(u32x4*)(Z + (g0 + rb + k) * ldc + col) = o;
                if (seam && r0 + rb + k < 2) { float* p = zp + ((size_t)u.pm * 2 + rb + k) * ldc + col; float* q = bgb + ((size_t)u.pm * 2 + rb + k) * ldc + col;
                    *(f32x4*)p = (f32x4){zf[0], zf[1], zf[2], zf[3]}; *(f32x4*)(p + 4) = (f32x4){zf[4], zf[5], zf[6], zf[7]}; *(f32x4*)q = (f32x4){gf[0], gf[1], gf[2], gf[3]}; *(f32x4*)(q + 4) = (f32x4){gf[4], gf[5], gf[6], gf[7]}; }
                u2 = u1; u1 = uu[k]; } }
    }
};
template <bool GATHER, int K, int nN, int ntok> struct MoeSched {
    static constexpr size_t estride = (size_t)nN * BM * K * 2;
    int G, c; const char* Bt; const PG8_LAS int* tab; const int* list; const PG8_LAS unsigned short* gtok;
    __device__ __forceinline__ bool next(int i, Unit& u) const {
        const int nM = __builtin_amdgcn_readfirstlane(tab[8]); if (!tile_order(i, G, c, nM, nN, u.pm, u.pn)) return false;
        int e = 0;
#pragma unroll
        for (int j = 1; j < 8; ++j) e += (u.pm >= __builtin_amdgcn_readfirstlane(tab[j])) ? 1 : 0;
        u.e = e; u.lrow0 = (u.pm - __builtin_amdgcn_readfirstlane(tab[e])) * BM; u.ui = i; return true;
    }
    __device__ __forceinline__ unsigned a_off(const Unit& u, int r) const {
        if (GATHER) return (unsigned)gtok[u.ui * BM + r] * (unsigned)(K * 2);
        return (unsigned)(u.pm * BM + r) * (unsigned)(K * 2);
    }
    __device__ __forceinline__ const char* b_ptr(const Unit& u) const { return Bt + (size_t)u.e * estride + (size_t)u.pn * BM * K * 2; }
    __device__ __forceinline__ void a_ready(const Unit&) const {}
    __device__ __forceinline__ void done(const Unit&) const {}
    __device__ __forceinline__ void fill_gtok(PG8_LAS unsigned short* g, int max_units) const {
        const int t = (int)threadIdx.x & (BM - 1), par = __builtin_amdgcn_readfirstlane((int)threadIdx.x >> 8);
        for (int i0 = 0; i0 < max_units; i0 += 16) { int v[8]; bool okk[8];
#pragma unroll
            for (int k = 0; k < 8; ++k) { Unit u; const int i = i0 + 2 * k + par; okk[k] = i < max_units && next(i, u); v[k] = 0;
                if (okk[k]) { const int cnt = __builtin_amdgcn_readfirstlane(tab[16 + u.e]); const int lr = u.lrow0 + t; if (lr < cnt) v[k] = list[(size_t)u.e * ntok + lr]; } }
#pragma unroll
            for (int k = 0; k < 8; ++k) if (okk[k]) g[(i0 + 2 * k + par) * BM + t] = (unsigned short)v[k]; }
        __syncthreads();
    }
};

__device__ __forceinline__ unsigned cvt_pk_bf16(float lo, float hi) { unsigned r; asm volatile("v_cvt_pk_bf16_f32 %0, %1, %2" : "=v"(r) : "v"(lo), "v"(hi)); return r; }
__device__ __forceinline__ unsigned pk2h(float lo, float hi) { const f16x2 v = {(_Float16)lo, (_Float16)hi}; return __builtin_bit_cast(unsigned, v); }
__device__ __forceinline__ float h_lo(unsigned w) { return (float)__builtin_bit_cast(f16x2, w)[0]; }
__device__ __forceinline__ float h_hi(unsigned w) { return (float)__builtin_bit_cast(f16x2, w)[1]; }
__device__ __forceinline__ float swiglu_raw(float ag, float au, float c1, float c2) { const float e = __builtin_amdgcn_exp2f(ag * c1); return (ag * au) * __builtin_amdgcn_rcpf(__builtin_fmaf(e, c2, c2)); }
__device__ __forceinline__ f32x4 swiglu_raw4(f32x4 ag, f32x4 au, float c1, float c2) {
    const f32x4 t = ag * c1; f32x4 e; e[0] = __builtin_amdgcn_exp2f(t[0]); e[1] = __builtin_amdgcn_exp2f(t[1]); e[2] = __builtin_amdgcn_exp2f(t[2]); e[3] = __builtin_amdgcn_exp2f(t[3]);
    const f32x4 d = e * c2 + c2; f32x4 q; q[0] = __builtin_amdgcn_rcpf(d[0]); q[1] = __builtin_amdgcn_rcpf(d[1]); q[2] = __builtin_amdgcn_rcpf(d[2]); q[3] = __builtin_amdgcn_rcpf(d[3]);
    return (ag * au) * q; }
__device__ __forceinline__ float silu_f(float g) { return g * __builtin_amdgcn_rcpf(1.0f + __builtin_amdgcn_exp2f(-1.4426950408889634f * g)); }

template <int ldc, int split_cols> struct EpiBf16 {
    static constexpr bool PERM = true;
    bf16_t* O; size_t split_stride; float scale0;
    unsigned* nrm; int rows_per_batch;
    __device__ __forceinline__ void operator()(const f32x4 (&acc)[2][2][4][2], const Unit& u, int wr, int wc, int fr, int fq) const {
        const int row0 = u.pm * BM + wr * 64 + fr; int colt = u.pn * BM; bf16_t* base = O; int tsel = 0;
        float sc = 1.f; if (split_cols) { const int t = colt / split_cols; tsel = t; base += (size_t)t * split_stride; colt -= t * split_cols; if (t == 0) sc = scale0; }
        const int col0 = colt + wc * 32 + 8 * fq;
        if (nrm && tsel < 2) {
#pragma unroll
            for (int bj = 0; bj < 2; ++bj) { float mx = 0.f;
#pragma unroll
                for (int ai = 0; ai < 2; ++ai)
#pragma unroll
                    for (int m = 0; m < 4; ++m) { const f32x4 v0 = acc[ai][bj][m][0] * sc, v1 = acc[ai][bj][m][1] * sc;
                        float s2 = ((v0[0] * v0[0] + v0[1] * v0[1]) + (v0[2] * v0[2] + v0[3] * v0[3])) + ((v1[0] * v1[0] + v1[1] * v1[1]) + (v1[2] * v1[2] + v1[3] * v1[3]));
                        s2 += __shfl_xor(s2, 16); s2 += __shfl_xor(s2, 32); mx = fmaxf(mx, s2); }
                mx = fmaxf(mx, __shfl_xor(mx, 1)); mx = fmaxf(mx, __shfl_xor(mx, 2)); mx = fmaxf(mx, __shfl_xor(mx, 4)); mx = fmaxf(mx, __shfl_xor(mx, 8));
                const int head = (colt + bj * HALF + wc * 32) >> 6, b = (u.pm * BM) / rows_per_batch;
                if ((fr | fq) == 0) __hip_atomic_fetch_max(nrm + ((tsel * 64 + b * 16 + head) * 2 + (wc & 1)), __float_as_uint(mx), __ATOMIC_RELAXED, __HIP_MEMORY_SCOPE_AGENT); }
        }
#pragma unroll
        for (int ai = 0; ai < 2; ++ai)
#pragma unroll
            for (int m = 0; m < 4; ++m) { bf16_t* rowp = base + (size_t)(row0 + ai * HALF + m * 16) * ldc + col0;
#pragma unroll
                for (int bj = 0; bj < 2; ++bj) { const f32x4 v0 = acc[ai][bj][m][0] * sc, v1 = acc[ai][bj][m][1] * sc;
                    u32x4 w; w.x = cvt_pk_bf16(v0[0], v0[1]); w.y = cvt_pk_bf16(v0[2], v0[3]); w.z = cvt_pk_bf16(v1[0], v1[1]); w.w = cvt_pk_bf16(v1[2], v1[3]);
                    *(u32x4*)(rowp + bj * HALF) = w; } }
    }
};
struct RowScale {
    const float* ss; PG8_LAS float* tab; int last_pm; float inv_n, eps;
    __device__ __forceinline__ void prepare(int pm) {
        if (pm == last_pm) return;
        last_pm = pm;
        const int t = threadIdx.x, row = t >> 1, h = t & 1;
        const f32x4* p = (const f32x4*)(ss + ((size_t)pm * BM + row) * 16 + h * 8);
        const f32x4 a = p[0], b = p[1]; float s = ((a[0] + a[1]) + (a[2] + a[3])) + ((b[0] + b[1]) + (b[2] + b[3]));
        s += __shfl_xor(s, 1);
        asm volatile("s_waitcnt lgkmcnt(0)" ::: "memory"); __builtin_amdgcn_s_barrier(); asm volatile("" ::: "memory");
        if (h == 0) tab[row] = 1.0f / sqrtf(s * inv_n + eps);
        asm volatile("s_waitcnt lgkmcnt(0)" ::: "memory"); __builtin_amdgcn_s_barrier(); asm volatile("" ::: "memory");
    }
    __device__ __forceinline__ float get(int r) const { return tab[r]; }
};
__device__ __forceinline__ unsigned pk4_fp8(float a, float b, float c, float d) { int p = __builtin_amdgcn_cvt_pk_fp8_f32(a, b, 0, false); p = __builtin_amdgcn_cvt_pk_fp8_f32(c, d, p, true); return (unsigned)p; }
constexpr float W8_SCALE = 256.f, H8_SCALE = 4.f;
template <int ldh> struct EpiSwiGLU8 {
    static constexpr bool PERM = true;
    unsigned char* H;
    __device__ __forceinline__ void operator()(const f32x4 (&acc)[2][2][4][2], const Unit& u, int wr, int wc, int fr, int fq) {
        const int row0 = u.pm * BM + wr * 64 + fr + (fq & 1) * 16, col0 = u.pn * HALF + wc * 32 + 16 * (fq >> 1); const float c1 = -1.4426950408889634f / W8_SCALE, c2 = W8_SCALE * W8_SCALE / H8_SCALE;
#pragma unroll
        for (int ai = 0; ai < 2; ++ai)
#pragma unroll
            for (int p = 0; p < 2; ++p) { u32x2 w[2];
#pragma unroll
                for (int q = 0; q < 2; ++q) { const int m = 2 * p + q;
                    const f32x4 g0 = acc[ai][0][m][0], g1 = acc[ai][0][m][1], u0 = acc[ai][1][m][0], u1 = acc[ai][1][m][1];
                    const f32x4 o0 = swiglu_raw4(g0, u0, c1, c2), o1 = swiglu_raw4(g1, u1, c1, c2);
                    w[q].x = pk4_fp8(o0[0], o0[1], o0[2], o0[3]); w[q].y = pk4_fp8(o1[0], o1[1], o1[2], o1[3]); }
                const auto r0 = __builtin_amdgcn_permlane16_swap(w[0].x, w[1].x, false, false), r1 = __builtin_amdgcn_permlane16_swap(w[0].y, w[1].y, false, false);
                u32x4 o; o.x = r0[0]; o.y = r1[0]; o.z = r0[1]; o.w = r1[1];
                *(u32x4*)(H + (size_t)(row0 + ai * HALF + p * 32) * ldh + col0) = o; }
    }
};
template <int ldc> struct EpiY8 {
    static constexpr bool PERM = true;
    bf16_t* Y;
    __device__ __forceinline__ void operator()(const f32x4 (&acc)[2][2][4][2], const Unit& u, int wr, int wc, int fr, int fq) {
        const int row0 = u.pm * BM + wr * 64 + fr, col0 = u.pn * BM + wc * 32 + 8 * fq; const float sc = 1.0f / (W8_SCALE * H8_SCALE);
#pragma unroll
        for (int ai = 0; ai < 2; ++ai)
#pragma unroll
            for (int m = 0; m < 4; ++m) { bf16_t* rowp = Y + (size_t)(row0 + ai * HALF + m * 16) * ldc + col0;
#pragma unroll
                for (int bj = 0; bj < 2; ++bj) { const f32x4 v0 = acc[ai][bj][m][0] * sc, v1 = acc[ai][bj][m][1] * sc;
                    u32x4 w; w.x = cvt_pk_bf16(v0[0], v0[1]); w.y = cvt_pk_bf16(v0[2], v0[3]); w.z = cvt_pk_bf16(v1[0], v1[1]); w.w = cvt_pk_bf16(v1[2], v1[3]);
                    *(u32x4*)(rowp + bj * HALF) = w; } }
    }
};
template <int ldh, bool SCALED = false> struct EpiSwiGLU {
    static constexpr bool PERM = true;
    bf16_t* H; RowScale rs;
    __device__ __forceinline__ void operator()(const f32x4 (&acc)[2][2][4][2], const Unit& u, int wr, int wc, int fr, int fq) {
        const int row0 = u.pm * BM + wr * 64 + fr, col0 = u.pn * HALF + wc * 32 + 8 * fq;
        if (SCALED) rs.prepare(u.pm);
#pragma unroll
        for (int ai = 0; ai < 2; ++ai)
#pragma unroll
            for (int m = 0; m < 4; ++m) { bf16_t* rowp = H + (size_t)(row0 + ai * HALF + m * 16) * ldh + col0;
                const float r = SCALED ? rs.get(ai * HALF + wr * 64 + m * 16 + fr) : 1.0f, c1 = -1.4426950408889634f * r, c2 = __builtin_amdgcn_rcpf(r * r);
                const f32x4 g0 = acc[ai][0][m][0], g1 = acc[ai][0][m][1], u0 = acc[ai][1][m][0], u1 = acc[ai][1][m][1];
                const f32x4 o0 = swiglu_raw4(g0, u0, c1, c2), o1 = swiglu_raw4(g1, u1, c1, c2);
                u32x4 w; w.x = cvt_pk_bf16(o0[0], o0[1]); w.y = cvt_pk_bf16(o0[2], o0[3]); w.z = cvt_pk_bf16(o1[0], o1[1]); w.w = cvt_pk_bf16(o1[2], o1[3]);
                *(u32x4*)rowp = w; }
    }
};
template <int ldc> struct EpiConvIn {
    static constexpr bool PERM = true;
    bf16_t* U; bf16_t* Bg; RowScale rs;
    __device__ __forceinline__ void operator()(const f32x4 (&acc)[2][2][4][2], const Unit& u, int wr, int wc, int fr, int fq) {
        const int row0 = u.pm * BM + wr * 64 + fr;
        rs.prepare(u.pm);
        if (u.pn < 8) {
            const int col0 = u.pn * HALF + wc * 32 + 8 * fq;
#pragma unroll
            for (int ai = 0; ai < 2; ++ai)
#pragma unroll
                for (int m = 0; m < 4; ++m) { bf16_t* rowp = U + (size_t)(row0 + ai * HALF + m * 16) * ldc + col0;
                    const float r = rs.get(ai * HALF + wr * 64 + m * 16 + fr), r2 = r * r;
                    const f32x4 a0 = acc[ai][0][m][0] * acc[ai][1][m][0] * r2, a1 = acc[ai][0][m][1] * acc[ai][1][m][1] * r2;
                    u32x4 w; w.x = cvt_pk_bf16(a0[0], a0[1]); w.y = cvt_pk_bf16(a0[2], a0[3]); w.z = cvt_pk_bf16(a1[0], a1[1]); w.w = cvt_pk_bf16(a1[2], a1[3]);
                    *(u32x4*)rowp = w; }
        } else {
            const int col0 = (u.pn - 8) * BM + wc * 32 + 8 * fq;
#pragma unroll
            for (int ai = 0; ai < 2; ++ai)
#pragma unroll
                for (int m = 0; m < 4; ++m) { bf16_t* rowp = Bg + (size_t)(row0 + ai * HALF + m * 16) * ldc + col0; const float r = rs.get(ai * HALF + wr * 64 + m * 16 + fr);
#pragma unroll
                    for (int bj = 0; bj < 2; ++bj) { const f32x4 v0 = acc[ai][bj][m][0] * r, v1 = acc[ai][bj][m][1] * r;
                        u32x4 w; w.x = cvt_pk_bf16(v0[0], v0[1]); w.y = cvt_pk_bf16(v0[2], v0[3]); w.z = cvt_pk_bf16(v1[0], v1[1]); w.w = cvt_pk_bf16(v1[2], v1[3]);
                        *(u32x4*)(rowp + bj * HALF) = w; } }
        }
    }
};
template <int ldc, bool BASE16, bool STATS> struct EpiResH16 {
    static constexpr bool PERM = true;
    const void* base; unsigned short* hb; float* ss;
    __device__ __forceinline__ void operator()(f32x4 (&acc)[2][2][4][2], const Unit& u, int wr, int wc, int fr, int fq) const {
        const int row0 = u.pm * BM + wr * 64 + fr, col0 = u.pn * BM + wc * 32 + 8 * fq;
#pragma unroll
        for (int ai = 0; ai < 2; ++ai) { f32x4 pre[4][2][2];
#pragma unroll
            for (int m = 0; m < 4; ++m)
#pragma unroll
                for (int bj = 0; bj < 2; ++bj) { const size_t off = (size_t)(row0 + ai * HALF + m * 16) * ldc + col0 + bj * HALF;
                    if (BASE16) pre[m][bj][0] = __builtin_bit_cast(f32x4, *(const u32x4*)((const unsigned short*)base + off));
                    else { pre[m][bj][0] = *(const f32x4*)((const float*)base + off); pre[m][bj][1] = *(const f32x4*)((const float*)base + off + 4); } }
            asm volatile("s_waitcnt vmcnt(0)" ::: "memory");
#pragma unroll
            for (int m = 0; m < 4; ++m) { const int row = row0 + ai * HALF + m * 16; const size_t off = (size_t)row * ldc + col0; float s = 0.f;
#pragma unroll
                for (int bj = 0; bj < 2; ++bj) { f32x4 b0, b1;
                    if (BASE16) { const u32x4 w = __builtin_bit_cast(u32x4, pre[m][bj][0]); b0 = (f32x4){h_lo(w.x), h_hi(w.x), h_lo(w.y), h_hi(w.y)}; b1 = (f32x4){h_lo(w.z), h_hi(w.z), h_lo(w.w), h_hi(w.w)}; }
                    else { b0 = pre[m][bj][0]; b1 = pre[m][bj][1]; }
                    const f32x4 v0 = b0 + acc[ai][bj][m][0], v1 = b1 + acc[ai][bj][m][1];
                    if (STATS) s += ((v0[0] * v0[0] + v0[1] * v0[1]) + (v0[2] * v0[2] + v0[3] * v0[3])) + ((v1[0] * v1[0] + v1[1] * v1[1]) + (v1[2] * v1[2] + v1[3] * v1[3]));
                    u32x4 w; w.x = pk2h(v0[0], v0[1]); w.y = pk2h(v0[2], v0[3]); w.z = pk2h(v1[0], v1[1]); w.w = pk2h(v1[2], v1[3]);
                    *(u32x4*)(hb + off + bj * HALF) = w; }
                if (STATS) { s += __shfl_xor(s, 16); s += __shfl_xor(s, 32); if (fq == 0) ss[(size_t)row * 16 + u.pn * 4 + wc] = s; } }
            asm volatile("" ::: "memory"); }
    }
};
template <int ldc, int ntok> struct EpiMoeDown {
    static constexpr bool PERM = false;
    float* out; const int* list; const float* glist; const PG8_LAS int* tab;
    __device__ __forceinline__ void operator()(const f32x4 (&acc)[2][2][4][2], const Unit& u, int wr, int wc, int fr, int fq) const {
        const int col0 = u.pn * BM + wc * 32 + 4 * fq, cnt = __builtin_amdgcn_readfirstlane(tab[16 + u.e]); const size_t lb = (size_t)u.e * ntok;
#pragma unroll
        for (int ai = 0; ai < 2; ++ai)
#pragma unroll
            for (int m = 0; m < 4; ++m) { const int lr = u.lrow0 + ai * HALF + wr * 64 + m * 16 + fr;
                if (lr < cnt) { const int tok = list[lb + lr]; const float g = glist[lb + lr]; const size_t off = (size_t)tok * ldc + col0;
#pragma unroll
                    for (int bj = 0; bj < 2; ++bj)
#pragma unroll
                        for (int n = 0; n < 2; ++n) { const f32x4 b = *(const f32x4*)(out + off + bj * HALF + n * 16); *(f32x4*)(out + off + bj * HALF + n * 16) = b + acc[ai][bj][m][n] * g; } }
                asm volatile("" ::: "memory"); }
    }
};

template <int K, class Epi, class Sched, bool ALIGN_EPI = false, bool SP2 = false, int DT = 0>
__device__ __forceinline__ void gemm_phase(PG8_LAS unsigned char* lds, const char* Abase, const Sched& S, Epi& E) {
    constexpr bool FP8 = (DT == 1);
    const int tid = threadIdx.x, wid = __builtin_amdgcn_readfirstlane(tid >> 6), lane = tid & 63, wr = wid >> 2, wc = wid & 3, fr = lane & 15, fq = lane >> 4;
    constexpr int nt = K / BK; static_assert(K % (2 * BK) == 0 && K >= 4 * BK, "K: a multiple of 128, at least 256");
    int RA[2]; unsigned cofA[2], voffB[2];
#pragma unroll
    for (int i = 0; i < 2; ++i) { int R, C; stage_rc(tid * 16 + i * 8192, R, C); const int Rb = Epi::PERM ? ((R & ~31) + perm32(R & 31)) : R;
        RA[i] = R; cofA[i] = (unsigned)C * 2u; voffB[i] = (unsigned)(Rb * K + C) * 2u; }
    const size_t kstep = (size_t)(BK * 2);
    const size_t hstep = (size_t)HALF * K * 2;
    const unsigned ldsw = (unsigned)wid * 1024u;
    const int aoff = lds_byte(wr * 64 + fr, fq * 8), boff = lds_byte(wc * 32 + fr, fq * 8);
#define PG8_SA(b, h) (((b) * 2 + (h)) * HTB)
#define PG8_SB(b, h) ((4 + (b) * 2 + (h)) * HTB)
#define PG8_STAGE(bufoff, gbase, voff) do { _Pragma("unroll") for (int _i = 0; _i < 2; ++_i) \
        __builtin_amdgcn_global_load_lds((const unsigned*)((const char*)(gbase) + (voff)[_i]), (PG8_LAS unsigned*)(lds + (bufoff) + ldsw + _i * 8192), 16, 0, 0); } while (0)
#define PG8_LD16(off) (*(const PG8_LAS i32x4*)(lds + (off)))
#define PG8_LDA(dst, b, h) do { _Pragma("unroll") for (int m = 0; m < 4; ++m) { const i32x4 lo_ = PG8_LD16(PG8_SA(b, h) + aoff + m * 2048), hi_ = PG8_LD16(PG8_SA(b, h) + aoff + m * 2048 + 1024); \
        if constexpr (FP8) dst##8[m] = __builtin_shufflevector(lo_, hi_, 0, 1, 2, 3, 4, 5, 6, 7); else { dst[m][0] = __builtin_bit_cast(bf16x8, lo_); dst[m][1] = __builtin_bit_cast(bf16x8, hi_); } } } while (0)
#define PG8_LDB(dst, b, h) do { _Pragma("unroll") for (int n = 0; n < 2; ++n) { const i32x4 lo_ = PG8_LD16(PG8_SB(b, h) + boff + n * 2048), hi_ = PG8_LD16(PG8_SB(b, h) + boff + n * 2048 + 1024); \
        if constexpr (FP8) dst##8[n] = __builtin_shufflevector(lo_, hi_, 0, 1, 2, 3, 4, 5, 6, 7); else { dst[n][0] = __builtin_bit_cast(bf16x8, lo_); dst[n][1] = __builtin_bit_cast(bf16x8, hi_); } } } while (0)
#define PG8_MFMA_ASM(OP, ACC, B_, A_, Z) do { if constexpr (Z) asm volatile(OP " %0, %1, %2, 0" : "=&v"(ACC) : "v"(B_), "v"(A_)); else asm volatile(OP " %0, %1, %2, %0" : "+v"(ACC) : "v"(B_), "v"(A_)); } while (0)
#define PG8_MMA(ai, bj, At, Bt, Z) do { __builtin_amdgcn_s_setprio(1); \
        if constexpr (FP8) { _Pragma("unroll") for (int m = 0; m < 4; ++m) _Pragma("unroll") for (int n = 0; n < 2; ++n) PG8_MFMA_ASM("v_mfma_f32_16x16x128_f8f6f4", acc[ai][bj][m][n], Bt##8[n], At##8[m], Z); } \
        else if constexpr (DT == 2) { _Pragma("unroll") for (int m = 0; m < 4; ++m) _Pragma("unroll") for (int n = 0; n < 2; ++n) PG8_MFMA_ASM("v_mfma_f32_16x16x32_f16", acc[ai][bj][m][n], Bt[n][0], At[m][0], Z); \
                                      _Pragma("unroll") for (int m = 0; m < 4; ++m) _Pragma("unroll") for (int n = 0; n < 2; ++n) PG8_MFMA_ASM("v_mfma_f32_16x16x32_f16", acc[ai][bj][m][n], Bt[n][1], At[m][1], false); } \
        else { _Pragma("unroll") for (int m = 0; m < 4; ++m) _Pragma("unroll") for (int n = 0; n < 2; ++n) PG8_MFMA_ASM("v_mfma_f32_16x16x32_bf16", acc[ai][bj][m][n], Bt[n][0], At[m][0], Z); \
               _Pragma("unroll") for (int m = 0; m < 4; ++m) _Pragma("unroll") for (int n = 0; n < 2; ++n) PG8_MFMA_ASM("v_mfma_f32_16x16x32_bf16", acc[ai][bj][m][n], Bt[n][1], At[m][1], false); } \
        __builtin_amdgcn_s_setprio(0); } while (0)
#define PG8_WAIT_V(n) asm volatile("s_waitcnt vmcnt(" #n ")" ::: "memory")
#define PG8_WAIT_L(n) asm volatile("s_waitcnt lgkmcnt(" #n ")" ::: "memory")
#define PG8_BAR __builtin_amdgcn_s_barrier()
#define PG8_SCHED __builtin_amdgcn_sched_barrier(0)
    Unit cur, nxt; int ui = 0;
    if (!S.next(0, cur)) return;
    f32x4 acc[2][2][4][2];
    bf16x8 At[4][2], B0[2][2], B1[2][2]; i32x8 At8[4], B08[2], B18[2];
    unsigned c0[2], c1[2], n0[2], n1[2];
#pragma unroll
    for (int i = 0; i < 2; ++i) { c0[i] = S.a_off(cur, RA[i]) + cofA[i]; c1[i] = S.a_off(cur, HALF + RA[i]) + cofA[i]; }
    const char* cB = S.b_ptr(cur);
    S.a_ready(cur);
    if constexpr (SP2) {
        PG8_STAGE(PG8_SB(0, 0), cB, voffB); PG8_STAGE(PG8_SB(0, 1), cB + hstep, voffB); PG8_STAGE(PG8_SA(0, 0), Abase, c0); PG8_STAGE(PG8_SA(0, 1), Abase, c1);
        if (wr == 1) PG8_BAR;
        PG8_WAIT_V(2); PG8_BAR;
        PG8_STAGE(PG8_SB(1, 0), cB + kstep, voffB); PG8_STAGE(PG8_SA(1, 0), Abase + kstep, c0); PG8_STAGE(PG8_SB(1, 1), cB + hstep + kstep, voffB);
        PG8_WAIT_V(6); PG8_BAR;
    } else {
        PG8_STAGE(PG8_SB(0, 0), cB, voffB); PG8_STAGE(PG8_SA(0, 0), Abase, c0); PG8_STAGE(PG8_SB(0, 1), cB + hstep, voffB); PG8_STAGE(PG8_SA(0, 1), Abase, c1);
        if (wr == 1) PG8_BAR;
        PG8_WAIT_V(4); PG8_BAR;
        PG8_STAGE(PG8_SB(1, 0), cB + kstep, voffB); PG8_STAGE(PG8_SA(1, 0), Abase + kstep, c0); PG8_STAGE(PG8_SB(1, 1), cB + hstep + kstep, voffB);
        PG8_WAIT_V(6); PG8_BAR;
    }
    for (;;) {
        const bool has_next = S.next(ui + 1, nxt);
        const char* nB = cB;
#pragma unroll
        for (int i = 0; i < 2; ++i) { n0[i] = c0[i]; n1[i] = c1[i]; }
        if (has_next) { nB = S.b_ptr(nxt);
#pragma unroll
            for (int i = 0; i < 2; ++i) { n0[i] = S.a_off(nxt, RA[i]) + cofA[i]; n1[i] = S.a_off(nxt, HALF + RA[i]) + cofA[i]; } }
        static_assert(SP2, "only the two-blocks-per-barrier-pair schedule is kept");
#define PG8_ITER(T_, Z_) do { const int t = (T_); const bool last = (t == nt - 2); \
            const char* a1 = Abase + (size_t)(t + 1) * kstep;                                            \
            const char* a2 = last ? Abase : Abase + (size_t)(t + 2) * kstep; const char* b2 = last ? nB : cB + (size_t)(t + 2) * kstep;     \
            const char* a3 = a2 + kstep; const char* b3 = b2 + kstep;                                    \
            unsigned x0[2], x1[2];                                                                       \
            _Pragma("unroll") for (int i = 0; i < 2; ++i) { x0[i] = last ? n0[i] : c0[i]; x1[i] = last ? n1[i] : c1[i]; } \
            if (last && has_next) S.a_ready(nxt); \
            PG8_LDB(B0, 0, 0); PG8_LDB(B1, 0, 1); PG8_SCHED; PG8_LDA(At, 0, 0); PG8_STAGE(PG8_SA(1, 1), a1, c1); \
            PG8_WAIT_V(8); PG8_WAIT_L(0); PG8_BAR; PG8_MMA(0, 0, At, B0, Z_); PG8_MMA(0, 1, At, B1, Z_); PG8_BAR; PG8_SCHED; \
            PG8_LDA(At, 0, 1); PG8_STAGE(PG8_SB(0, 0), b2, voffB); PG8_STAGE(PG8_SB(0, 1), b2 + hstep, voffB); PG8_STAGE(PG8_SA(0, 0), a2, x0); \
            PG8_WAIT_V(8); PG8_WAIT_L(0); PG8_BAR; PG8_MMA(1, 0, At, B0, Z_); PG8_MMA(1, 1, At, B1, Z_); PG8_BAR; PG8_SCHED; \
            PG8_LDB(B0, 1, 0); PG8_LDB(B1, 1, 1); PG8_SCHED; PG8_LDA(At, 1, 0); PG8_STAGE(PG8_SA(0, 1), a2, x1); \
            PG8_WAIT_V(8); PG8_WAIT_L(0); PG8_BAR; PG8_MMA(0, 0, At, B0, false); PG8_MMA(0, 1, At, B1, false); PG8_BAR; PG8_SCHED; \
            PG8_LDA(At, 1, 1); PG8_STAGE(PG8_SB(1, 0), b3, voffB); PG8_STAGE(PG8_SB(1, 1), b3 + hstep, voffB); PG8_STAGE(PG8_SA(1, 0), a3, x0); \
            PG8_WAIT_V(8); PG8_WAIT_L(0); PG8_BAR; PG8_MMA(1, 0, At, B0, false); PG8_MMA(1, 1, At, B1, false); PG8_BAR; PG8_SCHED; } while (0)
        PG8_ITER(0, true);
#pragma unroll 1
        for (int tt = 2; tt < nt; tt += 2) PG8_ITER(tt, false);
#undef PG8_ITER
        if constexpr (ALIGN_EPI) { if (wr == 0) PG8_BAR; }
        asm volatile("s_nop 15\n\ts_nop 15" ::: "memory");
        E(acc, cur, wr, wc, fr, fq); S.done(cur);
        if (!has_next) break;
        cur = nxt; cB = nB; ++ui;
#pragma unroll
        for (int i = 0; i < 2; ++i) { c0[i] = n0[i]; c1[i] = n1[i]; }
        if constexpr (ALIGN_EPI) { if (wr == 1) PG8_BAR; }
    }
    PG8_WAIT_V(0);
    if constexpr (!ALIGN_EPI) { if (wr == 0) PG8_BAR; }
    PG8_BAR;
#undef PG8_SA
#undef PG8_SB
#undef PG8_STAGE
#undef PG8_LDA
#undef PG8_LDB
#undef PG8_MMA
#undef PG8_MFMA_ASM
#undef PG8_LD16
#undef PG8_WAIT_V
#undef PG8_WAIT_L
#undef PG8_BAR
#undef PG8_SCHED
}
}
#include <hip/hip_bf16.h>
#include <cmath>
namespace attn_body {
using bf16=__hip_bfloat16;
using bf16x8=__attribute__((ext_vector_type(8)))short;
using s16x4=__attribute__((ext_vector_type(4)))short;
using f32x16=__attribute__((ext_vector_type(16)))float;
using u32x4=__attribute__((ext_vector_type(4)))unsigned;
using f32x4_t=__attribute__((ext_vector_type(4)))float;
constexpr int BATCH=4,NHEAD=16,SEQ=8192,D=64,DM=NHEAD*D;
constexpr int NW=8,QBLK=32,QB=QBLK*NW,KVBLK=64,NQB=SEQ/QB;
constexpr int ATTN_PITCH=DM, ATTN_UNIT_ROWS=QB;
__device__ __forceinline__ int crow(int r,int hi){return (r&3)+8*(r>>2)+4*hi;}
#define SBAR() __builtin_amdgcn_sched_barrier(0)
__device__ __forceinline__ void cmask(f32x16&p0,f32x16&p1,int jb,int qrel,int hi){
  const float NEG=-INFINITY; int kb=64*jb+4*hi;
  #pragma unroll
  for(int r=0;r<16;++r){int kv=kb+(r&3)+8*(r>>2); if(kv>qrel)p0[r]=NEG; if(kv+32>qrel)p1[r]=NEG;}
}

constexpr int NSLOT=3, SLOTB=8192;
constexpr int LDS_K=0, LDS_V=NSLOT*SLOTB, LDS_WS=2*NSLOT*SLOTB, LDS_OST=LDS_WS+NW*64*4, LDS_CB=LDS_OST+NW*4096, LDS_Q=LDS_CB+SEQ*4, LDS_OK=LDS_Q+16, LDS_BYTES=LDS_OK+48;
constexpr float C2=0.125f*1.4426950408889634f;
__device__ __forceinline__ void glds16(const void*gsrc,unsigned lds_dst){unsigned keep;
  asm volatile("s_mov_b32 %0, m0\n\ts_mov_b32 m0, %2\n\ts_nop 0\n\tglobal_load_lds_dwordx4 %1, off\n\ts_mov_b32 m0, %0":"=&s"(keep):"v"(gsrc),"s"(lds_dst):"memory");}
__device__ __forceinline__ float max3f(float a,float b,float c){float r;asm("v_max3_f32 %0, %1, %2, %3":"=v"(r):"v"(a),"v"(b),"v"(c));return r;}
__device__ __forceinline__ float max2f(float a,float b){float r;asm("v_max_f32_e32 %0, %1, %2":"=v"(r):"v"(a),"v"(b));return r;}
__device__ __forceinline__ float fadd_s(float a,float b){float r;asm("v_add_f32_e32 %0, %1, %2":"=v"(r):"v"(a),"v"(b));return r;}
__device__ __forceinline__ float fsub_s(float a,float b){float r;asm("v_sub_f32_e32 %0, %1, %2":"=v"(r):"v"(a),"v"(b));return r;}
typedef float f32x2_t __attribute__((ext_vector_type(2))); typedef __bf16 bf16x2_t __attribute__((ext_vector_type(2)));
__device__ __forceinline__ unsigned cvtpk_s(float lo,float hi){f32x2_t v={lo,hi};bf16x2_t b=__builtin_convertvector(v,bf16x2_t);return __builtin_bit_cast(unsigned,b);}
#define WAIT_BAR(N) asm volatile("s_waitcnt vmcnt(" #N ") lgkmcnt(0)\n\ts_barrier":::"memory")

__device__ __forceinline__ void qkt(f32x16&p0,f32x16&p1,const char*Kslot,const bf16x8*qr,int r32,int hi){
  const char*kb=Kslot+hi*1024+r32*16;
  #pragma unroll
  for(int d0=0;d0<4;++d0){
    const bf16x8 b0=*reinterpret_cast<const bf16x8*>(kb+d0*2048);
    const bf16x8 b1=*reinterpret_cast<const bf16x8*>(kb+d0*2048+512);
    p0=__builtin_amdgcn_mfma_f32_32x32x16_bf16(b0,qr[d0],p0,0,0,0);p1=__builtin_amdgcn_mfma_f32_32x32x16_bf16(b1,qr[d0],p1,0,0,0);}
}
typedef __attribute__((address_space(3))) const char* lds_cptr;
typedef short v4i16_t __attribute__((ext_vector_type(4)));
__device__ __forceinline__ void kload8(bf16x8*kf,lds_cptr kp){
  kf[0]=*(const __attribute__((address_space(3))) bf16x8*)(kp);      kf[1]=*(const __attribute__((address_space(3))) bf16x8*)(kp+512);
  kf[2]=*(const __attribute__((address_space(3))) bf16x8*)(kp+2048); kf[3]=*(const __attribute__((address_space(3))) bf16x8*)(kp+2560);
  kf[4]=*(const __attribute__((address_space(3))) bf16x8*)(kp+4096); kf[5]=*(const __attribute__((address_space(3))) bf16x8*)(kp+4608);
  kf[6]=*(const __attribute__((address_space(3))) bf16x8*)(kp+6144); kf[7]=*(const __attribute__((address_space(3))) bf16x8*)(kp+6656);
}
__device__ __forceinline__ void kload2(bf16x8*kf,lds_cptr kp,int j){ kf[2*j]=*(const __attribute__((address_space(3))) bf16x8*)(kp+j*2048); kf[2*j+1]=*(const __attribute__((address_space(3))) bf16x8*)(kp+j*2048+512); }
__device__ __forceinline__ s16x4 vtr(lds_cptr p){ return __builtin_bit_cast(s16x4,__builtin_amdgcn_ds_read_tr16_b64_v4i16((__attribute__((address_space(3))) v4i16_t*)p)); }
__device__ __forceinline__ float rowmax(const f32x16&p0,const f32x16&p1){
  float a=max3f(p0[0],p0[1],p1[0]),b=max3f(p0[2],p0[3],p1[1]);a=max3f(a,p1[2],p1[3]);
  #pragma unroll
  for(int r=4;r<16;r+=4){a=max3f(a,p0[r],p0[r+1]);b=max3f(b,p0[r+2],p0[r+3]);a=max3f(a,p1[r],p1[r+1]);b=max3f(b,p1[r+2],p1[r+3]);}
  const float m=max2f(a,b);
  auto rr=__builtin_amdgcn_permlane32_swap(__float_as_uint(m),__float_as_uint(m),false,false);
  return max2f(__uint_as_float(rr[0]),__uint_as_float(rr[1]));
}
__device__ __forceinline__ void pv(f32x16*o,int vb,bf16x8 pa0,bf16x8 pa1,bf16x8 pa2,bf16x8 pa3){
  #pragma unroll
  for(int d0=0;d0<2;++d0){s16x4 lo[4],hi[4];
    #pragma unroll
    for(int ks=0;ks<4;++ks){
      asm volatile("ds_read_b64_tr_b16 %0,%1 offset:%c2":"=&v"(lo[ks]):"v"(vb),"i"(d0*4096+ks*1024):"memory");
      asm volatile("ds_read_b64_tr_b16 %0,%1 offset:%c2":"=&v"(hi[ks]):"v"(vb),"i"(d0*4096+ks*1024+512):"memory");}
    asm volatile("s_waitcnt lgkmcnt(0)":::"memory");SBAR();
    #define PK(k) (bf16x8){lo[k][0],lo[k][1],lo[k][2],lo[k][3],hi[k][0],hi[k][1],hi[k][2],hi[k][3]}
    o[d0]=__builtin_amdgcn_mfma_f32_32x32x16_bf16(pa0,PK(0),o[d0],0,0,0);
    o[d0]=__builtin_amdgcn_mfma_f32_32x32x16_bf16(pa1,PK(1),o[d0],0,0,0);
    o[d0]=__builtin_amdgcn_mfma_f32_32x32x16_bf16(pa2,PK(2),o[d0],0,0,0);
    o[d0]=__builtin_amdgcn_mfma_f32_32x32x16_bf16(pa3,PK(3),o[d0],0,0,0);
    #undef PK
  }
}

#ifndef ATTN_STORE16
#define ATTN_STORE16(p,v) (*(u32x4*)(p)=(v))
#endif
constexpr float GUARD_B=96.f;
constexpr float SKIP_TH=200.f, SKIP_MARGIN=42.f, SKIP_G=10.f, SKIP_LMIN=0.0009765625f  ;
template<int THRL> __device__ __forceinline__ bool attn_unit(int b,int h,int qb,int t0s,bool guard,f32x4_t cbv0,f32x4_t cbv1,f32x4_t cbv2,f32x4_t cbv3,unsigned*tctr,bool redo,unsigned&nraw,const bf16*Q,const bf16*__restrict__ K,const bf16*__restrict__ V,bf16*O,const float*Cb,char*shm){
  int tid_=threadIdx.x; asm volatile("":"+v"(tid_));
  const int tid=tid_,lane=tid&63,r32=lane&31,hi=lane>>5; const int wid=__builtin_amdgcn_readfirstlane(tid>>6);
  const long rowbase=(long)b*SEQ; const int q0=qb*QB;
  const bf16*Qw=Q+(rowbase+q0+wid*QBLK)*DM+h*D;
  const bf16*Kh=K+(rowbase+(long)t0s*KVBLK)*DM+h*D,*Vh=V+(rowbase+(long)t0s*KVBLK)*DM+h*D;
  const unsigned lds0=(unsigned)(uintptr_t)shm;
  float*wsf=(float*)(shm+LDS_WS)+wid*64;
  const bf16*ksrc=Kh+(long)lane*DM+wid*8;
  const bf16*vsrc=Vh+(long)(16*(wid&3)+(lane>>2))*DM+(wid>>2)*32+(lane&3)*8;
  const unsigned kdst=lds0+LDS_K+wid*1024, vdst=lds0+LDS_V+wid*1024;
  #define DMA_K(t,slot) glds16(ksrc+(long)(t)*KVBLK*DM,(unsigned)__builtin_amdgcn_readfirstlane(kdst+(slot)))
  #define DMA_V(t,slot) glds16(vsrc+(long)(t)*KVBLK*DM,(unsigned)__builtin_amdgcn_readfirstlane(vdst+(slot)))
  const int vb0=(int)(lds0+LDS_V)+((lane>>4)&1)*32+(lane&3)*8+(4*hi+((lane&15)>>2))*64;
  const char*Kbase=shm+LDS_K; bf16x8 kf[8];
  const lds_cptr shm3=(lds_cptr)shm; const lds_cptr kp0=shm3+LDS_K+hi*1024+r32*16; const lds_cptr vp0=shm3+LDS_V+((lane>>4)&1)*32+(lane&3)*8+(4*hi+((lane&15)>>2))*64;
  const int NT=(q0+QB)/KVBLK-t0s;
  typedef __attribute__((address_space(3))) f32x4_t* lds_f4ptr; typedef __attribute__((address_space(3))) const f32x4_t* lds_cf4ptr;
  { const int n4=(q0+QB)/4; lds_f4ptr cl=(lds_f4ptr)((lds_cptr)shm+LDS_CB);
    if(tid<n4)cl[tid]=cbv0; if(tid+512<n4)cl[tid+512]=cbv1; if(tid+1024<n4)cl[tid+1024]=cbv2; if(tid+1536<n4)cl[tid+1536]=cbv3; }
  const lds_cf4ptr cbp=(lds_cf4ptr)((lds_cptr)shm+LDS_CB)+hi+16*t0s;
  #define CI4(PX,t_,g_,o_,nm_) do{ const f32x4_t z_=cbp[16*(t_)+(o_)+2*(g_)]; PX[4*(g_)]=(nm_)-z_.x; PX[4*(g_)+1]=(nm_)-z_.y; PX[4*(g_)+2]=(nm_)-z_.z; PX[4*(g_)+3]=(nm_)-z_.w; }while(0)
  #define CI16(PX,t_,o_,nm_) do{ CI4(PX,t_,0,o_,nm_); CI4(PX,t_,1,o_,nm_); CI4(PX,t_,2,o_,nm_); CI4(PX,t_,3,o_,nm_); }while(0)
  DMA_K(0,0);DMA_V(0,0);DMA_K(1,SLOTB);
  bf16x8 qr[4];
  #pragma unroll
  for(int d0=0;d0<4;++d0)qr[d0]=*reinterpret_cast<const bf16x8*>(&Qw[(long)r32*DM+d0*16+hi*8]);
  float mhat=0.f,l_reg=0.f;f32x16 o[2];o[0]=f32x16{};o[1]=f32x16{};
  const int qrel=wid*QBLK+r32;
  #define CMASK(P0,P1,t) do{int jb_=(t)-(NT-4); if(jb_>=0)cmask(P0,P1,jb_,qrel,hi);}while(0)
  bool resc=false;
  #define START(P0,P1) do{ const float rm=rowmax(P0,P1); resc=false; \
    if(__builtin_expect(__any(rm>(float)THRL),0)){ const float dl=__builtin_fmaxf(rm,0.f); mhat=fadd_s(mhat,dl); \
      _Pragma("unroll") for(int r=0;r<16;++r){P0[r]=fsub_s(P0[r],dl);P1[r]=fsub_s(P1[r],dl);} } \
    _Pragma("unroll") for(int r=0;r<16;++r)P0[r]=__builtin_amdgcn_exp2f(P0[r]); }while(0)
  #define RESC() do{ if(resc){ asm volatile("s_waitcnt lgkmcnt(0)":::"memory"); \
      _Pragma("unroll") for(int d_=0;d_<2;++d_) _Pragma("unroll") for(int r=0;r<16;++r)o[d_][r]*=wsf[crow(r,hi)]; } }while(0)
  f32x16 pA0,pA1,pB0,pB1;
  int sl_prev=0,sl_cur=0,sl_next=SLOTB;
  #define ROT() do{sl_prev=sl_cur;sl_cur=sl_next;sl_next=(sl_next==(NSLOT-1)*SLOTB)?0:sl_next+SLOTB;}while(0)
  DMA_K(2,2*SLOTB);
  if(!redo&&tid==0)nraw=__hip_atomic_fetch_add(tctr,1u,__ATOMIC_RELAXED,__HIP_MEMORY_SCOPE_AGENT);
  WAIT_BAR(3);
  const float qb2=*((const __attribute__((address_space(3))) float*)((lds_cptr)shm+LDS_CB)+q0+qrel);
  CI16(pA0,0,0,qb2); CI16(pA1,0,8,qb2);
  qkt(pA0,pA1,Kbase,qr,r32,hi);asm volatile("s_nop 15\n\ts_nop 7":"+v"(pA0),"+v"(pA1));CMASK(pA0,pA1,0);
  START(pA0,pA1);
  _Pragma("unroll") for(int r=0;r<16;++r)pA1[r]=__builtin_amdgcn_exp2f(pA1[r]);
  WAIT_BAR(0);
  DMA_K(3,0);DMA_V(1,SLOTB);
  ROT();
  kload8(kf,kp0+sl_cur);
  WAIT_BAR(2);
  s16x4 vlo[8],vhi[8]; u32x4 pw0,pw1,pw2,pw3;
  #define PKW(P,B) cvtpk_s(P[B],P[B+1])
  #define PAF(k) __builtin_bit_cast(bf16x8,pw##k)
  #define VFR(i) (bf16x8){vlo[i][0],vlo[i][1],vlo[i][2],vlo[i][3],vhi[i][0],vhi[i][1],vhi[i][2],vhi[i][3]}
  #define PIN(x) asm volatile("":"+v"(x))
  #define MX3(a,b,c) __builtin_fmaxf(__builtin_fmaxf((a),(b)),(c))
  #define GAPA(MF,A0,A1,A2,A3,W0,W1,PW) do{ MF; sacc+=A0; sacc+=A1; sacc+=A2; sacc+=A3; PIN(sacc); W0; W1; PIN(PW); SBAR(); }while(0)
  #define EX(v) __builtin_amdgcn_exp2f(v)
  #define GAPB(MF,X,B,GI,PX,tn_,g_,o_) do{ MF; X[B]=EX(X[B]); X[B+1]=EX(X[B+1]); X[B+2]=EX(X[B+2]); X[B+3]=EX(X[B+3]); PIN(X); SBAR(); }while(0)
  #define VRD(i) do{ vlo[i]=vtr(vp_+(((i)>>2)*4096+((i)&3)*1024)); vhi[i]=vtr(vp_+(((i)>>2)*4096+((i)&3)*1024+512)); }while(0)
  #define KRD(G,j) do{ if(G){ kload2(kf,kp0+sl_next,j); SBAR(); } }while(0)
  #define STEP(C0,C1,P0,P1,t,GK,GV,GL,GI) do{ SBAR(); const float nm1_=qb2-mhat; CI16(C0,t,0,nm1_); SBAR(); \
    const lds_cptr vp_=vp0+sl_prev; \
    VRD(0); SBAR(); float sacc=(P0[0]+P0[1]); \
    GAPA(C0=__builtin_amdgcn_mfma_f32_32x32x16_bf16(kf[0],qr[0],C0,0,0,0), P0[2],P0[3],P0[4],P0[5],     pw0[0]=PKW(P0,0), pw0[1]=PKW(P0,2), pw0); \
    CI16(C1,t,8,nm1_); PIN(C1); SBAR(); \
    VRD(4); SBAR(); GAPA(C1=__builtin_amdgcn_mfma_f32_32x32x16_bf16(kf[1],qr[0],C1,0,0,0), P0[6],P0[7],P0[8],P0[9],     pw0[2]=PKW(P0,4), pw0[3]=PKW(P0,6), pw0); \
    VRD(1); SBAR(); GAPA(C0=__builtin_amdgcn_mfma_f32_32x32x16_bf16(kf[2],qr[1],C0,0,0,0),   P0[10],P0[11],P0[12],P0[13], pw1[0]=PKW(P0,8), pw1[1]=PKW(P0,10), pw1); \
    VRD(5); SBAR(); GAPA(C1=__builtin_amdgcn_mfma_f32_32x32x16_bf16(kf[3],qr[1],C1,0,0,0),   P0[14],P0[15],P1[0],P1[1],   pw1[2]=PKW(P0,12),pw1[3]=PKW(P0,14), pw1); \
    VRD(2); SBAR(); GAPA(C0=__builtin_amdgcn_mfma_f32_32x32x16_bf16(kf[4],qr[2],C0,0,0,0),   P1[2],P1[3],P1[4],P1[5],     pw2[0]=PKW(P1,0), pw2[1]=PKW(P1,2), pw2); \
    VRD(6); SBAR(); GAPA(C1=__builtin_amdgcn_mfma_f32_32x32x16_bf16(kf[5],qr[2],C1,0,0,0),   P1[6],P1[7],P1[8],P1[9],     pw2[2]=PKW(P1,4), pw2[3]=PKW(P1,6), pw2); \
    VRD(3); SBAR(); GAPA(C0=__builtin_amdgcn_mfma_f32_32x32x16_bf16(kf[6],qr[3],C0,0,0,0),   P1[10],P1[11],P1[12],P1[13], pw3[0]=PKW(P1,8), pw3[1]=PKW(P1,10), pw3); \
    VRD(7); SBAR(); GAPA(C1=__builtin_amdgcn_mfma_f32_32x32x16_bf16(kf[7],qr[3],C1,0,0,0),   P1[14],P1[15],0.f,0.f,       pw3[2]=PKW(P1,12),pw3[3]=PKW(P1,14), pw3); \
    l_reg+=sacc; \
    if(GK){DMA_K((t)+3,sl_cur);} if(GV){DMA_V((t)+1,sl_next);} \
    CMASK(C0,C1,t); \
    resc=false; \
    if(guard){ float a=MX3(C0[0],C0[1],C1[0]),b=MX3(C0[2],C0[3],C1[1]); a=MX3(a,C1[2],C1[3]); \
      _Pragma("unroll") for(int r=4;r<16;r+=4){a=MX3(a,C0[r],C0[r+1]);b=MX3(b,C0[r+2],C0[r+3]);a=MX3(a,C1[r],C1[r+1]);b=MX3(b,C1[r+2],C1[r+3]);} \
      float rm=__builtin_fmaxf(a,b); { auto rr=__builtin_amdgcn_permlane32_swap(__float_as_uint(rm),__float_as_uint(rm),false,false); rm=__builtin_fmaxf(__uint_as_float(rr[0]),__uint_as_float(rr[1])); } \
      if(__builtin_expect(__any(rm>(float)THRL),0)){ const float dl=__builtin_fmaxf(rm,0.f); mhat+=dl; \
        _Pragma("unroll") for(int r=0;r<16;++r){C0[r]-=dl;C1[r]-=dl;} \
        const float f=__builtin_amdgcn_exp2f(-dl); l_reg*=f; if(hi==0)wsf[r32]=f; resc=true; } } \
    SBAR(); \
    GAPB(o[0]=__builtin_amdgcn_mfma_f32_32x32x16_bf16(PAF(0),VFR(0),o[0],0,0,0), C0,0,  GI,P0,(t)+1,0,0); \
    GAPB(o[1]=__builtin_amdgcn_mfma_f32_32x32x16_bf16(PAF(0),VFR(4),o[1],0,0,0), C0,4,  GI,P0,(t)+1,1,0); \
    KRD(GL,0); GAPB(o[0]=__builtin_amdgcn_mfma_f32_32x32x16_bf16(PAF(1),VFR(1),o[0],0,0,0), C0,8,  GI,P0,(t)+1,2,0); \
    KRD(GL,1); GAPB(o[1]=__builtin_amdgcn_mfma_f32_32x32x16_bf16(PAF(1),VFR(5),o[1],0,0,0), C0,12, GI,P0,(t)+1,3,0); \
    KRD(GL,2); GAPB(o[0]=__builtin_amdgcn_mfma_f32_32x32x16_bf16(PAF(2),VFR(2),o[0],0,0,0), C1,0,  GI,P1,(t)+1,0,8); \
    KRD(GL,3); GAPB(o[1]=__builtin_amdgcn_mfma_f32_32x32x16_bf16(PAF(2),VFR(6),o[1],0,0,0), C1,4,  GI,P1,(t)+1,1,8); \
    GAPB(o[0]=__builtin_amdgcn_mfma_f32_32x32x16_bf16(PAF(3),VFR(3),o[0],0,0,0), C1,8,  GI,P1,(t)+1,2,8); \
    GAPB(o[1]=__builtin_amdgcn_mfma_f32_32x32x16_bf16(PAF(3),VFR(7),o[1],0,0,0), C1,12, GI,P1,(t)+1,3,8); \
    }while(0)
  int t=1;
  #undef CMASK
  #define CMASK(P0,P1,t) do{}while(0)
  for(;t+5<NT;t+=2){
    STEP(pB0,pB1,pA0,pA1,t,true,true,true,true);     WAIT_BAR(2); RESC(); ROT();
    STEP(pA0,pA1,pB0,pB1,t+1,true,true,true,true);   WAIT_BAR(2); RESC(); ROT();
  }
  #undef CMASK
  #define CMASK(P0,P1,t) do{int jb_=(t)-(NT-4); if(jb_>=0)cmask(P0,P1,jb_,qrel,hi);}while(0)
  #define ENDW(tt) do{ if((tt)+3<NT){WAIT_BAR(2);} else if((tt)+2<NT){WAIT_BAR(1);} else {WAIT_BAR(0);} }while(0)
  for(;t+1<NT;t+=2){
    STEP(pB0,pB1,pA0,pA1,t,(t+3<NT),(t+1<NT),(t+1<NT),true);       ENDW(t);   RESC(); ROT();
    STEP(pA0,pA1,pB0,pB1,t+1,(t+4<NT),(t+2<NT),(t+2<NT),true);     ENDW(t+1); RESC(); ROT();
  }
  STEP(pB0,pB1,pA0,pA1,NT-1,false,false,false,false); RESC();
  { float sacc=pB0[0]+pB0[1]; _Pragma("unroll") for(int r=2;r<16;++r)sacc+=pB0[r]; _Pragma("unroll") for(int r=0;r<16;++r)sacc+=pB1[r]; l_reg+=sacc;
    pw0=(u32x4){PKW(pB0,0),PKW(pB0,2),PKW(pB0,4),PKW(pB0,6)};pw1=(u32x4){PKW(pB0,8),PKW(pB0,10),PKW(pB0,12),PKW(pB0,14)};pw2=(u32x4){PKW(pB1,0),PKW(pB1,2),PKW(pB1,4),PKW(pB1,6)};pw3=(u32x4){PKW(pB1,8),PKW(pB1,10),PKW(pB1,12),PKW(pB1,14)};
    SBAR(); pv(o,vb0+sl_cur,PAF(0),PAF(1),PAF(2),PAF(3)); }
  #undef PKW
  #undef PAF
  #undef VFR
  #undef PIN
  #undef MX3
  #undef GAPA
  #undef GAPB
  #undef EX
  #undef VRD
  #undef KRD
  #undef STEP
  #undef ENDW
  {auto rr=__builtin_amdgcn_permlane32_swap(__float_as_uint(l_reg),__float_as_uint(l_reg),false,false);l_reg=__uint_as_float(rr[0])+__uint_as_float(rr[1]);}
  { const bool okw_=__all(l_reg>=SKIP_LMIN); if(lane==0)*((volatile __attribute__((address_space(3))) unsigned*)((lds_cptr)shm+LDS_OK)+wid)=okw_?1u:0u; }
  if(hi==0)wsf[32+r32]=l_reg;asm volatile("s_waitcnt lgkmcnt(0)":::"memory");
  float rli[16];
  #pragma unroll
  for(int r=0;r<16;++r)rli[r]=__builtin_amdgcn_rcpf(wsf[32+crow(r,hi)]);
  bf16*Ow=O+(rowbase+q0+wid*QBLK)*DM+h*D;
  { bf16*stg=(bf16*)(shm+LDS_OST)+wid*2048;
    #pragma unroll
    for(int r=0;r<16;++r){const int orow=crow(r,hi);
      #pragma unroll
      for(int d0=0;d0<2;++d0)stg[orow*64+d0*32+r32]=__float2bfloat16(o[d0][r]*rli[r]);}
    asm volatile("s_waitcnt lgkmcnt(0)":::"memory");
    #pragma unroll
    for(int i=0;i<4;++i){const int row=i*8+(lane>>3),ch=lane&7; const u32x4 v=*(const u32x4*)(stg+row*64+ch*8); ATTN_STORE16(Ow+(long)row*DM+ch*8,v);} }
  asm volatile("s_waitcnt lgkmcnt(0)\n\ts_barrier":::"memory");
  { const volatile __attribute__((address_space(3))) unsigned*okp_=(const volatile __attribute__((address_space(3))) unsigned*)((lds_cptr)shm+LDS_OK);
    return (okp_[0]&okp_[1]&okp_[2]&okp_[3]&okp_[4]&okp_[5]&okp_[6]&okp_[7])!=0u; }
  #undef CI4
  #undef CI16
  #undef DMA_K
  #undef DMA_V
  #undef CMASK
  #undef START
  #undef RESC
  #undef ROT
}
constexpr int ATTN_LDS_BYTES=LDS_BYTES;
struct AttnTensors { const bf16* Q; const bf16* K; const bf16* V; bf16* O; const float* Cb; };
__device__ __forceinline__ unsigned aq_grab_from(unsigned*ctr,unsigned q0_){
  for(unsigned qq=0;qq<8;++qq){ const unsigned q=(q0_+qq)&7u; const unsigned r=__hip_atomic_fetch_add(ctr+64*q,1u,__ATOMIC_RELAXED,__HIP_MEMORY_SCOPE_AGENT); if(r<256u)return (q<<16)|r; }
  return 0xffffffffu; }
template<int THRL=8> __device__ __forceinline__ void attn_phase(char*lds,const AttnTensors&T,unsigned*ctr,unsigned xcc,const unsigned*nrm){
  const int tid=threadIdx.x,lane_=tid&63;
  volatile __attribute__((address_space(3))) unsigned*qw=(volatile __attribute__((address_space(3))) unsigned*)((lds_cptr)lds+LDS_Q);
  if(tid==0)qw[0]=aq_grab_from(ctr,xcc&7u);
  asm volatile("s_waitcnt lgkmcnt(0)\n\ts_barrier":::"memory");
  bool redo=false; unsigned nraw=0u;
  for(;;){
    const unsigned pk=qw[0]; if(pk==0xffffffffu)break;
    const unsigned q=pk>>16,idx=pk&0xffffu; const int bh=(int)(q+8u*(idx&7u)),qb=31-(int)(idx>>3);
    int t0s=0,t0a=0;
    int lane=lane_; asm volatile("":"+v"(lane));
    const float*cg=T.Cb+(size_t)bh*SEQ; const int ntabs=4*qb+4;
    const unsigned nw=__hip_atomic_load(nrm+(((lane>>1)&1)*64+bh)*2+(lane&1),__ATOMIC_RELAXED,__HIP_MEMORY_SCOPE_AGENT);
    float e0=0.f,e1=0.f; if(qb>0){ e0=cg[64*lane+63]; e1=(lane+64<ntabs)?cg[64*(lane+64)+63]:0.f; }
    f32x4_t cb0=f32x4_t{},cb1=f32x4_t{},cb2=f32x4_t{},cb3=f32x4_t{};
    { int tt=tid; asm volatile("":"+v"(tt)); const f32x4_t*cg4=(const f32x4_t*)cg; const int n4=ntabs*16;
      if(tt<n4)cb0=cg4[tt]; if(tt+512<n4)cb1=cg4[tt+512]; if(tt+1024<n4)cb2=cg4[tt+1024]; if(tt+1536<n4)cb3=cg4[tt+1536]; }
    const float nv=__uint_as_float(nw); const float q2=__shfl(nv,0)+__shfl(nv,1), k2=__shfl(nv,2)+__shfl(nv,3);
    const float bnd=1.02f*sqrtf(q2*k2);
    const bool guard=__builtin_amdgcn_readfirstlane((bnd<GUARD_B)?0:1)!=0;
    if(qb>0){
      const float th=fminf(SKIP_TH,SKIP_MARGIN+2.f*bnd), tha=fminf(th,SKIP_MARGIN+bnd+SKIP_G);
      const int tq=4*qb-1; const float ref=__shfl((tq<64)?e0:e1,tq&63);
      const unsigned long long m0=__ballot((lane<ntabs)&&((e0-ref)>th)), m1=__ballot((lane+64<ntabs)&&((e1-ref)>th));
      const int nskip=__popcll(m0)+__popcll(m1); t0s=nskip&~1; if(t0s>ntabs-4)t0s=ntabs-4; t0s=__builtin_amdgcn_readfirstlane(t0s);
      const unsigned long long a0=__ballot((lane<ntabs)&&((e0-ref)>tha)), a1=__ballot((lane+64<ntabs)&&((e1-ref)>tha));
      const int nska=__popcll(a0)+__popcll(a1); t0a=nska&~1; if(t0a>ntabs-4)t0a=ntabs-4; t0a=__builtin_amdgcn_readfirstlane(t0a); }
    const int t0u=redo?t0s:t0a;
    const bool ok=attn_unit<THRL>(bh/NHEAD,bh%NHEAD,qb,t0u,guard,cb0,cb1,cb2,cb3,ctr+64*q,redo,nraw,T.Q,T.K,T.V,T.O,T.Cb,lds);
    if(!ok&&t0u!=t0s){ redo=true; continue; }
    redo=false;
    if(tid==0)qw[0]=(nraw<256u)?((q<<16)|nraw):aq_grab_from(ctr,(q+1u)&7u);
    asm volatile("s_waitcnt lgkmcnt(0)\n\ts_barrier":::"memory");
  }
}
#undef SBAR
#undef WAIT_BAR
}
#define ATTN_PHASE_BODY { static_assert(attn_body::ATTN_LDS_BYTES <= RING_BYTES && attn_body::ATTN_PITCH == D, "attention body geometry vs frame"); \
    const attn_body::AttnTensors AT{(const attn_body::bf16*)QO, (const attn_body::bf16*)KB, (const attn_body::bf16*)VB, (attn_body::bf16*)OB, (const float*)(F.ws + WS_C2)}; \
    attn_body::attn_phase<8>((char*)lds + RING_OFF, AT, (unsigned*)(F.ctl + CW_AQ), xb_xcc_id(), (const unsigned*)(F.ctl + CW_NRM)); }
constexpr int NWAVES = 8;
#ifndef MK_PER_PHASE
#define MK_PER_PHASE 0
#endif
constexpr int N_PHASES = 15;

constexpr int BATCH = 4, SEQ = 8192, D = 1024, H = 16, HD = 64, FF = 2816, NE = 8;
constexpr int M = BATCH * SEQ;
constexpr int NQKV = 3 * D, NIN = 3 * D + H;
constexpr int NCH = M / 128;
constexpr int TMAX = 2 * M / 256 + NE;
constexpr int HROWS = TMAX * 256;
constexpr float RMS_EPS = 1e-6f;
constexpr float QSCALE = 0.125f * 1.4426950408889634f;
constexpr float LOG2E = 1.4426950408889634f;

constexpr size_t MiB = 1u << 20;
constexpr size_t WS_CTL = 0, CTL_ZERO_BYTES = 1 * MiB;
constexpr size_t WS_CTOT = 1 * MiB;
constexpr size_t WS_WQKV = 2 * MiB, WS_WO = 8 * MiB, WS_WGU = 10 * MiB, WS_WD = 21 * MiB, WS_WCIN = 27 * MiB, WS_WCO = 33 * MiB;
constexpr size_t WS_MGU8 = 35 * MiB, WS_MD8 = 79 * MiB;
constexpr size_t WS_XN8 = 2 * MiB;
constexpr size_t WS_HB = 101 * MiB;
constexpr size_t WS_ZP = 165 * MiB, WS_BGB = 166 * MiB;
constexpr size_t WS_C2 = 167 * MiB;
constexpr size_t WS_LIST = 169 * MiB;
constexpr size_t WS_INV = 170 * MiB, WS_GATE = 170 * MiB + 512 * 1024;
constexpr size_t WS_SS = 173 * MiB;
constexpr size_t WS_XN = 176 * MiB;
constexpr size_t WS_QO = 240 * MiB, WS_K = 304 * MiB, WS_V = 368 * MiB;
constexpr size_t WS_HID = 240 * MiB;
constexpr size_t WS_HID8 = 176 * MiB, WS_Y = 358 * MiB;
constexpr size_t WS_O = 432 * MiB;
constexpr size_t WS_END = 496 * MiB;
static_assert(WS_WD + (size_t)D * FF * 2 <= WS_WCIN && WS_MGU8 + (size_t)NE * 2 * FF * D <= WS_MD8 && WS_MD8 + (size_t)NE * D * FF <= WS_HB && WS_HB + (size_t)M * D * 2 <= WS_ZP && WS_ZP + (size_t)(M / 256) * 2 * D * 4 <= WS_BGB && WS_BGB + (size_t)(M / 256) * 2 * D * 4 <= WS_C2 && WS_XN8 + (size_t)M * D <= WS_MGU8 && WS_LIST + (size_t)NE * M * 4 <= WS_INV && WS_GATE + (size_t)M * 8 <= WS_SS && WS_SS + (size_t)M * 16 * 4 <= WS_XN, "d_ws map (weights)");
static_assert(WS_HID + (size_t)M * FF * 2 <= WS_O && WS_HID8 + (size_t)HROWS * FF <= WS_Y && WS_Y + (size_t)HROWS * D * 2 <= WS_END && WS_V + (size_t)M * D * 2 <= WS_O && WS_O + (size_t)M * D * 2 <= WS_END && WS_V - WS_K == WS_K - WS_QO, "d_ws map (activations)");
constexpr int CW_TMO = 0, CW_CODE = 1;
constexpr int CW_BAR = 4096;
constexpr int CW_AQ = 12288;
constexpr int CW_NRM = 2048;
constexpr int CW_MOE = 8192;
constexpr int RING_OFF = 0, RING_BYTES = 131072;
constexpr int RSTAB_OFF = RING_BYTES + 1024;
constexpr int GTOK_OFF = RING_BYTES + 2048, GTOK_UNITS = 24;
constexpr int LDSCTL_OFF = RING_BYTES, MISC_OFF = LDSCTL_OFF + 320;
constexpr int LDS_BYTES = 147456;
static_assert(MISC_OFF + 128 <= RSTAB_OFF && GTOK_OFF + GTOK_UNITS * 512 <= LDS_BYTES && M <= 65536, "LDS map");

#define GAS __attribute__((address_space(1)))
#define LAS __attribute__((address_space(3)))
typedef unsigned short bf16;
typedef unsigned v4u __attribute__((ext_vector_type(4)));
typedef float f32x4 __attribute__((ext_vector_type(4)));
typedef short bf16x8 __attribute__((ext_vector_type(8)));
typedef GAS unsigned gu32;
typedef GAS unsigned long long gu64;
#define RLX_AGENT __ATOMIC_RELAXED, __HIP_MEMORY_SCOPE_AGENT
#define LDS_WAIT() asm volatile("s_waitcnt lgkmcnt(0)" ::: "memory")
#define VM_WAIT() asm volatile("s_waitcnt vmcnt(0)" ::: "memory")
__device__ __forceinline__ unsigned f2bf(float f) { unsigned u = __builtin_bit_cast(unsigned, f); return (u + 0x7fffu + ((u >> 16) & 1u)) >> 16; }
__device__ __forceinline__ unsigned pk2(float lo, float hi) { return f2bf(lo) | (f2bf(hi) << 16); }
__device__ __forceinline__ float bf_lo(unsigned w) { return __uint_as_float(w << 16); }
__device__ __forceinline__ float bf_hi(unsigned w) { return __uint_as_float(w & 0xffff0000u); }

#define XB_TMO      128
#define XB_XCNT(j)  (256  + 64 * (j))
#define XB_XSUB(j)  (1280 + 64 * (j))
#define XB_XGEN(j)  (2304 + 64 * (j))
#define XB_TOP      3328
#define XB_TOPGEN   3392
#define XCD_BAR_WORDS 3456
#define XB_SPIN_CAP (1u << 18)

__device__ __forceinline__ unsigned xb_ld(unsigned* p)              { return __hip_atomic_load(p, __ATOMIC_RELAXED, __HIP_MEMORY_SCOPE_AGENT); }
__device__ __forceinline__ unsigned xb_add(unsigned* p, unsigned v) { return __hip_atomic_fetch_add(p, v, __ATOMIC_RELAXED, __HIP_MEMORY_SCOPE_AGENT); }
__device__ __forceinline__ unsigned xb_xcc_id() { return (unsigned)__builtin_amdgcn_s_getreg((3 << 11) | 20) & 0xFu; }
#define XB_SPIN(cond, bar) do { unsigned _sp = 0; while (cond) { __builtin_amdgcn_s_sleep(1); \
    if ((++_sp & 255u) == 0u) { if (xb_ld(&(bar)[XB_TMO])) break; if (_sp > XB_SPIN_CAP) { atomicAdd(&(bar)[XB_TMO], 1u); break; } } } } while (0)

struct XcdBarrier {
    unsigned* bar; unsigned x;
    volatile LAS unsigned* st;
};

__device__ __forceinline__ XcdBarrier xcd_barrier_post(unsigned* bar, volatile LAS unsigned* st) {
    XcdBarrier b; b.bar = bar; b.x = xb_xcc_id(); b.st = st;
    if (threadIdx.x == 0) (void)xb_add(&bar[XB_XCNT(b.x)], 1u);
    return b;
}
__device__ __forceinline__ void xcd_barrier_complete(unsigned* bar, unsigned x, unsigned& nloc, unsigned& nx) {
    const unsigned G = gridDim.x * gridDim.y * gridDim.z;
    unsigned sum, cnt, mine, sp = 0u;
    for (;;) {
        sum = 0u; cnt = 0u; mine = 0u;
#pragma unroll
        for (unsigned j = 0; j < 16; ++j) { const unsigned c = xb_ld(&bar[XB_XCNT(j)]); sum += c; cnt += (c > 0u) ? 1u : 0u; mine = (j == x) ? c : mine; }
        if (sum == G) break;
        __builtin_amdgcn_s_sleep(1);
        if ((++sp & 255u) == 0u) { if (xb_ld(&bar[XB_TMO])) break; if (sp > XB_SPIN_CAP) { atomicAdd(&bar[XB_TMO], 1u); break; } }
    }
    nloc = mine > 0u ? mine : 1u; nx = cnt > 0u ? cnt : 1u;
}

__device__ __forceinline__ void xcd_barrier(const XcdBarrier& b) {
    asm volatile("s_waitcnt vmcnt(0)" ::: "memory");
    __syncthreads();
    if (threadIdx.x == 0) {
        unsigned* bar = b.bar;
        __builtin_amdgcn_s_waitcnt(0);
        unsigned nloc = b.st[0], nx = b.st[1];
        if (nloc == 0u) { xcd_barrier_complete(bar, b.x, nloc, nx); b.st[0] = nloc; b.st[1] = nx; }
        const unsigned old = xb_add(&bar[XB_XSUB(b.x)], 1u);
        const unsigned gen = old / nloc;
        if (old + 1u == (gen + 1u) * nloc) {
            __builtin_amdgcn_fence(__ATOMIC_RELEASE, "agent");
            asm volatile("s_waitcnt vmcnt(0)" ::: "memory");
            const unsigned og = xb_add(&bar[XB_TOP], 1u);
            const unsigned tg = og / nx;
            if (og + 1u == (tg + 1u) * nx) xb_add(&bar[XB_TOPGEN], 1u);
            else XB_SPIN(xb_ld(&bar[XB_TOPGEN]) == tg, bar);
            __builtin_amdgcn_fence(__ATOMIC_ACQUIRE, "agent");
            xb_add(&bar[XB_XGEN(b.x)], 1u);
            asm volatile("s_waitcnt vmcnt(0)" ::: "memory");
        } else {
            XB_SPIN(xb_ld(&bar[XB_XGEN(b.x)]) == gen, bar);
            __builtin_amdgcn_fence(__ATOMIC_ACQUIRE, "agent");
            asm volatile("s_waitcnt vmcnt(0)" ::: "memory");
        }
    }
    __syncthreads();
}

struct Frame {
    LAS unsigned char* lds;
    volatile LAS unsigned* MISC;
    gu32* ctl;
    int tid, lane, wave;
    int vcu, G;
    const float* const* in; float* out; unsigned char* ws;
};
enum { I_X = 0, I_ATTN_NORM, I_ATTN_WIN, I_ATTN_BF, I_ATTN_WOUT, I_FFN_NORM, I_FFN_WG, I_FFN_WU, I_FFN_WD, I_CONV_NORM, I_CONV_WIN, I_CONV_W, I_CONV_WOUT, I_MOE_NORM, I_MOE_WR, I_MOE_WG, I_MOE_WU, I_MOE_WD, I_FINAL_NORM };

__device__ __forceinline__ float wave_sum(float v) {
#pragma unroll
    for (int o = 1; o < 64; o <<= 1) v += __shfl_xor(v, o);
    return v;
}
__device__ __forceinline__ void tr_item(const float* W, int ldw, int K, bf16* WT, int k0, int n0, int drow0, LAS float* scr, int lane, const float* gain = nullptr) {
    { f32x4 t[8]; const int kr = lane >> 3, c4 = 4 * (lane & 7);
#pragma unroll
      for (int i = 0; i < 8; ++i) t[i] = *(const GAS f32x4*)(W + (size_t)(k0 + kr + 8 * i) * ldw + n0 + c4);
#pragma unroll
      for (int i = 0; i < 8; ++i) { const int kk = kr + 8 * i; const float gn = gain ? gain[k0 + kk] : 1.0f; LAS float* d = scr + kk * 33 + c4;
          d[0] = t[i].x * gn; d[1] = t[i].y * gn; d[2] = t[i].z * gn; d[3] = t[i].w * gn; } }
    LDS_WAIT(); asm volatile("" ::: "memory");
    const int c = lane & 7;
#pragma unroll
    for (int j = 0; j < 4; ++j) { const int n = (lane >> 3) + 8 * j; const LAS float* s = scr + (8 * c) * 33 + n;
        v4u o; o.x = pk2(s[0 * 33], s[1 * 33]); o.y = pk2(s[2 * 33], s[3 * 33]); o.z = pk2(s[4 * 33], s[5 * 33]); o.w = pk2(s[6 * 33], s[7 * 33]);
        *(GAS v4u*)(WT + (size_t)(drow0 + n) * K + k0 + 8 * c) = o; }
    LDS_WAIT(); asm volatile("" ::: "memory");
}
__device__ __forceinline__ void tr_item8(const float* W, int ldw, int Kb, unsigned char* WT, int k0, int n0, int drow0, LAS float* scr, int lane) {
    { f32x4 t[8]; const int kr = lane >> 3, c4 = 4 * (lane & 7);
#pragma unroll
      for (int i = 0; i < 8; ++i) t[i] = *(const GAS f32x4*)(W + (size_t)(k0 + kr + 8 * i) * ldw + n0 + c4);
#pragma unroll
      for (int i = 0; i < 8; ++i) { LAS float* d = scr + (kr + 8 * i) * 33 + c4;
          d[0] = t[i].x * pg8::W8_SCALE; d[1] = t[i].y * pg8::W8_SCALE; d[2] = t[i].z * pg8::W8_SCALE; d[3] = t[i].w * pg8::W8_SCALE; } }
    LDS_WAIT(); asm volatile("" ::: "memory");
#pragma unroll
    for (int j = 0; j < 2; ++j) { const int idx = lane + 64 * j, n = idx >> 2, c = idx & 3; const LAS float* s = scr + (16 * c) * 33 + n;
        v4u o; o.x = pg8::pk4_fp8(s[0 * 33], s[1 * 33], s[2 * 33], s[3 * 33]); o.y = pg8::pk4_fp8(s[4 * 33], s[5 * 33], s[6 * 33], s[7 * 33]);
        o.z = pg8::pk4_fp8(s[8 * 33], s[9 * 33], s[10 * 33], s[11 * 33]); o.w = pg8::pk4_fp8(s[12 * 33], s[13 * 33], s[14 * 33], s[15 * 33]);
        *(GAS v4u*)(WT + (size_t)(drow0 + n) * Kb + k0 + 16 * c) = o; }
    LDS_WAIT(); asm volatile("" ::: "memory");
}
struct TrItem { const float* W; const float* gain; unsigned char* WT; int ldw, Kb, k0, n0, drow0, fp8; };
__device__ __forceinline__ void tr_load(const TrItem& I, f32x4 (&t)[8], float (&gq)[8], int lane) {
    const int kr = lane >> 3, c4 = 4 * (lane & 7);
#pragma unroll
    for (int i = 0; i < 8; ++i) t[i] = *(const GAS f32x4*)(I.W + (size_t)(I.k0 + kr + 8 * i) * I.ldw + I.n0 + c4);
#pragma unroll
    for (int i = 0; i < 8; ++i) gq[i] = I.gain ? I.gain[I.k0 + kr + 8 * i] : 1.0f;
}
__device__ __forceinline__ void tr_to_lds(const TrItem& I, const f32x4 (&t)[8], const float (&gq)[8], LAS float* scr, int lane) {
    const int kr = lane >> 3, c4 = 4 * (lane & 7); const float sc = (I.fp8 == 1) ? pg8::W8_SCALE : 1.0f;
#pragma unroll
    for (int i = 0; i < 8; ++i) { const int kk = kr + 8 * i; const float gn = gq[i] * sc; LAS float* d = scr + kk * 33 + c4;
        d[0] = t[i].x * gn; d[1] = t[i].y * gn; d[2] = t[i].z * gn; d[3] = t[i].w * gn; }
    LDS_WAIT(); asm volatile("" ::: "memory");
}
__device__ __forceinline__ void tr_store(const TrItem& I, LAS float* scr, int lane) {
    if (I.fp8 == 1) {
#pragma unroll
        for (int j = 0; j < 2; ++j) { const int idx = lane + 64 * j, n = idx >> 2, c = idx & 3; const LAS float* s = scr + (16 * c) * 33 + n;
            v4u o; o.x = pg8::pk4_fp8(s[0 * 33], s[1 * 33], s[2 * 33], s[3 * 33]); o.y = pg8::pk4_fp8(s[4 * 33], s[5 * 33], s[6 * 33], s[7 * 33]);
            o.z = pg8::pk4_fp8(s[8 * 33], s[9 * 33], s[10 * 33], s[11 * 33]); o.w = pg8::pk4_fp8(s[12 * 33], s[13 * 33], s[14 * 33], s[15 * 33]);
            *(GAS v4u*)(I.WT + (size_t)(I.drow0 + n) * I.Kb + I.k0 + 16 * c) = o; }
    } else {
        const int c = lane & 7;
#pragma unroll
        for (int j = 0; j < 4; ++j) { const int n = (lane >> 3) + 8 * j; const LAS float* s = scr + (8 * c) * 33 + n;
            v4u o;
            if (I.fp8 == 2) { o.x = pg8::pk2h(s[0 * 33], s[1 * 33]); o.y = pg8::pk2h(s[2 * 33], s[3 * 33]); o.z = pg8::pk2h(s[4 * 33], s[5 * 33]); o.w = pg8::pk2h(s[6 * 33], s[7 * 33]); }
            else { o.x = pk2(s[0 * 33], s[1 * 33]); o.y = pk2(s[2 * 33], s[3 * 33]); o.z = pk2(s[4 * 33], s[5 * 33]); o.w = pk2(s[6 * 33], s[7 * 33]); }
            *(GAS v4u*)(I.WT + (size_t)(I.drow0 + n) * I.Kb + (size_t)(I.k0 + 8 * c) * 2) = o; }
    }
    LDS_WAIT(); asm volatile("" ::: "memory");
}
__device__ __forceinline__ int map_gate(int n0) { return 256 * (n0 >> 7) + (n0 & 127); }
__device__ __forceinline__ int map_up(int n0) { return 256 * (n0 >> 7) + 128 + (n0 & 127); }

__device__ __forceinline__ void rms_row(const float* xrow, const f32x4 (&g)[4], f32x4 (&v)[4], int lane) {
    const GAS f32x4* xr = (const GAS f32x4*)xrow + lane; float s = 0.f;
#pragma unroll
    for (int j = 0; j < 4; ++j) { v[j] = xr[64 * j]; s += (v[j].x * v[j].x + v[j].y * v[j].y) + (v[j].z * v[j].z + v[j].w * v[j].w); }
    const float rstd = 1.0f / sqrtf(wave_sum(s) * (1.f / D) + RMS_EPS);
#pragma unroll
    for (int j = 0; j < 4; ++j) v[j] = v[j] * rstd * g[j];
}
__device__ __forceinline__ void rms_load(const float* xrow, f32x4 (&v)[4], int lane) {
    const GAS f32x4* xr = (const GAS f32x4*)xrow + lane;
#pragma unroll
    for (int j = 0; j < 4; ++j) v[j] = xr[64 * j];
}
__device__ __forceinline__ void rms_finish(const f32x4 (&g)[4], f32x4 (&v)[4]) {
    float s = 0.f;
#pragma unroll
    for (int j = 0; j < 4; ++j) s += (v[j].x * v[j].x + v[j].y * v[j].y) + (v[j].z * v[j].z + v[j].w * v[j].w);
    const float rstd = 1.0f / sqrtf(wave_sum(s) * (1.f / D) + RMS_EPS);
#pragma unroll
    for (int j = 0; j < 4; ++j) v[j] = v[j] * rstd * g[j];
}
__device__ __forceinline__ void load_row_h16(const bf16* hrow, f32x4 (&v)[4], int lane) {
    typedef unsigned u32x2 __attribute__((ext_vector_type(2)));
    const GAS u32x2* hr = (const GAS u32x2*)hrow + lane;
#pragma unroll
    for (int j = 0; j < 4; ++j) { const u32x2 w = hr[64 * j]; v[j] = (f32x4){pg8::h_lo(w.x), pg8::h_hi(w.x), pg8::h_lo(w.y), pg8::h_hi(w.y)}; }
}
__device__ __forceinline__ void store_row_bf16(bf16* orow, const f32x4 (&v)[4], int lane) {
    GAS unsigned long long* o8 = (GAS unsigned long long*)orow + lane;
#pragma unroll
    for (int j = 0; j < 4; ++j) o8[64 * j] = (unsigned long long)pk2(v[j].x, v[j].y) | ((unsigned long long)pk2(v[j].z, v[j].w) << 32);
}
__device__ __forceinline__ void load_gain(const float* gp, f32x4 (&g)[4], int lane) {
#pragma unroll
    for (int j = 0; j < 4; ++j) g[j] = ((const GAS f32x4*)gp)[lane + 64 * j];
}

__device__ __forceinline__ void p0_prologue(Frame& F) {
    constexpr int WFLD = 1032;
    LAS bf16* wf = (LAS bf16*)(F.lds + RING_OFF);
    LAS float* wtot = (LAS float*)(F.lds + RING_OFF + 40960);
    const float* Win = F.in[I_ATTN_WIN];
    for (int i = 0; i < 32; ++i) { const int k = (F.tid >> 4) + 32 * i, h = F.tid & 15; wf[h * WFLD + k] = (bf16)f2bf(Win[(size_t)k * NIN + NQKV + h]); }
    __syncthreads();
    bf16* XN = (bf16*)(F.ws + WS_XN); float* C2 = (float*)(F.ws + WS_C2); float* CTOT = (float*)(F.ws + WS_CTOT);
    f32x4 g[4]; load_gain(F.in[I_ATTN_NORM], g, F.lane);
    const int hh = F.lane & 15, q4 = F.lane >> 4; const float bfg = F.in[I_ATTN_BF][hh];
    for (int chunk = blockIdx.x; chunk < NCH; chunk += F.G) {
        const int r0 = chunk * 128 + F.wave * 16;
        for (int rr = 0; rr < 16; rr += 2) { f32x4 v[4], w[4];
            rms_load(F.in[I_X] + (size_t)(r0 + rr) * D, v, F.lane); rms_load(F.in[I_X] + (size_t)(r0 + rr + 1) * D, w, F.lane);
            rms_finish(g, v); rms_finish(g, w); store_row_bf16(XN + (size_t)(r0 + rr) * D, v, F.lane); store_row_bf16(XN + (size_t)(r0 + rr + 1) * D, w, F.lane); }
        VM_WAIT();
        f32x4 acc = (f32x4){0.f, 0.f, 0.f, 0.f};
        const bf16* arow = XN + (size_t)(r0 + hh) * D + 8 * q4; const LAS bf16* brow = wf + hh * WFLD + 8 * q4;
#pragma unroll 8
        for (int s = 0; s < 32; ++s) { const bf16x8 a = *(const GAS bf16x8*)(arow + 32 * s); const bf16x8 b = *(const LAS bf16x8*)(brow + 32 * s); acc = __builtin_amdgcn_mfma_f32_16x16x32_bf16(a, b, acc, 0, 0, 0); }
        float p[4], run = 0.f;
#pragma unroll
        for (int r = 0; r < 4; ++r) { const float x = acc[r] + bfg; const float ls = fminf(x, 0.f) - log1pf(expf(-fabsf(x))); run += ls; p[r] = run; }
        const float T0 = __shfl(run, hh), T1 = __shfl(run, hh + 16), T2 = __shfl(run, hh + 32), T3 = __shfl(run, hh + 48);
        const float excl = (q4 > 0 ? T0 : 0.f) + (q4 > 1 ? T1 : 0.f) + (q4 > 2 ? T2 : 0.f);
        if (q4 == 0) wtot[F.wave * 16 + hh] = (T0 + T1) + (T2 + T3);
        __syncthreads();
        float wp = 0.f, tot = 0.f;
#pragma unroll
        for (int i = 0; i < 8; ++i) { const float t = wtot[i * 16 + hh]; if (i < F.wave) wp += t; tot += t; }
        if (F.wave == 0 && q4 == 0) CTOT[chunk * 16 + hh] = tot;
        const int b = chunk / (SEQ / 128), t0 = (chunk % (SEQ / 128)) * 128 + F.wave * 16 + 4 * q4; const float base = wp + excl;
        *(GAS f32x4*)(C2 + (size_t)(b * H + hh) * SEQ + t0) = (f32x4){p[0] + base, p[1] + base, p[2] + base, p[3] + base};
        __syncthreads();
    }
}
constexpr int TI_QKV = (D / 64) * (NQKV / 32), TI_DD = (D / 64) * (D / 32), TI_DF = (D / 64) * (FF / 32), TI_FD = (FF / 64) * (D / 32);
constexpr int N_EARLY = TI_QKV + TI_DD, NITEMS = TI_QKV + TI_DD + 2 * TI_DF + TI_FD + TI_QKV + TI_DD + NE * (2 * TI_DF + TI_FD);
__device__ __forceinline__ void weight_copies(Frame& F, int it_lo, int it_hi, int cw, int ncw) {
    LAS float* scr = (LAS float*)(F.lds + RING_OFF + F.wave * 16384);
    constexpr int I_QKV = TI_QKV, I_DD = TI_DD, I_DF = TI_DF, I_FD = TI_FD;
    bf16* WQKV = (bf16*)(F.ws + WS_WQKV); bf16* WO = (bf16*)(F.ws + WS_WO); bf16* WGU = (bf16*)(F.ws + WS_WGU); bf16* WD = (bf16*)(F.ws + WS_WD);
    bf16* WCIN = (bf16*)(F.ws + WS_WCIN); bf16* WCO = (bf16*)(F.ws + WS_WCO); unsigned char* MGU = F.ws + WS_MGU8; unsigned char* MD = F.ws + WS_MD8;
    auto decode = [&](int it, TrItem& I) {
        int r = it; I.gain = nullptr; I.fp8 = 0;
        auto set = [&](const float* W, int ldw, int ncols, void* WT, int Kb) { const int nb = ncols / 32; I.W = W; I.ldw = ldw; I.WT = (unsigned char*)WT; I.Kb = Kb; I.k0 = 64 * (r / nb); I.n0 = 32 * (r % nb); I.drow0 = I.n0; };
        if (r < I_QKV) { set(F.in[I_ATTN_WIN], NIN, NQKV, WQKV, D * 2); return; } r -= I_QKV;
        if (r < I_DD) { set(F.in[I_ATTN_WOUT], D, D, WO, D * 2); return; } r -= I_DD;
        if (r < I_DF) { set(F.in[I_FFN_WG], FF, FF, WGU, D * 2); I.drow0 = map_gate(I.n0); I.gain = F.in[I_FFN_NORM]; I.fp8 = 2; return; } r -= I_DF;
        if (r < I_DF) { set(F.in[I_FFN_WU], FF, FF, WGU, D * 2); I.drow0 = map_up(I.n0); I.gain = F.in[I_FFN_NORM]; I.fp8 = 2; return; } r -= I_DF;
        if (r < I_FD) { set(F.in[I_FFN_WD], D, D, WD, FF * 2); return; } r -= I_FD;
        if (r < I_QKV) { set(F.in[I_CONV_WIN], NQKV, NQKV, WCIN, D * 2); const int n0 = I.n0;
            I.drow0 = n0 < D ? 2 * D + n0 : (n0 < 2 * D ? map_gate(n0 - D) : map_up(n0 - 2 * D)); I.gain = F.in[I_CONV_NORM]; I.fp8 = 2; return; } r -= I_QKV;
        if (r < I_DD) { set(F.in[I_CONV_WOUT], D, D, WCO, D * 2); return; } r -= I_DD;
        const int per_e = 2 * I_DF + I_FD, e = r / per_e; r -= e * per_e; I.fp8 = 1;
        if (r < I_DF) { set(F.in[I_MOE_WG] + (size_t)e * D * FF, FF, FF, MGU + (size_t)e * 2 * FF * D, D); I.drow0 = map_gate(I.n0); I.gain = F.in[I_MOE_NORM]; return; } r -= I_DF;
        if (r < I_DF) { set(F.in[I_MOE_WU] + (size_t)e * D * FF, FF, FF, MGU + (size_t)e * 2 * FF * D, D); I.drow0 = map_up(I.n0); I.gain = F.in[I_MOE_NORM]; return; } r -= I_DF;
        set(F.in[I_MOE_WD] + (size_t)e * FF * D, D, D, MD + (size_t)e * D * FF, FF);
    };
    f32x4 ta[8], tb[8], tc[8], td[8]; float ga[8], gb[8], gc[8], gd[8]; TrItem I; int itA = it_lo + cw; const int step = 4 * ncw;
#define WC_FIRST(T_, G_, OFF_) do { if (itA + (OFF_) < it_hi) { decode(itA + (OFF_), I); tr_load(I, T_, G_, F.lane); } } while (0)
#define WC_STEP(T_, G_, OFF_) do { if (itA + (OFF_) < it_hi) { decode(itA + (OFF_), I); tr_to_lds(I, T_, G_, scr, F.lane); \
            if (itA + (OFF_) + step < it_hi) { decode(itA + (OFF_) + step, I); tr_load(I, T_, G_, F.lane); } \
            decode(itA + (OFF_), I); tr_store(I, scr, F.lane); } } while (0)
    WC_FIRST(ta, ga, 0); WC_FIRST(tb, gb, ncw); WC_FIRST(tc, gc, 2 * ncw); WC_FIRST(td, gd, 3 * ncw);
    while (itA < it_hi) { WC_STEP(ta, ga, 0); WC_STEP(tb, gb, ncw); WC_STEP(tc, gc, 2 * ncw); WC_STEP(td, gd, 3 * ncw); itA += step; }
#undef WC_FIRST
#undef WC_STEP
}
__device__ __forceinline__ void p1_scan_fixup(Frame& F) {
    LAS float* part = (LAS float*)(F.lds + RING_OFF); LAS float* pre = part + 512;
    float* C2 = (float*)(F.ws + WS_C2); const float* CTOT = (const float*)(F.ws + WS_CTOT);
    for (int chunk = blockIdx.x; chunk < NCH; chunk += F.G) {
        const int b = chunk / (SEQ / 128), cb = chunk % (SEQ / 128), hh = F.tid & 15, j = F.tid >> 4;
        float s = 0.f;
        if (j < cb) s += CTOT[(b * (SEQ / 128) + j) * 16 + hh];
        if (j + 32 < cb) s += CTOT[(b * (SEQ / 128) + j + 32) * 16 + hh];
        part[j * 16 + hh] = s;
        __syncthreads();
        if (F.tid < 16) { float t = 0.f; for (int i = 0; i < 32; ++i) t += part[i * 16 + F.tid]; pre[F.tid] = t; }
        __syncthreads();
        const int h2 = F.tid >> 5, t4 = (F.tid & 31) * 4;
        GAS f32x4* p = (GAS f32x4*)(C2 + (size_t)(b * H + h2) * SEQ + cb * 128 + t4);
        const float pr = pre[h2]; const f32x4 v = *p; *p = (f32x4){(v.x + pr) * LOG2E, (v.y + pr) * LOG2E, (v.z + pr) * LOG2E, (v.w + pr) * LOG2E};
        __syncthreads();
    }
}
__device__ __forceinline__ void norm_phase(Frame& F, const float* gain) {
    f32x4 g[4]; load_gain(gain, g, F.lane); bf16* XN = (bf16*)(F.ws + WS_XN);
    const int gw = F.vcu * NWAVES + F.wave, NGW = F.G * NWAVES;
    for (int m = gw; m < M; m += NGW) { f32x4 v[4]; rms_row(F.out + (size_t)m * D, g, v, F.lane); store_row_bf16(XN + (size_t)m * D, v, F.lane); }
}
__device__ __forceinline__ void final_norm_phase(Frame& F) {
    f32x4 g[4]; load_gain(F.in[I_FINAL_NORM], g, F.lane);
    const int gw = F.vcu * NWAVES + F.wave, NGW = F.G * NWAVES;
    for (int m = gw; m < M; m += NGW) { f32x4 v[4]; rms_row(F.out + (size_t)m * D, g, v, F.lane); GAS f32x4* o = (GAS f32x4*)(F.out + (size_t)m * D) + F.lane;
#pragma unroll
        for (int j = 0; j < 4; ++j) o[64 * j] = v[j]; }
}
__device__ __forceinline__ void conv_fixup(Frame& F, int pm) {
    if ((pm % (SEQ / 256)) == 0) return;
    typedef unsigned u32x2 __attribute__((ext_vector_type(2)));
    const bf16* U = (const bf16*)(F.ws + WS_K); bf16* Z = (bf16*)(F.ws + WS_V); const float* cw = F.in[I_CONV_W];
    const float* zp = (const float*)(F.ws + WS_ZP); const float* bgb = (const float*)(F.ws + WS_BGB);
    const int r = F.tid >> 8, c4 = (F.tid & 255) * 4; const size_t g = (size_t)pm * 256 + r, gt0 = (size_t)pm * 256;
    const f32x4 z0 = *(const GAS f32x4*)(zp + ((size_t)pm * 2 + r) * D + c4), gt = *(const GAS f32x4*)(bgb + ((size_t)pm * 2 + r) * D + c4);
    const f32x4 w0 = *(const GAS f32x4*)(cw + c4), w1 = *(const GAS f32x4*)(cw + D + c4);
    const u32x2 ua = *(const GAS u32x2*)(U + (gt0 - 1) * D + c4), ub = *(const GAS u32x2*)(U + (gt0 - 2) * D + c4);
    const f32x4 a = (f32x4){bf_lo(ua.x), bf_hi(ua.x), bf_lo(ua.y), bf_hi(ua.y)}, b = (f32x4){bf_lo(ub.x), bf_hi(ub.x), bf_lo(ub.y), bf_hi(ub.y)};
    const f32x4 z = (r == 0) ? z0 + gt * (w0 * b + w1 * a) : z0 + gt * (w0 * a);
    u32x2 o; o.x = pk2(z.x, z.y); o.y = pk2(z.z, z.w); *(GAS u32x2*)(Z + g * D + c4) = o;
}
__device__ __forceinline__ void store_row_fp8(unsigned char* orow, const f32x4 (&v)[4], int lane) {
    GAS unsigned* o = (GAS unsigned*)orow + lane;
#pragma unroll
    for (int j = 0; j < 4; ++j) o[64 * j] = pg8::pk4_fp8(v[j].x, v[j].y, v[j].z, v[j].w);
}
__device__ __forceinline__ void route_phase(Frame& F) {
    constexpr int WLD = 1032;
    LAS _Float16* wh = (LAS _Float16*)(F.lds + RING_OFF);
    LAS _Float16* wl = wh + NE * WLD;
    LAS int* sel = (LAS int*)(F.lds + RING_OFF + 34816);
    LAS float* gv = (LAS float*)(F.lds + RING_OFF + 34816 + 1024);
    LAS int* wcnt = (LAS int*)(F.lds + RING_OFF + 34816 + 2048);
    static_assert(2 * NE * WLD * 2 <= 34816, "router tables");
    static_assert(D * NE == 16 * NWAVES * 64, "router table fill");
    float rw[16], rg[16];
    { const float* Wr = F.in[I_MOE_WR]; const float* gn = F.in[I_MOE_NORM];
#pragma unroll
      for (int j = 0; j < 16; ++j) { const int i = F.tid + j * NWAVES * 64; rw[j] = Wr[i]; rg[j] = gn[i >> 3]; } }
    unsigned char* XN8 = F.ws + WS_XN8;
    int* LIST = (int*)(F.ws + WS_LIST); unsigned* INV = (unsigned*)(F.ws + WS_INV); float* GT = (float*)(F.ws + WS_GATE); const bf16* HBc = (const bf16*)(F.ws + WS_HB);
    const int r = F.lane & 15, q = F.lane >> 4;
    for (int chunk = blockIdx.x; chunk < NCH; chunk += F.G) {
        const int rc = F.wave * 16 + r, m = chunk * 128 + rc;
        pg8::u32x4 hv[16][2]; { const GAS pg8::u32x4* hp = (const GAS pg8::u32x4*)(HBc + (size_t)m * D + 16 * q);
#pragma unroll
          for (int j = 0; j < 16; ++j) { hv[j][0] = hp[8 * j]; hv[j][1] = hp[8 * j + 1]; } }
        if (chunk == (int)blockIdx.x) {
#pragma unroll
            for (int j = 0; j < 16; ++j) { const int i = F.tid + j * NWAVES * 64, k = i >> 3, e = i & 7; const float w = rw[j] * rg[j]; const _Float16 hi = (_Float16)w;
                wh[e * WLD + k] = hi; wl[e * WLD + k] = (_Float16)((w - (float)hi) * 2048.f); }
            __syncthreads(); }
        pg8::f32x4 aH = (pg8::f32x4){0.f, 0.f, 0.f, 0.f}, aL = aH, aN = aH;
        const LAS _Float16* whp = wh + (r & 7) * WLD + 16 * q; const LAS _Float16* wlp = wl + (r & 7) * WLD + 16 * q;
#pragma unroll
        for (int j = 0; j < 16; ++j)
#pragma unroll
            for (int hf = 0; hf < 2; ++hf) { const pg8::f16x8 x = __builtin_bit_cast(pg8::f16x8, hv[j][hf]);
                const pg8::f16x8 wa = *(const LAS pg8::f16x8*)(whp + 64 * j + 8 * hf), wb = *(const LAS pg8::f16x8*)(wlp + 64 * j + 8 * hf);
                aH = __builtin_amdgcn_mfma_f32_16x16x32_f16(wa, x, aH, 0, 0, 0);
                aL = __builtin_amdgcn_mfma_f32_16x16x32_f16(wb, x, aL, 0, 0, 0);
                aN = __builtin_amdgcn_mfma_f32_16x16x32_f16(x, x, aN, 0, 0, 0); }
        const float dsel = (r & 3) == 0 ? aN[0] : ((r & 3) == 1 ? aN[1] : ((r & 3) == 2 ? aN[2] : aN[3]));
        const float rstd = 1.0f / sqrtf(__shfl(dsel, r + 16 * (r >> 2)) * (1.f / D) + RMS_EPS);
#pragma unroll
        for (int j = 0; j < 16; ++j) { const pg8::u32x4 a = hv[j][0], b = hv[j][1]; pg8::u32x4 o;
            o.x = pg8::pk4_fp8(pg8::h_lo(a.x) * rstd, pg8::h_hi(a.x) * rstd, pg8::h_lo(a.y) * rstd, pg8::h_hi(a.y) * rstd); o.y = pg8::pk4_fp8(pg8::h_lo(a.z) * rstd, pg8::h_hi(a.z) * rstd, pg8::h_lo(a.w) * rstd, pg8::h_hi(a.w) * rstd);
            o.z = pg8::pk4_fp8(pg8::h_lo(b.x) * rstd, pg8::h_hi(b.x) * rstd, pg8::h_lo(b.y) * rstd, pg8::h_hi(b.y) * rstd); o.w = pg8::pk4_fp8(pg8::h_lo(b.z) * rstd, pg8::h_hi(b.z) * rstd, pg8::h_lo(b.w) * rstd, pg8::h_hi(b.w) * rstd);
            *(GAS pg8::u32x4*)(XN8 + (size_t)m * D + 16 * (q + 4 * j)) = o; }
        float own[4], oth[4], lg[NE];
#pragma unroll
        for (int i = 0; i < 4; ++i) { own[i] = (aH[i] + aL[i] * (1.f / 2048.f)) * rstd; oth[i] = __shfl_xor(own[i], 16); }
#pragma unroll
        for (int i = 0; i < 4; ++i) { lg[i] = (q & 1) ? oth[i] : own[i]; lg[4 + i] = (q & 1) ? own[i] : oth[i]; }
        int e1 = 0; float v1 = lg[0];
#pragma unroll
        for (int e = 1; e < NE; ++e) if (lg[e] > v1) { v1 = lg[e]; e1 = e; }
        int e2 = -1; float v2 = -INFINITY;
#pragma unroll
        for (int e = 0; e < NE; ++e) if (e != e1 && lg[e] > v2) { v2 = lg[e]; e2 = e; }
        const float g1 = 1.0f / (1.0f + expf(v2 - v1));
        if (q == 0) { sel[rc * 2] = e1; sel[rc * 2 + 1] = e2; gv[rc * 2] = g1; gv[rc * 2 + 1] = 1.0f - g1; }
        __syncthreads();
        int my_e = -1, my_rank = 0;
        if (F.tid < 256) { my_e = sel[F.tid];
#pragma unroll
            for (int ex = 0; ex < NE; ++ex) { const unsigned long long mk = __ballot(my_e == ex); if (my_e == ex) my_rank = __popcll(mk & ((1ull << F.lane) - 1ull)); if (F.lane == 0) wcnt[F.wave * NE + ex] = __popcll(mk); } }
        __syncthreads();
        if (F.tid < NE) { const int c0 = wcnt[F.tid], c1 = wcnt[NE + F.tid], c2 = wcnt[2 * NE + F.tid], c3 = wcnt[3 * NE + F.tid], tot = c0 + c1 + c2 + c3;
            const int b = tot ? (int)__hip_atomic_fetch_add(F.ctl + CW_MOE + 64 * F.tid, (unsigned)tot, RLX_AGENT) : 0;
            wcnt[F.tid] = b; wcnt[NE + F.tid] = b + c0; wcnt[2 * NE + F.tid] = b + c0 + c1; wcnt[3 * NE + F.tid] = b + c0 + c1 + c2; }
        __syncthreads();
        if (F.tid < 256 && my_e >= 0) { const int pos = wcnt[F.wave * NE + my_e] + my_rank, tok = chunk * 128 + (F.tid >> 1);
            LIST[(size_t)my_e * M + pos] = tok; INV[tok * 2 + (F.tid & 1)] = ((unsigned)my_e << 20) | (unsigned)pos; GT[tok * 2 + (F.tid & 1)] = gv[F.tid]; }
        __syncthreads();
    }
}
__device__ __forceinline__ void moe_table(Frame& F) {
    LAS int* tab = (LAS int*)(F.lds + LDSCTL_OFF);
    if (F.tid < NE) tab[16 + F.tid] = (int)__hip_atomic_load(F.ctl + CW_MOE + 64 * F.tid, RLX_AGENT);
    __syncthreads();
    if (F.tid == 0) { int ts = 0; for (int e = 0; e < NE; ++e) { const int c = tab[16 + e]; tab[e] = ts; ts += (c + 255) >> 8; } tab[8] = ts; }
    __syncthreads();
}
__device__ __forceinline__ void final_phase(Frame& F) {
    typedef unsigned u32x2 __attribute__((ext_vector_type(2)));
    f32x4 g[4]; load_gain(F.in[I_FINAL_NORM], g, F.lane);
    const LAS int* tab = (const LAS int*)(F.lds + LDSCTL_OFF);
    const bf16* Y = (const bf16*)(F.ws + WS_Y); const bf16* HBc = (const bf16*)(F.ws + WS_HB); const unsigned* INV = (const unsigned*)(F.ws + WS_INV); const float* GT = (const float*)(F.ws + WS_GATE);
    const int gw = F.vcu * NWAVES + F.wave, NGW = F.G * NWAVES, nrow = (M - gw + NGW - 1) / NGW;
    for (int k0 = 0; k0 < nrow; k0 += 32) {
        const int kk = k0 + (F.lane >> 1); const bool okl = kk < nrow; const int ml = gw + kk * NGW;
        const unsigned ivl = okl ? INV[ml * 2 + (F.lane & 1)] : 0u; const float gtl = okl ? GT[ml * 2 + (F.lane & 1)] : 0.f;
        const int nb = (nrow - k0) < 32 ? (nrow - k0) : 32;
        u32x2 hw[4], ya[4], yb[4]; float g0 = 0.f, g1 = 0.f;
        auto issue = [&](int k, u32x2 (&h_)[4], u32x2 (&a_)[4], u32x2 (&b_)[4], float& g0_, float& g1_) {
            const unsigned i0 = __shfl(ivl, 2 * k), i1 = __shfl(ivl, 2 * k + 1); g0_ = __shfl(gtl, 2 * k); g1_ = __shfl(gtl, 2 * k + 1);
            const size_t r0 = (size_t)tab[i0 >> 20] * 256 + (i0 & 0xfffffu), r1 = (size_t)tab[i1 >> 20] * 256 + (i1 & 0xfffffu); const int m = gw + (k0 + k) * NGW;
            const GAS u32x2* xr = (const GAS u32x2*)(HBc + (size_t)m * D) + F.lane; const GAS u32x2* y0 = (const GAS u32x2*)(Y + r0 * D) + F.lane; const GAS u32x2* y1 = (const GAS u32x2*)(Y + r1 * D) + F.lane;
#pragma unroll
            for (int j = 0; j < 4; ++j) { h_[j] = xr[64 * j]; a_[j] = y0[64 * j]; b_[j] = y1[64 * j]; } };
        issue(0, hw, ya, yb, g0, g1);
        for (int k = 0; k < nb; ++k) {
            u32x2 hn[4] = {}, an[4] = {}, bn[4] = {}; float g0n = 0.f, g1n = 0.f;
            if (k + 1 < nb) issue(k + 1, hn, an, bn, g0n, g1n);
            f32x4 v[4]; float s = 0.f;
#pragma unroll
            for (int j = 0; j < 4; ++j) { const u32x2 a = ya[j], b = yb[j];
                v[j].x = pg8::h_lo(hw[j].x) + g0 * bf_lo(a.x) + g1 * bf_lo(b.x); v[j].y = pg8::h_hi(hw[j].x) + g0 * bf_hi(a.x) + g1 * bf_hi(b.x);
                v[j].z = pg8::h_lo(hw[j].y) + g0 * bf_lo(a.y) + g1 * bf_lo(b.y); v[j].w = pg8::h_hi(hw[j].y) + g0 * bf_hi(a.y) + g1 * bf_hi(b.y);
                s += (v[j].x * v[j].x + v[j].y * v[j].y) + (v[j].z * v[j].z + v[j].w * v[j].w); }
            const float rstd = 1.0f / sqrtf(wave_sum(s) * (1.f / D) + RMS_EPS);
            GAS f32x4* o = (GAS f32x4*)(F.out + (size_t)(gw + (k0 + k) * NGW) * D) + F.lane;
#pragma unroll
            for (int j = 0; j < 4; ++j) o[64 * j] = v[j] * rstd * g[j];
#pragma unroll
            for (int j = 0; j < 4; ++j) { hw[j] = hn[j]; ya[j] = an[j]; yb[j] = bn[j]; }
            g0 = g0n; g1 = g1n;
        }
    }
}
__device__ __forceinline__ int probe_two() { int n = 2; asm volatile("" : "+s"(n)); return n; }
struct Args { const float* in[19]; float* out; unsigned char* ws; int ph_lo, ph_hi; };
__global__ void __launch_bounds__(NWAVES * 64, 2) mk_fwd(Args args) {
    extern __shared__ __attribute__((aligned(16))) unsigned char lds[];
    Frame F;
    F.lds = (LAS unsigned char*)lds;
    F.MISC = (volatile LAS unsigned*)(F.lds + MISC_OFF);
    F.tid = threadIdx.x; F.lane = F.tid & 63; F.wave = __builtin_amdgcn_readfirstlane(F.tid >> 6);
    F.G = gridDim.x; { const int bx = blockIdx.x; F.vcu = (F.G % 8 == 0) ? (bx % 8) * (F.G / 8) + bx / 8 : bx; }
    F.ws = args.ws; F.out = args.out; F.ctl = (gu32*)(args.ws + WS_CTL);
    F.in = args.in;
    { int t0_ = F.tid; asm volatile("" : "+v"(t0_));
      for (int u = t0_; u < (LDS_BYTES - LDSCTL_OFF) / 4; u += NWAVES * 64) ((LAS unsigned*)(F.lds + LDSCTL_OFF))[u] = 0u; }
    __syncthreads();
    XcdBarrier bar; bar.bar = (unsigned*)(F.ctl + CW_BAR); bar.x = 0; bar.st = nullptr;
    if (!MK_PER_PHASE) bar = xcd_barrier_post((unsigned*)(F.ctl + CW_BAR), F.MISC + 8);
#define GRID_BAR() do { if (!MK_PER_PHASE) xcd_barrier(bar); } while (0)
    const int lo = args.ph_lo, hi = args.ph_hi;
#ifndef PH_MASK
#define PH_MASK 0x1ffff
#endif
#define IN(k) (((PH_MASK >> (k)) & 1) && lo <= (k) && (k) < hi)
#define BOTH(k) (IN(k) && IN((k) + 1))
#ifndef PROBE_PH
#define PROBE_PH (-1)
#endif
#define REP_BEGIN(k) for (int rep_ = 0, nrep_ = ((k) == PROBE_PH ? probe_two() : 1); rep_ < nrep_; ++rep_) {
#define REP_END(k) if (rep_ + 1 < nrep_) GRID_BAR(); }
    bf16* XN = (bf16*)(F.ws + WS_XN); bf16* QO = (bf16*)(F.ws + WS_QO); bf16* KB = (bf16*)(F.ws + WS_K); bf16* VB = (bf16*)(F.ws + WS_V); bf16* HID = (bf16*)(F.ws + WS_HID); bf16* OB = (bf16*)(F.ws + WS_O); bf16* HB = (bf16*)(F.ws + WS_HB);
    const int bx = (int)blockIdx.x;
#ifndef PROBE_T
#define PROBE_T (-1)
#endif
#ifndef PROBE_MULT
#define PROBE_MULT 8
#endif
    unsigned long long pt0_ = 0ull;
#define PH_T0(k) do { if ((k) == PROBE_T) pt0_ = __builtin_amdgcn_s_memrealtime(); } while (0)
#define PH_SPIN(k) do { if ((k) == PROBE_T) { const unsigned long long d_ = __builtin_amdgcn_s_memrealtime() - pt0_; while (__builtin_amdgcn_s_memrealtime() - pt0_ < (1ull + PROBE_MULT) * d_) __builtin_amdgcn_s_sleep(8); } } while (0)
#define REFRESH_F() do { int t_ = threadIdx.x; asm volatile("" : "+v"(t_)); F.tid = t_; F.lane = t_ & 63; } while (0)

    if (IN(0)) { PH_T0(0); REP_BEGIN(0) p0_prologue(F); __syncthreads(); weight_copies(F, 0, N_EARLY, F.vcu * NWAVES + F.wave, F.G * NWAVES); REP_END(0) PH_SPIN(0); if (BOTH(0)) GRID_BAR(); }
    if (IN(1)) {
        PH_T0(1); p1_scan_fixup(F);
        REP_BEGIN(1)
        typedef pg8::DenseSched<D, M / 256, NQKV / 256> Sc; typedef pg8::EpiBf16<D, D> Ep;
        Sc S{F.G, bx, (const char*)(F.ws + WS_WQKV)}; Ep E{QO, (size_t)(WS_K - WS_QO) / 2, QSCALE, (unsigned*)(F.ctl + CW_NRM), SEQ};
        pg8::gemm_phase<D, Ep, Sc, true, true>(F.lds + RING_OFF, (const char*)XN, S, E);
        REP_END(1)
        PH_SPIN(1); if (BOTH(1)) GRID_BAR();
    }
    if (IN(2)) {
        PH_T0(2);
        if (((bx >> 3) & 7) == 0 && F.G == 256) { weight_copies(F, N_EARLY, NITEMS, ((bx >> 6) * 8 + (bx & 7)) * NWAVES + F.wave, 32 * NWAVES); __syncthreads(); }
        else if (F.G != 256) { weight_copies(F, N_EARLY, NITEMS, F.vcu * NWAVES + F.wave, F.G * NWAVES); __syncthreads(); }
        REP_BEGIN(2)
        ATTN_PHASE_BODY
        REP_END(2)
        PH_SPIN(2); if (BOTH(2)) GRID_BAR();
    }
    if (IN(3)) {
        PH_T0(3);
        REP_BEGIN(3)
        typedef pg8::DenseSched<D, M / 256, D / 256> Sc; typedef pg8::EpiResH16<D, false, true> Ep;
        Sc S{F.G, bx, (const char*)(F.ws + WS_WO)}; Ep E{F.in[I_X], HB, (float*)(F.ws + WS_SS)};
        pg8::gemm_phase<D, Ep, Sc, true, true>(F.lds + RING_OFF, (const char*)OB, S, E);
        REP_END(3)
        PH_SPIN(3); if (BOTH(3)) GRID_BAR();
    }
    if (IN(5)) {
        PH_T0(5);
        REP_BEGIN(5)
        typedef pg8::DenseSched<D, M / 256, 2 * FF / 256> Sc; typedef pg8::EpiSwiGLU<FF, true> Ep;
        Sc S{F.G, bx, (const char*)(F.ws + WS_WGU)}; Ep E{HID, pg8::RowScale{(const float*)(F.ws + WS_SS), (PG8_LAS float*)(F.lds + RSTAB_OFF), -1, 1.0f / D, RMS_EPS}};
        pg8::gemm_phase<D, Ep, Sc, true, true, 2>(F.lds + RING_OFF, (const char*)HB, S, E);
        REP_END(5)
        PH_SPIN(5); if (BOTH(5)) GRID_BAR();
    }
    if (IN(6)) {
        PH_T0(6);
        typedef pg8::DenseSched<FF, M / 256, D / 256> Sc; typedef pg8::EpiResH16<D, true, true> Ep;
        Sc S{F.G, bx, (const char*)(F.ws + WS_WD)}; Ep E{HB, HB, (float*)(F.ws + WS_SS)};
        pg8::gemm_phase<FF, Ep, Sc, true, true>(F.lds + RING_OFF, (const char*)HID, S, E);
        PH_SPIN(6); if (BOTH(6)) GRID_BAR();
    }
    if (IN(8)) {
        PH_T0(8);
        REP_BEGIN(8)
        typedef pg8::ConvSched<D, M / 256, D, SEQ / 256> Sc; typedef pg8::EpiConvIn<D> Ep;
        Sc S{F.G, bx, (const char*)(F.ws + WS_WCIN), KB, QO, VB, F.in[I_CONV_W], (float*)(F.ws + WS_ZP), (float*)(F.ws + WS_BGB)}; Ep E{KB, QO, pg8::RowScale{(const float*)(F.ws + WS_SS), (PG8_LAS float*)(F.lds + RSTAB_OFF), -1, 1.0f / D, RMS_EPS}};
        pg8::gemm_phase<D, Ep, Sc, true, true, 2>(F.lds + RING_OFF, (const char*)HB, S, E);
        REP_END(8)
        PH_SPIN(8); if (BOTH(8)) GRID_BAR();
    }
    if (IN(10)) {
        PH_T0(10); REFRESH_F();
        { pg8::Unit u0_; pg8::DenseSched<D, M / 256, D / 256> S0{F.G, bx, nullptr}; for (int i = 0; S0.next(i, u0_); ++i) conv_fixup(F, u0_.pm); VM_WAIT(); __syncthreads(); }
        typedef pg8::DenseSched<D, M / 256, D / 256> Sc; typedef pg8::EpiResH16<D, true, false> Ep;
        Sc S{F.G, bx, (const char*)(F.ws + WS_WCO)}; Ep E{HB, HB, nullptr};
        pg8::gemm_phase<D, Ep, Sc, true, true>(F.lds + RING_OFF, (const char*)VB, S, E);
        PH_SPIN(10); if (BOTH(10)) GRID_BAR();
    }
    if (IN(11)) { PH_T0(11); REFRESH_F(); route_phase(F); PH_SPIN(11); if (BOTH(11)) GRID_BAR(); }
    {
        const int* list = (const int*)(F.ws + WS_LIST); const PG8_LAS int* tab = (const PG8_LAS int*)(F.lds + LDSCTL_OFF);
        if (IN(12)) {
            PH_T0(12); REFRESH_F(); moe_table(F);
            REP_BEGIN(12)
            typedef pg8::MoeSched<true, D / 2, 2 * FF / 256, M> Sc; typedef pg8::EpiSwiGLU8<FF> Ep;
            Sc S{F.G, bx, (const char*)(F.ws + WS_MGU8), tab, list, (const PG8_LAS unsigned short*)(F.lds + GTOK_OFF)}; Ep E{F.ws + WS_HID8};
            S.fill_gtok((PG8_LAS unsigned short*)(F.lds + GTOK_OFF), GTOK_UNITS);
            pg8::gemm_phase<D / 2, Ep, Sc, true, true, 1>(F.lds + RING_OFF, (const char*)(F.ws + WS_XN8), S, E);
            REP_END(12)
            PH_SPIN(12); if (BOTH(12)) GRID_BAR();
        }
        if (IN(13)) {
            PH_T0(13); REFRESH_F(); moe_table(F);
            typedef pg8::MoeSched<false, FF / 2, D / 256, M> Sc; typedef pg8::EpiY8<D> Ep;
            Sc S{F.G, bx, (const char*)(F.ws + WS_MD8), tab, list, nullptr}; Ep E{(bf16*)(F.ws + WS_Y)};
            pg8::gemm_phase<FF / 2, Ep, Sc, true, true, 1>(F.lds + RING_OFF, (const char*)(F.ws + WS_HID8), S, E);
            PH_SPIN(13); if (BOTH(13)) GRID_BAR();
        }
    }
    if (IN(14)) { PH_T0(14); REFRESH_F(); moe_table(F); final_phase(F); PH_SPIN(14); }
#undef IN
#undef BOTH
#undef GRID_BAR
}

extern "C" void kernel_launch(void* const* d_in, const int* in_sizes, int n_in, void* d_out, int out_size, void* d_ws, size_t ws_size, hipStream_t stream) {
    static int grid = 0;
    if (grid == 0) {
        if (n_in != 19 || in_sizes[0] != M * D || out_size != M * D || ws_size < WS_END) { fprintf(stderr, "kernel_launch: built for 19 inputs, x and out of %d floats, >= %zu bytes of workspace; got n_in %d, in0 %d, out %d, ws %zu; nothing launched\n", M * D, (size_t)WS_END, n_in, n_in > 0 ? in_sizes[0] : -1, out_size, ws_size); grid = -1; return; }
        int dev = 0, cus = 0, per_cu = 0;
        if (hipGetDevice(&dev) != hipSuccess || hipDeviceGetAttribute(&cus, hipDeviceAttributeMultiprocessorCount, dev) != hipSuccess) { fprintf(stderr, "kernel_launch: hipGetDevice / hipDeviceGetAttribute failed; nothing launched\n"); grid = -1; return; }
        if (hipFuncSetAttribute((const void*)mk_fwd, hipFuncAttributeMaxDynamicSharedMemorySize, LDS_BYTES) != hipSuccess) { fprintf(stderr, "kernel_launch: hipFuncSetAttribute failed; nothing launched\n"); grid = -1; return; }
        if (hipOccupancyMaxActiveBlocksPerMultiprocessor(&per_cu, (const void*)mk_fwd, NWAVES * 64, LDS_BYTES) != hipSuccess || per_cu < 1)
            fprintf(stderr, "kernel_launch: note: the occupancy query reports %d workgroups per CU\n", per_cu);
        (void)hipGetLastError();
        grid = cus;
    }
    if (grid < 0) return;
    if (hipMemsetAsync((char*)d_ws + WS_CTL, 0, CTL_ZERO_BYTES, stream) != hipSuccess) { fprintf(stderr, "kernel_launch: hipMemsetAsync of the control words failed; nothing launched\n"); return; }
    Args a{};
    for (int i = 0; i < 19; ++i) a.in[i] = (const float*)d_in[i];
    a.out = (float*)d_out; a.ws = (unsigned char*)d_ws;
    const int nl = MK_PER_PHASE ? N_PHASES : 1;
    for (int li = 0; li < nl; ++li) {
        a.ph_lo = MK_PER_PHASE ? li : 0; a.ph_hi = MK_PER_PHASE ? li + 1 : N_PHASES;
        hipLaunchKernelGGL(mk_fwd, dim3(grid), dim3(NWAVES * 64), LDS_BYTES, stream, a);
        const hipError_t le = hipPeekAtLastError();
        if (le != hipSuccess) { fprintf(stderr, "kernel_launch: launch %d failed: %s\n", li, hipGetErrorName(le)); break; }
    }
}
```

```cpp
#include <hip/hip_runtime.h>
#include <hip/hip_bf16.h>
#include <cstdio>
#include <cstdint>
#include <cmath>
namespace pg8 {
#define PG8_LAS __attribute__((address_space(3)))
typedef unsigned short bf16_t;
typedef short bf16x8 __attribute__((ext_vector_type(8)));
typedef float f32x4 __attribute__((ext_vector_type(4)));
typedef float f32x2 __attribute__((ext_vector_type(2)));
typedef unsigned u32x4 __attribute__((ext_vector_type(4)));
typedef int i32x4 __attribute__((ext_vector_type(4)));
typedef int i32x8 __attribute__((ext_vector_type(8)));
typedef _Float16 f16x8 __attribute__((ext_vector_type(8)));
typedef _Float16 f16x2 __attribute__((ext_vector_type(2)));
typedef unsigned u32x2 __attribute__((ext_vector_type(2)));
constexpr int BM = 256, BK = 64, HALF = 128, HTB = HALF * BK * 2  , STAGE_BYTES = 8 * HTB, NXCD = 8, WGM = 8;

__host__ __device__ __forceinline__ int lds_byte(int r, int c) { const int st = (r >> 4) * 2 + (c >> 5), rr = r & 15, cc = c & 31, ob = rr * 64 + cc * 2; return st * 1024 + (ob ^ (((ob >> 9) & 1) << 5)); }
__host__ __device__ __forceinline__ void stage_rc(int b, int& R, int& C) { const int st = b / 1024, sb = b % 1024, swz = sb ^ (((sb >> 9) & 1) << 5); R = (st >> 1) * 16 + swz / 64; C = (st & 1) * 32 + (swz % 64) / 2; }
__host__ __device__ __forceinline__ int perm32(int rho) { const int n = rho >> 4, i = rho & 15; return 8 * (i >> 2) + 4 * n + (i & 3); }

struct Unit { int pm, pn, e, lrow0, ui; };

template <int WG = WGM> __device__ __forceinline__ bool tile_order(int i, int G, int c, int nM, int nN, int& pm, int& pn) {
    const int nwg = nM * nN; const long L = (long)i * G + c; if (L >= nwg) return false;
    int wgid = (int)L; { const int q = nwg / NXCD, r = nwg % NXCD, xcd = wgid % NXCD, off = wgid / NXCD; wgid = (xcd < r ? xcd * (q + 1) : r * (q + 1) + (xcd - r) * q) + off; }
    const int nig = WG * nN, gid = wgid / nig, fm = gid * WG, gsz = (nM - fm) < WG ? (nM - fm) : WG;
    pm = fm + ((wgid % nig) % gsz); pn = (wgid % nig) / gsz; return true;
}
template <int K, int nM, int nN, int WG = WGM> struct DenseSched {
    int G, c; const char* Bt;
    __device__ __forceinline__ bool next(int i, Unit& u) const { u.e = 0; u.lrow0 = 0; u.ui = i; return tile_order<WG>(i, G, c, nM, nN, u.pm, u.pn); }
    __device__ __forceinline__ unsigned a_off(const Unit& u, int r) const { return (unsigned)(u.pm * BM + r) * (unsigned)(K * 2); }
    __device__ __forceinline__ const char* b_ptr(const Unit& u) const { return Bt + (size_t)u.pn * BM * K * 2; }
    __device__ __forceinline__ void a_ready(const Unit&) const {}
    __device__ __forceinline__ void done(const Unit&) const {}
};
__device__ __forceinline__ unsigned cvt_pk_bf16(float lo, float hi);
template <int K, int nM, int ldc, int tiles_per_seq, int WG = WGM> struct ConvSched {
    int G, c; const char* Bt; const bf16_t* U; const bf16_t* Bg; bf16_t* Z; const float* cw; float* zp; float* bgb;
    __device__ __forceinline__ bool next(int i, Unit& u) const { const int tr = i / 3, sub = i - 3 * tr; int pm, a; if (!tile_order<WG>(tr, G, c, nM, 4, pm, a)) return false;
        u.pm = pm; u.pn = sub < 2 ? 2 * a + sub : 8 + a; u.e = 0; u.lrow0 = 0; u.ui = i; return true; }
    __device__ __forceinline__ unsigned a_off(const Unit& u, int r) const { return (unsigned)(u.pm * BM + r) * (unsigned)(K * 2); }
    __device__ __forceinline__ const char* b_ptr(const Unit& u) const { return Bt + (size_t)u.pn * BM * K * 2; }
    __device__ __forceinline__ void a_ready(const Unit&) const {}
    __device__ __forceinline__ void done(const Unit& u) const {
        if (u.pn < 8) return;
        asm volatile("s_waitcnt vmcnt(0)" ::: "memory"); __builtin_amdgcn_s_barrier(); asm volatile("" ::: "memory");
        int t = threadIdx.x; asm volatile("" : "+v"(t));
        const int cg = t & 31, rsl = t >> 5, col = (u.pn - 8) * BM + 8 * cg, r0 = 16 * rsl; const size_t g0 = (size_t)u.pm * BM + r0;
        const bool seam = (u.pm % tiles_per_seq) != 0;
        float w0[8], w1[8], w2[8];
#pragma unroll
        for (int i = 0; i < 8; ++i) { w0[i] = cw[col + i]; w1[i] = cw[ldc + col + i]; w2[i] = cw[2 * ldc + col + i]; }
        u32x4 u1 = (u32x4){0u, 0u, 0u, 0u}, u2 = (u32x4){0u, 0u, 0u, 0u};
        if (r0 > 0) { u1 = *(const u32x4*)(U + (g0 - 1) * ldc + col); u2 = *(const u32x4*)(U + (g0 - 2) * ldc + col); }
#pragma unroll 1
        for (int rb = 0; rb < 16; rb += 4) { u32x4 uu[4], bb[4];
#pragma unroll
            for (int k = 0; k < 4; ++k) { uu[k] = *(const u32x4*)(U + (g0 + rb + k) * ldc + col); bb[k] = *(const u32x4*)(Bg + (g0 + rb + k) * ldc + col); }
#pragma unroll
            for (int k = 0; k < 4; ++k) { float zf[8], gf[8]; u32x4 o;
#pragma unroll
                for (int j = 0; j < 4; ++j) {
                    const float b0 = __uint_as_float(bb[k][j] << 16), b1 = __uint_as_float(bb[k][j] & 0xffff0000u);
                    const float c0 = w0[2 * j] * __uint_as_float(u2[j] << 16) + w1[2 * j] * __uint_as_float(u1[j] << 16) + w2[2 * j] * __uint_as_float(uu[k][j] << 16);
                    const float c1 = w0[2 * j + 1] * __uint_as_float(u2[j] & 0xffff0000u) + w1[2 * j + 1] * __uint_as_float(u1[j] & 0xffff0000u) + w2[2 * j + 1] * __uint_as_float(uu[k][j] & 0xffff0000u);
                    zf[2 * j] = b0 * c0; zf[2 * j + 1] = b1 * c1; gf[2 * j] = b0; gf[2 * j + 1] = b1; o[j] = cvt_pk_bf16(zf[2 * j], zf[2 * j + 1]); }
                *(u32x4*)(Z + (g0 + rb + k) * ldc + col) = o;
                if (seam && r0 + rb + k < 2) { float* p = zp + ((size_t)u.pm * 2 + rb + k) * ldc + col; float* q = bgb + ((size_t)u.pm * 2 + rb + k) * ldc + col;
                    *(f32x4*)p = (f32x4){zf[0], zf[1], zf[2], zf[3]}; *(f32x4*)(p + 4) = (f32x4){zf[4], zf[5], zf[6], zf[7]}; *(f32x4*)q = (f32x4){gf[0], gf[1], gf[2], gf[3]}; *(f32x4*)(q + 4) = (f32x4){gf[4], gf[5], gf[6], gf[7]}; }
                u2 = u1; u1 = uu[k]; } }
    }
};
template <bool GATHER, int K, int nN, int ntok, int WG = WGM> struct MoeSched {
    static constexpr size_t estride = (size_t)nN * BM * K * 2;
    int G, c; const char* Bt; const PG8_LAS int* tab; const int* list; const PG8_LAS unsigned short* gtok;
    __device__ __forceinline__ bool next(int i, Unit& u) const {
        const int nM = __builtin_amdgcn_readfirstlane(tab[8]); if (!tile_order<WG>(i, G, c, nM, nN, u.pm, u.pn)) return false;
        int e = 0;
#pragma unroll
        for (int j = 1; j < 8; ++j) e += (u.pm >= __builtin_amdgcn_readfirstlane(tab[j])) ? 1 : 0;
        u.e = e; u.lrow0 = (u.pm - __builtin_amdgcn_readfirstlane(tab[e])) * BM; u.ui = i; return true;
    }
    __device__ __forceinline__ unsigned a_off(const Unit& u, int r) const {
        if (GATHER) return (unsigned)gtok[u.ui * BM + r] * (unsigned)(K * 2);
        return (unsigned)(u.pm * BM + r) * (unsigned)(K * 2);
    }
    __device__ __forceinline__ const char* b_ptr(const Unit& u) const { return Bt + (size_t)u.e * estride + (size_t)u.pn * BM * K * 2; }
    __device__ __forceinline__ void a_ready(const Unit&) const {}
    __device__ __forceinline__ void done(const Unit&) const {}
    __device__ __forceinline__ void fill_gtok(PG8_LAS unsigned short* g, int max_units) const {
        const int t = (int)threadIdx.x & (BM - 1), par = __builtin_amdgcn_readfirstlane((int)threadIdx.x >> 8);
        for (int i0 = 0; i0 < max_units; i0 += 16) { int v[8]; bool okk[8];
#pragma unroll
            for (int k = 0; k < 8; ++k) { Unit u; const int i = i0 + 2 * k + par; okk[k] = i < max_units && next(i, u); v[k] = 0;
                if (okk[k]) { const int cnt = __builtin_amdgcn_readfirstlane(tab[16 + u.e]); const int lr = u.lrow0 + t; if (lr < cnt) v[k] = list[(size_t)u.e * ntok + lr]; } }
#pragma unroll
            for (int k = 0; k < 8; ++k) if (okk[k]) g[(i0 + 2 * k + par) * BM + t] = (unsigned short)v[k]; }
        __syncthreads();
    }
};

__device__ __forceinline__ unsigned cvt_pk_bf16(float lo, float hi) { unsigned r; asm volatile("v_cvt_pk_bf16_f32 %0, %1, %2" : "=v"(r) : "v"(lo), "v"(hi)); return r; }
__device__ __forceinline__ unsigned pk2h(float lo, float hi) { const f16x2 v = {(_Float16)lo, (_Float16)hi}; return __builtin_bit_cast(unsigned, v); }
__device__ __forceinline__ float h_lo(unsigned w) { return (float)__builtin_bit_cast(f16x2, w)[0]; }
__device__ __forceinline__ float h_hi(unsigned w) { return (float)__builtin_bit_cast(f16x2, w)[1]; }
__device__ __forceinline__ float swiglu_raw(float ag, float au, float c1, float c2) { const float e = __builtin_amdgcn_exp2f(ag * c1); return (ag * au) * __builtin_amdgcn_rcpf(__builtin_fmaf(e, c2, c2)); }
__device__ __forceinline__ f32x4 swiglu_raw4(f32x4 ag, f32x4 au, float c1, float c2) {
    const f32x4 t = ag * c1; f32x4 e; e[0] = __builtin_amdgcn_exp2f(t[0]); e[1] = __builtin_amdgcn_exp2f(t[1]); e[2] = __builtin_amdgcn_exp2f(t[2]); e[3] = __builtin_amdgcn_exp2f(t[3]);
    const f32x4 d = e * c2 + c2; f32x4 q; q[0] = __builtin_amdgcn_rcpf(d[0]); q[1] = __builtin_amdgcn_rcpf(d[1]); q[2] = __builtin_amdgcn_rcpf(d[2]); q[3] = __builtin_amdgcn_rcpf(d[3]);
    return (ag * au) * q; }
__device__ __forceinline__ float silu_f(float g) { return g * __builtin_amdgcn_rcpf(1.0f + __builtin_amdgcn_exp2f(-1.4426950408889634f * g)); }

template <int ldc, int split_cols> struct EpiBf16 {
    static constexpr bool PERM = true;
    bf16_t* O; size_t split_stride; float scale0;
    unsigned* nrm; int rows_per_batch;
    __device__ __forceinline__ void operator()(const f32x4 (&acc)[2][2][4][2], const Unit& u, int wr, int wc, int fr, int fq) const {
        const int row0 = u.pm * BM + wr * 64 + fr; int colt = u.pn * BM; bf16_t* base = O; int tsel = 0;
        float sc = 1.f; if (split_cols) { const int t = colt / split_cols; tsel = t; base += (size_t)t * split_stride; colt -= t * split_cols; if (t == 0) sc = scale0; }
        const int col0 = colt + wc * 32 + 8 * fq;
        if (nrm && tsel < 2) {
#pragma unroll
            for (int bj = 0; bj < 2; ++bj) { float mx = 0.f;
#pragma unroll
                for (int ai = 0; ai < 2; ++ai)
#pragma unroll
                    for (int m = 0; m < 4; ++m) { const f32x4 v0 = acc[ai][bj][m][0] * sc, v1 = acc[ai][bj][m][1] * sc;
                        float s2 = ((v0[0] * v0[0] + v0[1] * v0[1]) + (v0[2] * v0[2] + v0[3] * v0[3])) + ((v1[0] * v1[0] + v1[1] * v1[1]) + (v1[2] * v1[2] + v1[3] * v1[3]));
                        s2 += __shfl_xor(s2, 16); s2 += __shfl_xor(s2, 32); mx = fmaxf(mx, s2); }
                mx = fmaxf(mx, __shfl_xor(mx, 1)); mx = fmaxf(mx, __shfl_xor(mx, 2)); mx = fmaxf(mx, __shfl_xor(mx, 4)); mx = fmaxf(mx, __shfl_xor(mx, 8));
                const int head = (colt + bj * HALF + wc * 32) >> 6, b = (u.pm * BM) / rows_per_batch;
                if ((fr | fq) == 0) __hip_atomic_fetch_max(nrm + ((tsel * 64 + b * 16 + head) * 2 + (wc & 1)), __float_as_uint(mx), __ATOMIC_RELAXED, __HIP_MEMORY_SCOPE_AGENT); }
        }
#pragma unroll
        for (int ai = 0; ai < 2; ++ai)
#pragma unroll
            for (int m = 0; m < 4; ++m) { bf16_t* rowp = base + (size_t)(row0 + ai * HALF + m * 16) * ldc + col0;
#pragma unroll
                for (int bj = 0; bj < 2; ++bj) { const f32x4 v0 = acc[ai][bj][m][0] * sc, v1 = acc[ai][bj][m][1] * sc;
                    u32x4 w; w.x = cvt_pk_bf16(v0[0], v0[1]); w.y = cvt_pk_bf16(v0[2], v0[3]); w.z = cvt_pk_bf16(v1[0], v1[1]); w.w = cvt_pk_bf16(v1[2], v1[3]);
                    *(u32x4*)(rowp + bj * HALF) = w; } }
    }
};
struct RowScale {
    const float* ss; PG8_LAS float* tab; int last_pm; float inv_n, eps;
    __device__ __forceinline__ void prepare(int pm) {
        if (pm == last_pm) return;
        last_pm = pm;
        const int t = threadIdx.x, row = t >> 1, h = t & 1;
        const f32x4* p = (const f32x4*)(ss + ((size_t)pm * BM + row) * 16 + h * 8);
        const f32x4 a = p[0], b = p[1]; float s = ((a[0] + a[1]) + (a[2] + a[3])) + ((b[0] + b[1]) + (b[2] + b[3]));
        s += __shfl_xor(s, 1);
        asm volatile("s_waitcnt lgkmcnt(0)" ::: "memory"); __builtin_amdgcn_s_barrier(); asm volatile("" ::: "memory");
        if (h == 0) tab[row] = 1.0f / sqrtf(s * inv_n + eps);
        asm volatile("s_waitcnt lgkmcnt(0)" ::: "memory"); __builtin_amdgcn_s_barrier(); asm volatile("" ::: "memory");
    }
    __device__ __forceinline__ float get(int r) const { return tab[r]; }
};
__device__ __forceinline__ unsigned pk4_fp8(float a, float b, float c, float d) { int p = __builtin_amdgcn_cvt_pk_fp8_f32(a, b, 0, false); p = __builtin_amdgcn_cvt_pk_fp8_f32(c, d, p, true); return (unsigned)p; }
constexpr float W8_SCALE = 256.f, H8_SCALE = 4.f;
template <int ldh> struct EpiSwiGLU8 {
    static constexpr bool PERM = true;
    unsigned char* H;
    __device__ __forceinline__ void operator()(const f32x4 (&acc)[2][2][4][2], const Unit& u, int wr, int wc, int fr, int fq) {
        const int row0 = u.pm * BM + wr * 64 + fr + (fq & 1) * 16, col0 = u.pn * HALF + wc * 32 + 16 * (fq >> 1); const float c1 = -1.4426950408889634f / W8_SCALE, c2 = W8_SCALE * W8_SCALE / H8_SCALE;
#pragma unroll
        for (int ai = 0; ai < 2; ++ai)
#pragma unroll
            for (int p = 0; p < 2; ++p) { u32x2 w[2];
#pragma unroll
                for (int q = 0; q < 2; ++q) { const int m = 2 * p + q;
                    const f32x4 g0 = acc[ai][0][m][0], g1 = acc[ai][0][m][1], u0 = acc[ai][1][m][0], u1 = acc[ai][1][m][1];
                    const f32x4 o0 = swiglu_raw4(g0, u0, c1, c2), o1 = swiglu_raw4(g1, u1, c1, c2);
                    w[q].x = pk4_fp8(o0[0], o0[1], o0[2], o0[3]); w[q].y = pk4_fp8(o1[0], o1[1], o1[2], o1[3]); }
                const auto r0 = __builtin_amdgcn_permlane16_swap(w[0].x, w[1].x, false, false), r1 = __builtin_amdgcn_permlane16_swap(w[0].y, w[1].y, false, false);
                u32x4 o; o.x = r0[0]; o.y = r1[0]; o.z = r0[1]; o.w = r1[1];
                *(u32x4*)(H + (size_t)(row0 + ai * HALF + p * 32) * ldh + col0) = o; }
    }
};
template <int ldc> struct EpiY8 {
    static constexpr bool PERM = true;
    bf16_t* Y;
    __device__ __forceinline__ void operator()(const f32x4 (&acc)[2][2][4][2], const Unit& u, int wr, int wc, int fr, int fq) {
        const int row0 = u.pm * BM + wr * 64 + fr, col0 = u.pn * BM + wc * 32 + 8 * fq; const float sc = 1.0f / (W8_SCALE * H8_SCALE);
#pragma unroll
        for (int ai = 0; ai < 2; ++ai)
#pragma unroll
            for (int m = 0; m < 4; ++m) { bf16_t* rowp = Y + (size_t)(row0 + ai * HALF + m * 16) * ldc + col0;
#pragma unroll
                for (int bj = 0; bj < 2; ++bj) { const f32x4 v0 = acc[ai][bj][m][0] * sc, v1 = acc[ai][bj][m][1] * sc;
                    u32x4 w; w.x = cvt_pk_bf16(v0[0], v0[1]); w.y = cvt_pk_bf16(v0[2], v0[3]); w.z = cvt_pk_bf16(v1[0], v1[1]); w.w = cvt_pk_bf16(v1[2], v1[3]);
                    *(u32x4*)(rowp + bj * HALF) = w; } }
    }
};
template <int ldh, bool SCALED = false> struct EpiSwiGLU {
    static constexpr bool PERM = true;
    bf16_t* H; RowScale rs;
    __device__ __forceinline__ void operator()(const f32x4 (&acc)[2][2][4][2], const Unit& u, int wr, int wc, int fr, int fq) {
        const int row0 = u.pm * BM + wr * 64 + fr, col0 = u.pn * HALF + wc * 32 + 8 * fq;
        if (SCALED) rs.prepare(u.pm);
#pragma unroll
        for (int ai = 0; ai < 2; ++ai)
#pragma unroll
            for (int m = 0; m < 4; ++m) { bf16_t* rowp = H + (size_t)(row0 + ai * HALF + m * 16) * ldh + col0;
                const float r = SCALED ? rs.get(ai * HALF + wr * 64 + m * 16 + fr) : 1.0f, c1 = -1.4426950408889634f * r, c2 = __builtin_amdgcn_rcpf(r * r);
                const f32x4 g0 = acc[ai][0][m][0], g1 = acc[ai][0][m][1], u0 = acc[ai][1][m][0], u1 = acc[ai][1][m][1];
                const f32x4 o0 = swiglu_raw4(g0, u0, c1, c2), o1 = swiglu_raw4(g1, u1, c1, c2);
                u32x4 w; w.x = cvt_pk_bf16(o0[0], o0[1]); w.y = cvt_pk_bf16(o0[2], o0[3]); w.z = cvt_pk_bf16(o1[0], o1[1]); w.w = cvt_pk_bf16(o1[2], o1[3]);
                *(u32x4*)rowp = w; }
    }
};
template <int ldc> struct EpiConvIn {
    static constexpr bool PERM = true;
    bf16_t* U; bf16_t* Bg; RowScale rs;
    __device__ __forceinline__ void operator()(const f32x4 (&acc)[2][2][4][2], const Unit& u, int wr, int wc, int fr, int fq) {
        const int row0 = u.pm * BM + wr * 64 + fr;
        rs.prepare(u.pm);
        if (u.pn < 8) {
            const int col0 = u.pn * HALF + wc * 32 + 8 * fq;
#pragma unroll
            for (int ai = 0; ai < 2; ++ai)
#pragma unroll
                for (int m = 0; m < 4; ++m) { bf16_t* rowp = U + (size_t)(row0 + ai * HALF + m * 16) * ldc + col0;
                    const float r = rs.get(ai * HALF + wr * 64 + m * 16 + fr), r2 = r * r;
                    const f32x4 a0 = acc[ai][0][m][0] * acc[ai][1][m][0] * r2, a1 = acc[ai][0][m][1] * acc[ai][1][m][1] * r2;
                    u32x4 w; w.x = cvt_pk_bf16(a0[0], a0[1]); w.y = cvt_pk_bf16(a0[2], a0[3]); w.z = cvt_pk_bf16(a1[0], a1[1]); w.w = cvt_pk_bf16(a1[2], a1[3]);
                    *(u32x4*)rowp = w; }
        } else {
            const int col0 = (u.pn - 8) * BM + wc * 32 + 8 * fq;
#pragma unroll
            for (int ai = 0; ai < 2; ++ai)
#pragma unroll
                for (int m = 0; m < 4; ++m) { bf16_t* rowp = Bg + (size_t)(row0 + ai * HALF + m * 16) * ldc + col0; const float r = rs.get(ai * HALF + wr * 64 + m * 16 + fr);
#pragma unroll
                    for (int bj = 0; bj < 2; ++bj) { const f32x4 v0 = acc[ai][bj][m][0] * r, v1 = acc[ai][bj][m][1] * r;
                        u32x4 w; w.x = cvt_pk_bf16(v0[0], v0[1]); w.y = cvt_pk_bf16(v0[2], v0[3]); w.z = cvt_pk_bf16(v1[0], v1[1]); w.w = cvt_pk_bf16(v1[2], v1[3]);
                        *(u32x4*)(rowp + bj * HALF) = w; } }
        }
    }
};
template <int ldc, bool BASE16, bool STATS> struct EpiResH16 {
    static constexpr bool PERM = true;
    const void* base; unsigned short* hb; float* ss;
    __device__ __forceinline__ void operator()(f32x4 (&acc)[2][2][4][2], const Unit& u, int wr, int wc, int fr, int fq) const {
        const int row0 = u.pm * BM + wr * 64 + fr, col0 = u.pn * BM + wc * 32 + 8 * fq;
#pragma unroll
        for (int ai = 0; ai < 2; ++ai) { f32x4 pre[4][2][2];
#pragma unroll
            for (int m = 0; m < 4; ++m)
#pragma unroll
                for (int bj = 0; bj < 2; ++bj) { const size_t off = (size_t)(row0 + ai * HALF + m * 16) * ldc + col0 + bj * HALF;
                    if (BASE16) pre[m][bj][0] = __builtin_bit_cast(f32x4, *(const u32x4*)((const unsigned short*)base + off));
                    else { pre[m][bj][0] = *(const f32x4*)((const float*)base + off); pre[m][bj][1] = *(const f32x4*)((const float*)base + off + 4); } }
            asm volatile("s_waitcnt vmcnt(0)" ::: "memory");
#pragma unroll
            for (int m = 0; m < 4; ++m) { const int row = row0 + ai * HALF + m * 16; const size_t off = (size_t)row * ldc + col0; float s = 0.f;
#pragma unroll
                for (int bj = 0; bj < 2; ++bj) { f32x4 b0, b1;
                    if (BASE16) { const u32x4 w = __builtin_bit_cast(u32x4, pre[m][bj][0]); b0 = (f32x4){h_lo(w.x), h_hi(w.x), h_lo(w.y), h_hi(w.y)}; b1 = (f32x4){h_lo(w.z), h_hi(w.z), h_lo(w.w), h_hi(w.w)}; }
                    else { b0 = pre[m][bj][0]; b1 = pre[m][bj][1]; }
                    const f32x4 v0 = b0 + acc[ai][bj][m][0], v1 = b1 + acc[ai][bj][m][1];
                    if (STATS) s += ((v0[0] * v0[0] + v0[1] * v0[1]) + (v0[2] * v0[2] + v0[3] * v0[3])) + ((v1[0] * v1[0] + v1[1] * v1[1]) + (v1[2] * v1[2] + v1[3] * v1[3]));
                    u32x4 w; w.x = pk2h(v0[0], v0[1]); w.y = pk2h(v0[2], v0[3]); w.z = pk2h(v1[0], v1[1]); w.w = pk2h(v1[2], v1[3]);
                    *(u32x4*)(hb + off + bj * HALF) = w; }
                if (STATS) { s += __shfl_xor(s, 16); s += __shfl_xor(s, 32); if (fq == 0) ss[(size_t)row * 16 + u.pn * 4 + wc] = s; } }
            asm volatile("" ::: "memory"); }
    }
};
template <int ldc, int ntok> struct EpiMoeDown {
    static constexpr bool PERM = false;
    float* out; const int* list; const float* glist; const PG8_LAS int* tab;
    __device__ __forceinline__ void operator()(const f32x4 (&acc)[2][2][4][2], const Unit& u, int wr, int wc, int fr, int fq) const {
        const int col0 = u.pn * BM + wc * 32 + 4 * fq, cnt = __builtin_amdgcn_readfirstlane(tab[16 + u.e]); const size_t lb = (size_t)u.e * ntok;
#pragma unroll
        for (int ai = 0; ai < 2; ++ai)
#pragma unroll
            for (int m = 0; m < 4; ++m) { const int lr = u.lrow0 + ai * HALF + wr * 64 + m * 16 + fr;
                if (lr < cnt) { const int tok = list[lb + lr]; const float g = glist[lb + lr]; const size_t off = (size_t)tok * ldc + col0;
#pragma unroll
                    for (int bj = 0; bj < 2; ++bj)
#pragma unroll
                        for (int n = 0; n < 2; ++n) { const f32x4 b = *(const f32x4*)(out + off + bj * HALF + n * 16); *(f32x4*)(out + off + bj * HALF + n * 16) = b + acc[ai][bj][m][n] * g; } }
                asm volatile("" ::: "memory"); }
    }
};

template <int K, class Epi, class Sched, bool ALIGN_EPI = false, bool SP2 = false, int DT = 0>
__device__ __forceinline__ void gemm_phase(PG8_LAS unsigned char* lds, const char* Abase, const Sched& S, Epi& E) {
    constexpr bool FP8 = (DT == 1);
    const int tid = threadIdx.x, wid = __builtin_amdgcn_readfirstlane(tid >> 6), lane = tid & 63, wr = wid >> 2, wc = wid & 3, fr = lane & 15, fq = lane >> 4;
    constexpr int nt = K / BK; static_assert(K % (2 * BK) == 0 && K >= 4 * BK, "K: a multiple of 128, at least 256");
    int RA[2]; unsigned cofA[2], voffB[2];
#pragma unroll
    for (int i = 0; i < 2; ++i) { int R, C; stage_rc(tid * 16 + i * 8192, R, C); const int Rb = Epi::PERM ? ((R & ~31) + perm32(R & 31)) : R;
        RA[i] = R; cofA[i] = (unsigned)C * 2u; voffB[i] = (unsigned)(Rb * K + C) * 2u; }
    const size_t kstep = (size_t)(BK * 2);
    const size_t hstep = (size_t)HALF * K * 2;
    const unsigned ldsw = (unsigned)wid * 1024u;
    const int aoff = lds_byte(wr * 64 + fr, fq * 8), boff = lds_byte(wc * 32 + fr, fq * 8);
#define PG8_SA(b, h) (((b) * 2 + (h)) * HTB)
#define PG8_SB(b, h) ((4 + (b) * 2 + (h)) * HTB)
#define PG8_STAGE(bufoff, gbase, voff) do { _Pragma("unroll") for (int _i = 0; _i < 2; ++_i) \
        __builtin_amdgcn_global_load_lds((const unsigned*)((const char*)(gbase) + (voff)[_i]), (PG8_LAS unsigned*)(lds + (bufoff) + ldsw + _i * 8192), 16, 0, 0); } while (0)
#define PG8_LD16(off) (*(const PG8_LAS i32x4*)(lds + (off)))
#define PG8_LDA(dst, b, h) do { _Pragma("unroll") for (int m = 0; m < 4; ++m) { const i32x4 lo_ = PG8_LD16(PG8_SA(b, h) + aoff + m * 2048), hi_ = PG8_LD16(PG8_SA(b, h) + aoff + m * 2048 + 1024); \
        if constexpr (FP8) dst##8[m] = __builtin_shufflevector(lo_, hi_, 0, 1, 2, 3, 4, 5, 6, 7); else { dst[m][0] = __builtin_bit_cast(bf16x8, lo_); dst[m][1] = __builtin_bit_cast(bf16x8, hi_); } } } while (0)
#define PG8_LDB(dst, b, h) do { _Pragma("unroll") for (int n = 0; n < 2; ++n) { const i32x4 lo_ = PG8_LD16(PG8_SB(b, h) + boff + n * 2048), hi_ = PG8_LD16(PG8_SB(b, h) + boff + n * 2048 + 1024); \
        if constexpr (FP8) dst##8[n] = __builtin_shufflevector(lo_, hi_, 0, 1, 2, 3, 4, 5, 6, 7); else { dst[n][0] = __builtin_bit_cast(bf16x8, lo_); dst[n][1] = __builtin_bit_cast(bf16x8, hi_); } } } while (0)
#define PG8_MFMA_ASM(OP, ACC, B_, A_, Z) do { if constexpr (Z) asm volatile(OP " %0, %1, %2, 0" : "=&v"(ACC) : "v"(B_), "v"(A_)); else asm volatile(OP " %0, %1, %2, %0" : "+v"(ACC) : "v"(B_), "v"(A_)); } while (0)
#define PG8_MMA(ai, bj, At, Bt, Z) do { \
        if constexpr (FP8) { _Pragma("unroll") for (int m = 0; m < 4; ++m) _Pragma("unroll") for (int n = 0; n < 2; ++n) PG8_MFMA_ASM("v_mfma_f32_16x16x128_f8f6f4", acc[ai][bj][m][n], Bt##8[n], At##8[m], Z); } \
        else if constexpr (DT == 2) { _Pragma("unroll") for (int m = 0; m < 4; ++m) _Pragma("unroll") for (int n = 0; n < 2; ++n) PG8_MFMA_ASM("v_mfma_f32_16x16x32_f16", acc[ai][bj][m][n], Bt[n][0], At[m][0], Z); \
                                      _Pragma("unroll") for (int m = 0; m < 4; ++m) _Pragma("unroll") for (int n = 0; n < 2; ++n) PG8_MFMA_ASM("v_mfma_f32_16x16x32_f16", acc[ai][bj][m][n], Bt[n][1], At[m][1], false); } \
        else { _Pragma("unroll") for (int m = 0; m < 4; ++m) _Pragma("unroll") for (int n = 0; n < 2; ++n) PG8_MFMA_ASM("v_mfma_f32_16x16x32_bf16", acc[ai][bj][m][n], Bt[n][0], At[m][0], Z); \
               _Pragma("unroll") for (int m = 0; m < 4; ++m) _Pragma("unroll") for (int n = 0; n < 2; ++n) PG8_MFMA_ASM("v_mfma_f32_16x16x32_bf16", acc[ai][bj][m][n], Bt[n][1], At[m][1], false); } \
        } while (0)
#define PG8_WAIT_V(n) asm volatile("s_waitcnt vmcnt(" #n ")" ::: "memory")
#define PG8_WAIT_L(n) asm volatile("s_waitcnt lgkmcnt(" #n ")" ::: "memory")
#define PG8_BAR __builtin_amdgcn_s_barrier()
#define PG8_SCHED __builtin_amdgcn_sched_barrier(0)
    Unit cur, nxt; int ui = 0;
    if (!S.next(0, cur)) return;
    f32x4 acc[2][2][4][2];
    bf16x8 At[4][2], B0[2][2], B1[2][2]; i32x8 At8[4], B08[2], B18[2];
    unsigned c0[2], c1[2], n0[2], n1[2];
#pragma unroll
    for (int i = 0; i < 2; ++i) { c0[i] = S.a_off(cur, RA[i]) + cofA[i]; c1[i] = S.a_off(cur, HALF + RA[i]) + cofA[i]; }
    const char* cB = S.b_ptr(cur);
    S.a_ready(cur);
    if constexpr (SP2) {
        PG8_STAGE(PG8_SB(0, 0), cB, voffB); PG8_STAGE(PG8_SB(0, 1), cB + hstep, voffB); PG8_STAGE(PG8_SA(0, 0), Abase, c0); PG8_STAGE(PG8_SA(0, 1), Abase, c1);
        if (wr == 1) PG8_BAR;
        PG8_WAIT_V(2); PG8_BAR;
        PG8_STAGE(PG8_SB(1, 0), cB + kstep, voffB); PG8_STAGE(PG8_SA(1, 0), Abase + kstep, c0); PG8_STAGE(PG8_SB(1, 1), cB + hstep + kstep, voffB);
        PG8_WAIT_V(6); PG8_BAR;
    } else {
        PG8_STAGE(PG8_SB(0, 0), cB, voffB); PG8_STAGE(PG8_SA(0, 0), Abase, c0); PG8_STAGE(PG8_SB(0, 1), cB + hstep, voffB); PG8_STAGE(PG8_SA(0, 1), Abase, c1);
        if (wr == 1) PG8_BAR;
        PG8_WAIT_V(4); PG8_BAR;
        PG8_STAGE(PG8_SB(1, 0), cB + kstep, voffB); PG8_STAGE(PG8_SA(1, 0), Abase + kstep, c0); PG8_STAGE(PG8_SB(1, 1), cB + hstep + kstep, voffB);
        PG8_WAIT_V(6); PG8_BAR;
    }
    for (;;) {
        const bool has_next = S.next(ui + 1, nxt);
        const char* nB = cB;
#pragma unroll
        for (int i = 0; i < 2; ++i) { n0[i] = c0[i]; n1[i] = c1[i]; }
        if (has_next) { nB = S.b_ptr(nxt);
#pragma unroll
            for (int i = 0; i < 2; ++i) { n0[i] = S.a_off(nxt, RA[i]) + cofA[i]; n1[i] = S.a_off(nxt, HALF + RA[i]) + cofA[i]; } }
        static_assert(SP2, "only the two-blocks-per-barrier-pair schedule is kept");
#define PG8_ITER(T_, Z_) do { const int t = (T_); const bool last = (t == nt - 2); \
            const char* a1 = Abase + (size_t)(t + 1) * kstep;                                            \
            const char* a2 = last ? Abase : Abase + (size_t)(t + 2) * kstep; const char* b2 = last ? nB : cB + (size_t)(t + 2) * kstep;     \
            const char* a3 = a2 + kstep; const char* b3 = b2 + kstep;                                    \
            unsigned x0[2], x1[2];                                                                       \
            _Pragma("unroll") for (int i = 0; i < 2; ++i) { x0[i] = last ? n0[i] : c0[i]; x1[i] = last ? n1[i] : c1[i]; } \
            if (last && has_next) S.a_ready(nxt); \
            PG8_LDB(B0, 0, 0); PG8_LDB(B1, 0, 1); PG8_SCHED; PG8_LDA(At, 0, 0); PG8_STAGE(PG8_SA(1, 1), a1, c1); \
            PG8_WAIT_V(8); PG8_WAIT_L(0); PG8_BAR; PG8_MMA(0, 0, At, B0, Z_); PG8_MMA(0, 1, At, B1, Z_); PG8_BAR; PG8_SCHED; \
            PG8_LDA(At, 0, 1); PG8_STAGE(PG8_SB(0, 0), b2, voffB); PG8_STAGE(PG8_SB(0, 1), b2 + hstep, voffB); PG8_STAGE(PG8_SA(0, 0), a2, x0); \
            PG8_WAIT_V(8); PG8_WAIT_L(0); PG8_BAR; PG8_MMA(1, 0, At, B0, Z_); PG8_MMA(1, 1, At, B1, Z_); PG8_BAR; PG8_SCHED; \
            PG8_LDB(B0, 1, 0); PG8_LDB(B1, 1, 1); PG8_SCHED; PG8_LDA(At, 1, 0); PG8_STAGE(PG8_SA(0, 1), a2, x1); \
            PG8_WAIT_V(8); PG8_WAIT_L(0); PG8_BAR; PG8_MMA(0, 0, At, B0, false); PG8_MMA(0, 1, At, B1, false); PG8_BAR; PG8_SCHED; \
            PG8_LDA(At, 1, 1); PG8_STAGE(PG8_SB(1, 0), b3, voffB); PG8_STAGE(PG8_SB(1, 1), b3 + hstep, voffB); PG8_STAGE(PG8_SA(1, 0), a3, x0); \
            PG8_WAIT_V(8); PG8_WAIT_L(0); PG8_BAR; PG8_MMA(1, 0, At, B0, false); PG8_MMA(1, 1, At, B1, false); PG8_BAR; PG8_SCHED; } while (0)
        PG8_ITER(0, true);
#pragma unroll 1
        for (int tt = 2; tt < nt; tt += 2) PG8_ITER(tt, false);
#undef PG8_ITER
        if constexpr (ALIGN_EPI) { if (wr == 0) PG8_BAR; }
        asm volatile("s_nop 15\n\ts_nop 15" ::: "memory");
        E(acc, cur, wr, wc, fr, fq); S.done(cur);
        if (!has_next) break;
        cur = nxt; cB = nB; ++ui;
#pragma unroll
        for (int i = 0; i < 2; ++i) { c0[i] = n0[i]; c1[i] = n1[i]; }
        if constexpr (ALIGN_EPI) { if (wr == 1) PG8_BAR; }
    }
    PG8_WAIT_V(0);
    if constexpr (!ALIGN_EPI) { if (wr == 0) PG8_BAR; }
    PG8_BAR;
#undef PG8_SA
#undef PG8_SB
#undef PG8_STAGE
#undef PG8_LDA
#undef PG8_LDB
#undef PG8_MMA
#undef PG8_MFMA_ASM
#undef PG8_LD16
#undef PG8_WAIT_V
#undef PG8_WAIT_L
#undef PG8_BAR
#undef PG8_SCHED
}
}
#include <hip/hip_bf16.h>
#include <cmath>
namespace attn_body {
using bf16=__hip_bfloat16;
using bf16x8=__attribute__((ext_vector_type(8)))short;
using s16x4=__attribute__((ext_vector_type(4)))short;
using f32x16=__attribute__((ext_vector_type(16)))float;
using u32x4=__attribute__((ext_vector_type(4)))unsigned;
using f32x4_t=__attribute__((ext_vector_type(4)))float;
constexpr int BATCH=4,NHEAD=16,SEQ=8192,D=64,DM=NHEAD*D;
constexpr int NW=8,QBLK=32,QB=QBLK*NW,KVBLK=64,NQB=SEQ/QB;
constexpr int ATTN_PITCH=DM, ATTN_UNIT_ROWS=QB;
__device__ __forceinline__ int crow(int r,int hi){return (r&3)+8*(r>>2)+4*hi;}
#define SBAR() __builtin_amdgcn_sched_barrier(0)
__device__ __forceinline__ void cmask(f32x16&p0,f32x16&p1,int jb,int qrel,int hi){
  const float NEG=-INFINITY; int kb=64*jb+4*hi;
  #pragma unroll
  for(int r=0;r<16;++r){int kv=kb+(r&3)+8*(r>>2); if(kv>qrel)p0[r]=NEG; if(kv+32>qrel)p1[r]=NEG;}
}

constexpr int NSLOT=3, SLOTB=8192;
constexpr int LDS_K=0, LDS_V=NSLOT*SLOTB, LDS_WS=2*NSLOT*SLOTB, LDS_OST=LDS_WS+NW*64*4, LDS_CB=LDS_OST+NW*4096, LDS_Q=LDS_CB+SEQ*4, LDS_OK=LDS_Q+16, LDS_BYTES=LDS_OK+48;
constexpr float C2=0.125f*1.4426950408889634f;
__device__ __forceinline__ void glds16(const void*gsrc,unsigned lds_dst){unsigned keep;
  asm volatile("s_mov_b32 %0, m0\n\ts_mov_b32 m0, %2\n\ts_nop 0\n\tglobal_load_lds_dwordx4 %1, off\n\ts_mov_b32 m0, %0":"=&s"(keep):"v"(gsrc),"s"(lds_dst):"memory");}
__device__ __forceinline__ float max3f(float a,float b,float c){float r;asm("v_max3_f32 %0, %1, %2, %3":"=v"(r):"v"(a),"v"(b),"v"(c));return r;}
__device__ __forceinline__ float max2f(float a,float b){float r;asm("v_max_f32_e32 %0, %1, %2":"=v"(r):"v"(a),"v"(b));return r;}
__device__ __forceinline__ float fadd_s(float a,float b){float r;asm("v_add_f32_e32 %0, %1, %2":"=v"(r):"v"(a),"v"(b));return r;}
__device__ __forceinline__ float fsub_s(float a,float b){float r;asm("v_sub_f32_e32 %0, %1, %2":"=v"(r):"v"(a),"v"(b));return r;}
typedef float f32x2_t __attribute__((ext_vector_type(2))); typedef __bf16 bf16x2_t __attribute__((ext_vector_type(2)));
__device__ __forceinline__ unsigned cvtpk_s(float lo,float hi){f32x2_t v={lo,hi};bf16x2_t b=__builtin_convertvector(v,bf16x2_t);return __builtin_bit_cast(unsigned,b);}
#define WAIT_BAR(N) asm volatile("s_waitcnt vmcnt(" #N ") lgkmcnt(0)\n\ts_barrier":::"memory")

__device__ __forceinline__ void qkt(f32x16&p0,f32x16&p1,const char*Kslot,const bf16x8*qr,int r32,int hi){
  const char*kb=Kslot+hi*1024+r32*16;
  #pragma unroll
  for(int d0=0;d0<4;++d0){
    const bf16x8 b0=*reinterpret_cast<const bf16x8*>(kb+d0*2048);
    const bf16x8 b1=*reinterpret_cast<const bf16x8*>(kb+d0*2048+512);
    p0=__builtin_amdgcn_mfma_f32_32x32x16_bf16(b0,qr[d0],p0,0,0,0);p1=__builtin_amdgcn_mfma_f32_32x32x16_bf16(b1,qr[d0],p1,0,0,0);}
}
typedef __attribute__((address_space(3))) const char* lds_cptr;
typedef short v4i16_t __attribute__((ext_vector_type(4)));
__device__ __forceinline__ void kload8(bf16x8*kf,lds_cptr kp){
  kf[0]=*(const __attribute__((address_space(3))) bf16x8*)(kp);      kf[1]=*(const __attribute__((address_space(3))) bf16x8*)(kp+512);
  kf[2]=*(const __attribute__((address_space(3))) bf16x8*)(kp+2048); kf[3]=*(const __attribute__((address_space(3))) bf16x8*)(kp+2560);
  kf[4]=*(const __attribute__((address_space(3))) bf16x8*)(kp+4096); kf[5]=*(const __attribute__((address_space(3))) bf16x8*)(kp+4608);
  kf[6]=*(const __attribute__((address_space(3))) bf16x8*)(kp+6144); kf[7]=*(const __attribute__((address_space(3))) bf16x8*)(kp+6656);
}
__device__ __forceinline__ void kload2(bf16x8*kf,lds_cptr kp,int j){ kf[2*j]=*(const __attribute__((address_space(3))) bf16x8*)(kp+j*2048); kf[2*j+1]=*(const __attribute__((address_space(3))) bf16x8*)(kp+j*2048+512); }
__device__ __forceinline__ s16x4 vtr(lds_cptr p){ return __builtin_bit_cast(s16x4,__builtin_amdgcn_ds_read_tr16_b64_v4i16((__attribute__((address_space(3))) v4i16_t*)p)); }
__device__ __forceinline__ float rowmax(const f32x16&p0,const f32x16&p1){
  float a=max3f(p0[0],p0[1],p1[0]),b=max3f(p0[2],p0[3],p1[1]);a=max3f(a,p1[2],p1[3]);
  #pragma unroll
  for(int r=4;r<16;r+=4){a=max3f(a,p0[r],p0[r+1]);b=max3f(b,p0[r+2],p0[r+3]);a=max3f(a,p1[r],p1[r+1]);b=max3f(b,p1[r+2],p1[r+3]);}
  const float m=max2f(a,b);
  auto rr=__builtin_amdgcn_permlane32_swap(__float_as_uint(m),__float_as_uint(m),false,false);
  return max2f(__uint_as_float(rr[0]),__uint_as_float(rr[1]));
}
__device__ __forceinline__ void pv(f32x16*o,int vb,bf16x8 pa0,bf16x8 pa1,bf16x8 pa2,bf16x8 pa3){
  #pragma unroll
  for(int d0=0;d0<2;++d0){s16x4 lo[4],hi[4];
    #pragma unroll
    for(int ks=0;ks<4;++ks){
      asm volatile("ds_read_b64_tr_b16 %0,%1 offset:%c2":"=&v"(lo[ks]):"v"(vb),"i"(d0*4096+ks*1024):"memory");
      asm volatile("ds_read_b64_tr_b16 %0,%1 offset:%c2":"=&v"(hi[ks]):"v"(vb),"i"(d0*4096+ks*1024+512):"memory");}
    asm volatile("s_waitcnt lgkmcnt(0)":::"memory");SBAR();
    #define PK(k) (bf16x8){lo[k][0],lo[k][1],lo[k][2],lo[k][3],hi[k][0],hi[k][1],hi[k][2],hi[k][3]}
    o[d0]=__builtin_amdgcn_mfma_f32_32x32x16_bf16(pa0,PK(0),o[d0],0,0,0);
    o[d0]=__builtin_amdgcn_mfma_f32_32x32x16_bf16(pa1,PK(1),o[d0],0,0,0);
    o[d0]=__builtin_amdgcn_mfma_f32_32x32x16_bf16(pa2,PK(2),o[d0],0,0,0);
    o[d0]=__builtin_amdgcn_mfma_f32_32x32x16_bf16(pa3,PK(3),o[d0],0,0,0);
    #undef PK
  }
}

#ifndef ATTN_STORE16
#define ATTN_STORE16(p,v) (*(u32x4*)(p)=(v))
#endif
constexpr float GUARD_B=96.f;
constexpr float SKIP_TH=200.f, SKIP_MARGIN=42.f, SKIP_G=10.f, SKIP_LMIN=0.0009765625f  ;
template<int THRL> __device__ __forceinline__ bool attn_unit(int b,int h,int qb,int t0s,bool guard,f32x4_t cbv0,f32x4_t cbv1,f32x4_t cbv2,f32x4_t cbv3,unsigned*tctr,bool redo,unsigned&nraw,const bf16*Q,const bf16*__restrict__ K,const bf16*__restrict__ V,bf16*O,const float*Cb,char*shm){
  int tid_=threadIdx.x; asm volatile("":"+v"(tid_));
  const int tid=tid_,lane=tid&63,r32=lane&31,hi=lane>>5; const int wid=__builtin_amdgcn_readfirstlane(tid>>6);
  const long rowbase=(long)b*SEQ; const int q0=qb*QB;
  const bf16*Qw=Q+(rowbase+q0+wid*QBLK)*DM+h*D;
  const bf16*Kh=K+(rowbase+(long)t0s*KVBLK)*DM+h*D,*Vh=V+(rowbase+(long)t0s*KVBLK)*DM+h*D;
  const unsigned lds0=(unsigned)(uintptr_t)shm;
  float*wsf=(float*)(shm+LDS_WS)+wid*64;
  const bf16*ksrc=Kh+(long)lane*DM+wid*8;
  const bf16*vsrc=Vh+(long)(16*(wid&3)+(lane>>2))*DM+(wid>>2)*32+(lane&3)*8;
  const unsigned kdst=lds0+LDS_K+wid*1024, vdst=lds0+LDS_V+wid*1024;
  #define DMA_K(t,slot) glds16(ksrc+(long)(t)*KVBLK*DM,(unsigned)__builtin_amdgcn_readfirstlane(kdst+(slot)))
  #define DMA_V(t,slot) glds16(vsrc+(long)(t)*KVBLK*DM,(unsigned)__builtin_amdgcn_readfirstlane(vdst+(slot)))
  const int vb0=(int)(lds0+LDS_V)+((lane>>4)&1)*32+(lane&3)*8+(4*hi+((lane&15)>>2))*64;
  const char*Kbase=shm+LDS_K; bf16x8 kf[8];
  const lds_cptr shm3=(lds_cptr)shm; const lds_cptr kp0=shm3+LDS_K+hi*1024+r32*16; const lds_cptr vp0=shm3+LDS_V+((lane>>4)&1)*32+(lane&3)*8+(4*hi+((lane&15)>>2))*64;
  const int NT=(q0+QB)/KVBLK-t0s;
  typedef __attribute__((address_space(3))) f32x4_t* lds_f4ptr; typedef __attribute__((address_space(3))) const f32x4_t* lds_cf4ptr;
  { const int n4=(q0+QB)/4; lds_f4ptr cl=(lds_f4ptr)((lds_cptr)shm+LDS_CB);
    if(tid<n4)cl[tid]=cbv0; if(tid+512<n4)cl[tid+512]=cbv1; if(tid+1024<n4)cl[tid+1024]=cbv2; if(tid+1536<n4)cl[tid+1536]=cbv3; }
  const lds_cf4ptr cbp=(lds_cf4ptr)((lds_cptr)shm+LDS_CB)+hi+16*t0s;
  #define CI4(PX,t_,g_,o_,nm_) do{ const f32x4_t z_=cbp[16*(t_)+(o_)+2*(g_)]; PX[4*(g_)]=(nm_)-z_.x; PX[4*(g_)+1]=(nm_)-z_.y; PX[4*(g_)+2]=(nm_)-z_.z; PX[4*(g_)+3]=(nm_)-z_.w; }while(0)
  #define CI16(PX,t_,o_,nm_) do{ CI4(PX,t_,0,o_,nm_); CI4(PX,t_,1,o_,nm_); CI4(PX,t_,2,o_,nm_); CI4(PX,t_,3,o_,nm_); }while(0)
  DMA_K(0,0);DMA_V(0,0);DMA_K(1,SLOTB);
  bf16x8 qr[4];
  #pragma unroll
  for(int d0=0;d0<4;++d0)qr[d0]=*reinterpret_cast<const bf16x8*>(&Qw[(long)r32*DM+d0*16+hi*8]);
  float mhat=0.f,l_reg=0.f;f32x16 o[2];o[0]=f32x16{};o[1]=f32x16{};
  const int qrel=wid*QBLK+r32;
  #define CMASK(P0,P1,t) do{int jb_=(t)-(NT-4); if(jb_>=0)cmask(P0,P1,jb_,qrel,hi);}while(0)
  bool resc=false;
  #define START(P0,P1) do{ const float rm=rowmax(P0,P1); resc=false; \
    if(__builtin_expect(__any(rm>(float)THRL),0)){ const float dl=__builtin_fmaxf(rm,0.f); mhat=fadd_s(mhat,dl); \
      _Pragma("unroll") for(int r=0;r<16;++r){P0[r]=fsub_s(P0[r],dl);P1[r]=fsub_s(P1[r],dl);} } \
    _Pragma("unroll") for(int r=0;r<16;++r)P0[r]=__builtin_amdgcn_exp2f(P0[r]); }while(0)
  #define RESC() do{ if(resc){ asm volatile("s_waitcnt lgkmcnt(0)":::"memory"); \
      _Pragma("unroll") for(int d_=0;d_<2;++d_) _Pragma("unroll") for(int r=0;r<16;++r)o[d_][r]*=wsf[crow(r,hi)]; } }while(0)
  f32x16 pA0,pA1,pB0,pB1;
  int sl_prev=0,sl_cur=0,sl_next=SLOTB;
  #define ROT() do{sl_prev=sl_cur;sl_cur=sl_next;sl_next=(sl_next==(NSLOT-1)*SLOTB)?0:sl_next+SLOTB;}while(0)
  DMA_K(2,2*SLOTB);
  if(!redo&&tid==0)nraw=__hip_atomic_fetch_add(tctr,1u,__ATOMIC_RELAXED,__HIP_MEMORY_SCOPE_AGENT);
  WAIT_BAR(3);
  const float qb2=*((const __attribute__((address_space(3))) float*)((lds_cptr)shm+LDS_CB)+q0+qrel);
  CI16(pA0,0,0,qb2); CI16(pA1,0,8,qb2);
  qkt(pA0,pA1,Kbase,qr,r32,hi);asm volatile("s_nop 15\n\ts_nop 7":"+v"(pA0),"+v"(pA1));CMASK(pA0,pA1,0);
  START(pA0,pA1);
  _Pragma("unroll") for(int r=0;r<16;++r)pA1[r]=__builtin_amdgcn_exp2f(pA1[r]);
  WAIT_BAR(0);
  DMA_K(3,0);DMA_V(1,SLOTB);
  ROT();
  kload8(kf,kp0+sl_cur);
  WAIT_BAR(2);
  s16x4 vlo[8],vhi[8]; u32x4 pw0,pw1,pw2,pw3;
  #define PKW(P,B) cvtpk_s(P[B],P[B+1])
  #define PAF(k) __builtin_bit_cast(bf16x8,pw##k)
  #define VFR(i) (bf16x8){vlo[i][0],vlo[i][1],vlo[i][2],vlo[i][3],vhi[i][0],vhi[i][1],vhi[i][2],vhi[i][3]}
  #define PIN(x) asm volatile("":"+v"(x))
  #define MX3(a,b,c) __builtin_fmaxf(__builtin_fmaxf((a),(b)),(c))
  #define GAPA(MF,A0,A1,A2,A3,W0,W1,PW) do{ MF; sacc+=A0; sacc+=A1; sacc+=A2; sacc+=A3; PIN(sacc); W0; W1; PIN(PW); SBAR(); }while(0)
  #define EX(v) __builtin_amdgcn_exp2f(v)
  #define GAPB(MF,X,B,GI,PX,tn_,g_,o_) do{ MF; X[B]=EX(X[B]); X[B+1]=EX(X[B+1]); X[B+2]=EX(X[B+2]); X[B+3]=EX(X[B+3]); PIN(X); SBAR(); }while(0)
  #define VRD(i) do{ vlo[i]=vtr(vp_+(((i)>>2)*4096+((i)&3)*1024)); vhi[i]=vtr(vp_+(((i)>>2)*4096+((i)&3)*1024+512)); }while(0)
  #define KRD(G,j) do{ if(G){ kload2(kf,kp0+sl_next,j); SBAR(); } }while(0)
  #define STEP(C0,C1,P0,P1,t,GK,GV,GL,GI) do{ SBAR(); const float nm1_=qb2-mhat; CI16(C0,t,0,nm1_); SBAR(); \
    const lds_cptr vp_=vp0+sl_prev; \
    VRD(0); SBAR(); float sacc=(P0[0]+P0[1]); \
    GAPA(C0=__builtin_amdgcn_mfma_f32_32x32x16_bf16(kf[0],qr[0],C0,0,0,0), P0[2],P0[3],P0[4],P0[5],     pw0[0]=PKW(P0,0), pw0[1]=PKW(P0,2), pw0); \
    CI16(C1,t,8,nm1_); PIN(C1); SBAR(); \
    VRD(4); SBAR(); GAPA(C1=__builtin_amdgcn_mfma_f32_32x32x16_bf16(kf[1],qr[0],C1,0,0,0), P0[6],P0[7],P0[8],P0[9],     pw0[2]=PKW(P0,4), pw0[3]=PKW(P0,6), pw0); \
    VRD(1); SBAR(); GAPA(C0=__builtin_amdgcn_mfma_f32_32x32x16_bf16(kf[2],qr[1],C0,0,0,0),   P0[10],P0[11],P0[12],P0[13], pw1[0]=PKW(P0,8), pw1[1]=PKW(P0,10), pw1); \
    VRD(5); SBAR(); GAPA(C1=__builtin_amdgcn_mfma_f32_32x32x16_bf16(kf[3],qr[1],C1,0,0,0),   P0[14],P0[15],P1[0],P1[1],   pw1[2]=PKW(P0,12),pw1[3]=PKW(P0,14), pw1); \
    VRD(2); SBAR(); GAPA(C0=__builtin_amdgcn_mfma_f32_32x32x16_bf16(kf[4],qr[2],C0,0,0,0),   P1[2],P1[3],P1[4],P1[5],     pw2[0]=PKW(P1,0), pw2[1]=PKW(P1,2), pw2); \
    VRD(6); SBAR(); GAPA(C1=__builtin_amdgcn_mfma_f32_32x32x16_bf16(kf[5],qr[2],C1,0,0,0),   P1[6],P1[7],P1[8],P1[9],     pw2[2]=PKW(P1,4), pw2[3]=PKW(P1,6), pw2); \
    VRD(3); SBAR(); GAPA(C0=__builtin_amdgcn_mfma_f32_32x32x16_bf16(kf[6],qr[3],C0,0,0,0),   P1[10],P1[11],P1[12],P1[13], pw3[0]=PKW(P1,8), pw3[1]=PKW(P1,10), pw3); \
    VRD(7); SBAR(); GAPA(C1=__builtin_amdgcn_mfma_f32_32x32x16_bf16(kf[7],qr[3],C1,0,0,0),   P1[14],P1[15],0.f,0.f,       pw3[2]=PKW(P1,12),pw3[3]=PKW(P1,14), pw3); \
    l_reg+=sacc; \
    if(GK){DMA_K((t)+3,sl_cur);} if(GV){DMA_V((t)+1,sl_next);} \
    CMASK(C0,C1,t); \
    resc=false; \
    if(guard){ float a=MX3(C0[0],C0[1],C1[0]),b=MX3(C0[2],C0[3],C1[1]); a=MX3(a,C1[2],C1[3]); \
      _Pragma("unroll") for(int r=4;r<16;r+=4){a=MX3(a,C0[r],C0[r+1]);b=MX3(b,C0[r+2],C0[r+3]);a=MX3(a,C1[r],C1[r+1]);b=MX3(b,C1[r+2],C1[r+3]);} \
      float rm=__builtin_fmaxf(a,b); { auto rr=__builtin_amdgcn_permlane32_swap(__float_as_uint(rm),__float_as_uint(rm),false,false); rm=__builtin_fmaxf(__uint_as_float(rr[0]),__uint_as_float(rr[1])); } \
      if(__builtin_expect(__any(rm>(float)THRL),0)){ const float dl=__builtin_fmaxf(rm,0.f); mhat+=dl; \
        _Pragma("unroll") for(int r=0;r<16;++r){C0[r]-=dl;C1[r]-=dl;} \
        const float f=__builtin_amdgcn_exp2f(-dl); l_reg*=f; if(hi==0)wsf[r32]=f; resc=true; } } \
    SBAR(); \
    GAPB(o[0]=__builtin_amdgcn_mfma_f32_32x32x16_bf16(PAF(0),VFR(0),o[0],0,0,0), C0,0,  GI,P0,(t)+1,0,0); \
    GAPB(o[1]=__builtin_amdgcn_mfma_f32_32x32x16_bf16(PAF(0),VFR(4),o[1],0,0,0), C0,4,  GI,P0,(t)+1,1,0); \
    KRD(GL,0); GAPB(o[0]=__builtin_amdgcn_mfma_f32_32x32x16_bf16(PAF(1),VFR(1),o[0],0,0,0), C0,8,  GI,P0,(t)+1,2,0); \
    KRD(GL,1); GAPB(o[1]=__builtin_amdgcn_mfma_f32_32x32x16_bf16(PAF(1),VFR(5),o[1],0,0,0), C0,12, GI,P0,(t)+1,3,0); \
    KRD(GL,2); GAPB(o[0]=__builtin_amdgcn_mfma_f32_32x32x16_bf16(PAF(2),VFR(2),o[0],0,0,0), C1,0,  GI,P1,(t)+1,0,8); \
    KRD(GL,3); GAPB(o[1]=__builtin_amdgcn_mfma_f32_32x32x16_bf16(PAF(2),VFR(6),o[1],0,0,0), C1,4,  GI,P1,(t)+1,1,8); \
    GAPB(o[0]=__builtin_amdgcn_mfma_f32_32x32x16_bf16(PAF(3),VFR(3),o[0],0,0,0), C1,8,  GI,P1,(t)+1,2,8); \
    GAPB(o[1]=__builtin_amdgcn_mfma_f32_32x32x16_bf16(PAF(3),VFR(7),o[1],0,0,0), C1,12, GI,P1,(t)+1,3,8); \
    }while(0)
  int t=1;
  #undef CMASK
  #define CMASK(P0,P1,t) do{}while(0)
  for(;t+5<NT;t+=2){
    STEP(pB0,pB1,pA0,pA1,t,true,true,true,true);     WAIT_BAR(2); RESC(); ROT();
    STEP(pA0,pA1,pB0,pB1,t+1,true,true,true,true);   WAIT_BAR(2); RESC(); ROT();
  }
  #undef CMASK
  #define CMASK(P0,P1,t) do{int jb_=(t)-(NT-4); if(jb_>=0)cmask(P0,P1,jb_,qrel,hi);}while(0)
  #define ENDW(tt) do{ if((tt)+3<NT){WAIT_BAR(2);} else if((tt)+2<NT){WAIT_BAR(1);} else {WAIT_BAR(0);} }while(0)
  for(;t+1<NT;t+=2){
    STEP(pB0,pB1,pA0,pA1,t,(t+3<NT),(t+1<NT),(t+1<NT),true);       ENDW(t);   RESC(); ROT();
    STEP(pA0,pA1,pB0,pB1,t+1,(t+4<NT),(t+2<NT),(t+2<NT),true);     ENDW(t+1); RESC(); ROT();
  }
  STEP(pB0,pB1,pA0,pA1,NT-1,false,false,false,false); RESC();
  { float sacc=pB0[0]+pB0[1]; _Pragma("unroll") for(int r=2;r<16;++r)sacc+=pB0[r]; _Pragma("unroll") for(int r=0;r<16;++r)sacc+=pB1[r]; l_reg+=sacc;
    pw0=(u32x4){PKW(pB0,0),PKW(pB0,2),PKW(pB0,4),PKW(pB0,6)};pw1=(u32x4){PKW(pB0,8),PKW(pB0,10),PKW(pB0,12),PKW(pB0,14)};pw2=(u32x4){PKW(pB1,0),PKW(pB1,2),PKW(pB1,4),PKW(pB1,6)};pw3=(u32x4){PKW(pB1,8),PKW(pB1,10),PKW(pB1,12),PKW(pB1,14)};
    SBAR(); pv(o,vb0+sl_cur,PAF(0),PAF(1),PAF(2),PAF(3)); }
  #undef PKW
  #undef PAF
  #undef VFR
  #undef PIN
  #undef MX3
  #undef GAPA
  #undef GAPB
  #undef EX
  #undef VRD
  #undef KRD
  #undef STEP
  #undef ENDW
  {auto rr=__builtin_amdgcn_permlane32_swap(__float_as_uint(l_reg),__float_as_uint(l_reg),false,false);l_reg=__uint_as_float(rr[0])+__uint_as_float(rr[1]);}
  { const bool okw_=__all(l_reg>=SKIP_LMIN); if(lane==0)*((volatile __attribute__((address_space(3))) unsigned*)((lds_cptr)shm+LDS_OK)+wid)=okw_?1u:0u; }
  if(hi==0)wsf[32+r32]=l_reg;asm volatile("s_waitcnt lgkmcnt(0)":::"memory");
  float rli[16];
  #pragma unroll
  for(int r=0;r<16;++r)rli[r]=__builtin_amdgcn_rcpf(wsf[32+crow(r,hi)]);
  bf16*Ow=O+(rowbase+q0+wid*QBLK)*DM+h*D;
  { bf16*stg=(bf16*)(shm+LDS_OST)+wid*2048;
    #pragma unroll
    for(int r=0;r<16;++r){const int orow=crow(r,hi);
      #pragma unroll
      for(int d0=0;d0<2;++d0)stg[orow*64+d0*32+r32]=__float2bfloat16(o[d0][r]*rli[r]);}
    asm volatile("s_waitcnt lgkmcnt(0)":::"memory");
    #pragma unroll
    for(int i=0;i<4;++i){const int row=i*8+(lane>>3),ch=lane&7; const u32x4 v=*(const u32x4*)(stg+row*64+ch*8); ATTN_STORE16(Ow+(long)row*DM+ch*8,v);} }
  asm volatile("s_waitcnt lgkmcnt(0)\n\ts_barrier":::"memory");
  { const volatile __attribute__((address_space(3))) unsigned*okp_=(const volatile __attribute__((address_space(3))) unsigned*)((lds_cptr)shm+LDS_OK);
    return (okp_[0]&okp_[1]&okp_[2]&okp_[3]&okp_[4]&okp_[5]&okp_[6]&okp_[7])!=0u; }
  #undef CI4
  #undef CI16
  #undef DMA_K
  #undef DMA_V
  #undef CMASK
  #undef START
  #undef RESC
  #undef ROT
}
constexpr int ATTN_LDS_BYTES=LDS_BYTES;
struct AttnTensors { const bf16* Q; const bf16* K; const bf16* V; bf16* O; const float* Cb; };
__device__ __forceinline__ unsigned aq_grab_from(unsigned*ctr,unsigned q0_){
  for(unsigned qq=0;qq<8;++qq){ const unsigned q=(q0_+qq)&7u; const unsigned r=__hip_atomic_fetch_add(ctr+64*q,1u,__ATOMIC_RELAXED,__HIP_MEMORY_SCOPE_AGENT); if(r<256u)return (q<<16)|r; }
  return 0xffffffffu; }
template<int THRL=8> __device__ __forceinline__ void attn_phase(char*lds,const AttnTensors&T,unsigned*ctr,unsigned xcc,const unsigned*nrm){
  const int tid=threadIdx.x,lane_=tid&63;
  volatile __attribute__((address_space(3))) unsigned*qw=(volatile __attribute__((address_space(3))) unsigned*)((lds_cptr)lds+LDS_Q);
  if(tid==0)qw[0]=aq_grab_from(ctr,xcc&7u);
  asm volatile("s_waitcnt lgkmcnt(0)\n\ts_barrier":::"memory");
  bool redo=false; unsigned nraw=0u;
  for(;;){
    const unsigned pk=qw[0]; if(pk==0xffffffffu)break;
    const unsigned q=pk>>16,idx=pk&0xffffu; const int bh=(int)(q+8u*(idx&7u)),qb=31-(int)(idx>>3);
    int t0s=0,t0a=0;
    int lane=lane_; asm volatile("":"+v"(lane));
    const float*cg=T.Cb+(size_t)bh*SEQ; const int ntabs=4*qb+4;
    const unsigned nw=__hip_atomic_load(nrm+(((lane>>1)&1)*64+bh)*2+(lane&1),__ATOMIC_RELAXED,__HIP_MEMORY_SCOPE_AGENT);
    float e0=0.f,e1=0.f; if(qb>0){ e0=cg[64*lane+63]; e1=(lane+64<ntabs)?cg[64*(lane+64)+63]:0.f; }
    f32x4_t cb0=f32x4_t{},cb1=f32x4_t{},cb2=f32x4_t{},cb3=f32x4_t{};
    { int tt=tid; asm volatile("":"+v"(tt)); const f32x4_t*cg4=(const f32x4_t*)cg; const int n4=ntabs*16;
      if(tt<n4)cb0=cg4[tt]; if(tt+512<n4)cb1=cg4[tt+512]; if(tt+1024<n4)cb2=cg4[tt+1024]; if(tt+1536<n4)cb3=cg4[tt+1536]; }
    const float nv=__uint_as_float(nw); const float q2=__shfl(nv,0)+__shfl(nv,1), k2=__shfl(nv,2)+__shfl(nv,3);
    const float bnd=1.02f*sqrtf(q2*k2);
    const bool guard=__builtin_amdgcn_readfirstlane((bnd<GUARD_B)?0:1)!=0;
    if(qb>0){
      const float th=fminf(SKIP_TH,SKIP_MARGIN+2.f*bnd), tha=fminf(th,SKIP_MARGIN+bnd+SKIP_G);
      const int tq=4*qb-1; const float ref=__shfl((tq<64)?e0:e1,tq&63);
      const unsigned long long m0=__ballot((lane<ntabs)&&((e0-ref)>th)), m1=__ballot((lane+64<ntabs)&&((e1-ref)>th));
      const int nskip=__popcll(m0)+__popcll(m1); t0s=nskip&~1; if(t0s>ntabs-4)t0s=ntabs-4; t0s=__builtin_amdgcn_readfirstlane(t0s);
      const unsigned long long a0=__ballot((lane<ntabs)&&((e0-ref)>tha)), a1=__ballot((lane+64<ntabs)&&((e1-ref)>tha));
      const int nska=__popcll(a0)+__popcll(a1); t0a=nska&~1; if(t0a>ntabs-4)t0a=ntabs-4; t0a=__builtin_amdgcn_readfirstlane(t0a); }
    const int t0u=redo?t0s:t0a;
    const bool ok=attn_unit<THRL>(bh/NHEAD,bh%NHEAD,qb,t0u,guard,cb0,cb1,cb2,cb3,ctr+64*q,redo,nraw,T.Q,T.K,T.V,T.O,T.Cb,lds);
    if(!ok&&t0u!=t0s){ redo=true; continue; }
    redo=false;
    if(tid==0)qw[0]=(nraw<256u)?((q<<16)|nraw):aq_grab_from(ctr,(q+1u)&7u);
    asm volatile("s_waitcnt lgkmcnt(0)\n\ts_barrier":::"memory");
  }
}
#undef SBAR
#undef WAIT_BAR
}
#define ATTN_PHASE_BODY { static_assert(attn_body::ATTN_LDS_BYTES <= RING_BYTES && attn_body::ATTN_PITCH == D, "attention body geometry vs frame"); \
    const attn_body::AttnTensors AT{(const attn_body::bf16*)QO, (const attn_body::bf16*)KB, (const attn_body::bf16*)VB, (attn_body::bf16*)OB, (const float*)(F.ws + WS_C2)}; \
    attn_body::attn_phase<8>((char*)lds + RING_OFF, AT, (unsigned*)(F.ctl + CW_AQ), xb_xcc_id(), (const unsigned*)(F.ctl + CW_NRM)); }
constexpr int NWAVES = 8;
#ifndef MK_PER_PHASE
#define MK_PER_PHASE 0
#endif
constexpr int N_PHASES = 15;

constexpr int BATCH = 4, SEQ = 8192, D = 1024, H = 16, HD = 64, FF = 2816, NE = 8;
constexpr int M = BATCH * SEQ;
constexpr int NQKV = 3 * D, NIN = 3 * D + H;
constexpr int NCH = M / 128;
constexpr int TMAX = 2 * M / 256 + NE;
constexpr int HROWS = TMAX * 256;
constexpr float RMS_EPS = 1e-6f;
constexpr float QSCALE = 0.125f * 1.4426950408889634f;
constexpr float LOG2E = 1.4426950408889634f;

constexpr size_t MiB = 1u << 20;
constexpr size_t WS_CTL = 0, CTL_ZERO_BYTES = 1 * MiB;
constexpr size_t WS_CTOT = 1 * MiB;
constexpr size_t WS_WQKV = 2 * MiB, WS_WO = 8 * MiB, WS_WGU = 10 * MiB, WS_WD = 21 * MiB, WS_WCIN = 27 * MiB, WS_WCO = 33 * MiB;
constexpr size_t WS_MGU8 = 35 * MiB, WS_MD8 = 79 * MiB;
constexpr size_t WS_XN8 = 2 * MiB;
constexpr size_t WS_HB = 101 * MiB;
constexpr size_t WS_ZP = 165 * MiB, WS_BGB = 166 * MiB;
constexpr size_t WS_C2 = 167 * MiB;
constexpr size_t WS_LIST = 169 * MiB;
constexpr size_t WS_INV = 170 * MiB, WS_GATE = 170 * MiB + 512 * 1024;
constexpr size_t WS_SS = 173 * MiB;
constexpr size_t WS_XN = 176 * MiB;
constexpr size_t WS_QO = 240 * MiB, WS_K = 304 * MiB, WS_V = 368 * MiB;
constexpr size_t WS_HID = 240 * MiB;
constexpr size_t WS_HID8 = 176 * MiB, WS_Y = 358 * MiB;
constexpr size_t WS_O = 432 * MiB;
constexpr size_t WS_END = 496 * MiB;
static_assert(WS_WD + (size_t)D * FF * 2 <= WS_WCIN && WS_MGU8 + (size_t)NE * 2 * FF * D <= WS_MD8 && WS_MD8 + (size_t)NE * D * FF <= WS_HB && WS_HB + (size_t)M * D * 2 <= WS_ZP && WS_ZP + (size_t)(M / 256) * 2 * D * 4 <= WS_BGB && WS_BGB + (size_t)(M / 256) * 2 * D * 4 <= WS_C2 && WS_XN8 + (size_t)M * D <= WS_MGU8 && WS_LIST + (size_t)NE * M * 4 <= WS_INV && WS_GATE + (size_t)M * 8 <= WS_SS && WS_SS + (size_t)M * 16 * 4 <= WS_XN, "d_ws map (weights)");
static_assert(WS_HID + (size_t)M * FF * 2 <= WS_O && WS_HID8 + (size_t)HROWS * FF <= WS_Y && WS_Y + (size_t)HROWS * D * 2 <= WS_END && WS_V + (size_t)M * D * 2 <= WS_O && WS_O + (size_t)M * D * 2 <= WS_END && WS_V - WS_K == WS_K - WS_QO, "d_ws map (activations)");
constexpr int CW_TMO = 0, CW_CODE = 1;
constexpr int CW_BAR = 4096;
constexpr int CW_AQ = 12288;
constexpr int CW_NRM = 2048;
constexpr int CW_MOE = 8192;
constexpr int RING_OFF = 0, RING_BYTES = 131072;
constexpr int RSTAB_OFF = RING_BYTES + 1024;
constexpr int GTOK_OFF = RING_BYTES + 2048, GTOK_UNITS = 24;
constexpr int LDSCTL_OFF = RING_BYTES, MISC_OFF = LDSCTL_OFF + 320;
constexpr int LDS_BYTES = 147456;
static_assert(MISC_OFF + 128 <= RSTAB_OFF && GTOK_OFF + GTOK_UNITS * 512 <= LDS_BYTES && M <= 65536, "LDS map");

#define GAS __attribute__((address_space(1)))
#define LAS __attribute__((address_space(3)))
typedef unsigned short bf16;
typedef unsigned v4u __attribute__((ext_vector_type(4)));
typedef float f32x4 __attribute__((ext_vector_type(4)));
typedef short bf16x8 __attribute__((ext_vector_type(8)));
typedef GAS unsigned gu32;
typedef GAS unsigned long long gu64;
#define RLX_AGENT __ATOMIC_RELAXED, __HIP_MEMORY_SCOPE_AGENT
#define LDS_WAIT() asm volatile("s_waitcnt lgkmcnt(0)" ::: "memory")
#define VM_WAIT() asm volatile("s_waitcnt vmcnt(0)" ::: "memory")
__device__ __forceinline__ unsigned f2bf(float f) { unsigned u = __builtin_bit_cast(unsigned, f); return (u + 0x7fffu + ((u >> 16) & 1u)) >> 16; }
__device__ __forceinline__ unsigned pk2(float lo, float hi) { return f2bf(lo) | (f2bf(hi) << 16); }
__device__ __forceinline__ float bf_lo(unsigned w) { return __uint_as_float(w << 16); }
__device__ __forceinline__ float bf_hi(unsigned w) { return __uint_as_float(w & 0xffff0000u); }

#define XB_TMO      128
#define XB_XCNT(j)  (256  + 64 * (j))
#define XB_XSUB(j)  (1280 + 64 * (j))
#define XB_XGEN(j)  (2304 + 64 * (j))
#define XB_TOP      3328
#define XB_TOPGEN   3392
#define XCD_BAR_WORDS 3456
#define XB_SPIN_CAP (1u << 18)

__device__ __forceinline__ unsigned xb_ld(unsigned* p)              { return __hip_atomic_load(p, __ATOMIC_RELAXED, __HIP_MEMORY_SCOPE_AGENT); }
__device__ __forceinline__ unsigned xb_add(unsigned* p, unsigned v) { return __hip_atomic_fetch_add(p, v, __ATOMIC_RELAXED, __HIP_MEMORY_SCOPE_AGENT); }
__device__ __forceinline__ unsigned xb_xcc_id() { return (unsigned)__builtin_amdgcn_s_getreg((3 << 11) | 20) & 0xFu; }
#define XB_SPIN(cond, bar) do { unsigned _sp = 0; while (cond) { __builtin_amdgcn_s_sleep(1); \
    if ((++_sp & 255u) == 0u) { if (xb_ld(&(bar)[XB_TMO])) break; if (_sp > XB_SPIN_CAP) { atomicAdd(&(bar)[XB_TMO], 1u); break; } } } } while (0)

struct XcdBarrier {
    unsigned* bar; unsigned x;
    volatile LAS unsigned* st;
};

__device__ __forceinline__ XcdBarrier xcd_barrier_post(unsigned* bar, volatile LAS unsigned* st) {
    XcdBarrier b; b.bar = bar; b.x = xb_xcc_id(); b.st = st;
    if (threadIdx.x == 0) (void)xb_add(&bar[XB_XCNT(b.x)], 1u);
    return b;
}
__device__ __forceinline__ void xcd_barrier_complete(unsigned* bar, unsigned x, unsigned& nloc, unsigned& nx) {
    const unsigned G = gridDim.x * gridDim.y * gridDim.z;
    unsigned sum, cnt, mine, sp = 0u;
    for (;;) {
        sum = 0u; cnt = 0u; mine = 0u;
#pragma unroll
        for (unsigned j = 0; j < 16; ++j) { const unsigned c = xb_ld(&bar[XB_XCNT(j)]); sum += c; cnt += (c > 0u) ? 1u : 0u; mine = (j == x) ? c : mine; }
        if (sum == G) break;
        __builtin_amdgcn_s_sleep(1);
        if ((++sp & 255u) == 0u) { if (xb_ld(&bar[XB_TMO])) break; if (sp > XB_SPIN_CAP) { atomicAdd(&bar[XB_TMO], 1u); break; } }
    }
    nloc = mine > 0u ? mine : 1u; nx = cnt > 0u ? cnt : 1u;
}

__device__ __forceinline__ void xcd_barrier(const XcdBarrier& b) {
    asm volatile("s_waitcnt vmcnt(0)" ::: "memory");
    __syncthreads();
    if (threadIdx.x == 0) {
        unsigned* bar = b.bar;
        __builtin_amdgcn_s_waitcnt(0);
        unsigned nloc = b.st[0], nx = b.st[1];
        if (nloc == 0u) { xcd_barrier_complete(bar, b.x, nloc, nx); b.st[0] = nloc; b.st[1] = nx; }
        const unsigned old = xb_add(&bar[XB_XSUB(b.x)], 1u);
        const unsigned gen = old / nloc;
        if (old + 1u == (gen + 1u) * nloc) {
            __builtin_amdgcn_fence(__ATOMIC_RELEASE, "agent");
            asm volatile("s_waitcnt vmcnt(0)" ::: "memory");
            const unsigned og = xb_add(&bar[XB_TOP], 1u);
            const unsigned tg = og / nx;
            if (og + 1u == (tg + 1u) * nx) xb_add(&bar[XB_TOPGEN], 1u);
            else XB_SPIN(xb_ld(&bar[XB_TOPGEN]) == tg, bar);
            __builtin_amdgcn_fence(__ATOMIC_ACQUIRE, "agent");
            xb_add(&bar[XB_XGEN(b.x)], 1u);
            asm volatile("s_waitcnt vmcnt(0)" ::: "memory");
        } else {
            XB_SPIN(xb_ld(&bar[XB_XGEN(b.x)]) == gen, bar);
            __builtin_amdgcn_fence(__ATOMIC_ACQUIRE, "agent");
            asm volatile("s_waitcnt vmcnt(0)" ::: "memory");
        }
    }
    __syncthreads();
}

struct Frame {
    LAS unsigned char* lds;
    volatile LAS unsigned* MISC;
    gu32* ctl;
    int tid, lane, wave;
    int vcu, G;
    const float* const* in; float* out; unsigned char* ws;
};
enum { I_X = 0, I_ATTN_NORM, I_ATTN_WIN, I_ATTN_BF, I_ATTN_WOUT, I_FFN_NORM, I_FFN_WG, I_FFN_WU, I_FFN_WD, I_CONV_NORM, I_CONV_WIN, I_CONV_W, I_CONV_WOUT, I_MOE_NORM, I_MOE_WR, I_MOE_WG, I_MOE_WU, I_MOE_WD, I_FINAL_NORM };

__device__ __forceinline__ float wave_sum(float v) {
#pragma unroll
    for (int o = 1; o < 64; o <<= 1) v += __shfl_xor(v, o);
    return v;
}
__device__ __forceinline__ void tr_item(const float* W, int ldw, int K, bf16* WT, int k0, int n0, int drow0, LAS float* scr, int lane, const float* gain = nullptr) {
    { f32x4 t[8]; const int kr = lane >> 3, c4 = 4 * (lane & 7);
#pragma unroll
      for (int i = 0; i < 8; ++i) t[i] = *(const GAS f32x4*)(W + (size_t)(k0 + kr + 8 * i) * ldw + n0 + c4);
#pragma unroll
      for (int i = 0; i < 8; ++i) { const int kk = kr + 8 * i; const float gn = gain ? gain[k0 + kk] : 1.0f; LAS float* d = scr + kk * 33 + c4;
          d[0] = t[i].x * gn; d[1] = t[i].y * gn; d[2] = t[i].z * gn; d[3] = t[i].w * gn; } }
    LDS_WAIT(); asm volatile("" ::: "memory");
    const int c = lane & 7;
#pragma unroll
    for (int j = 0; j < 4; ++j) { const int n = (lane >> 3) + 8 * j; const LAS float* s = scr + (8 * c) * 33 + n;
        v4u o; o.x = pk2(s[0 * 33], s[1 * 33]); o.y = pk2(s[2 * 33], s[3 * 33]); o.z = pk2(s[4 * 33], s[5 * 33]); o.w = pk2(s[6 * 33], s[7 * 33]);
        *(GAS v4u*)(WT + (size_t)(drow0 + n) * K + k0 + 8 * c) = o; }
    LDS_WAIT(); asm volatile("" ::: "memory");
}
__device__ __forceinline__ void tr_item8(const float* W, int ldw, int Kb, unsigned char* WT, int k0, int n0, int drow0, LAS float* scr, int lane) {
    { f32x4 t[8]; const int kr = lane >> 3, c4 = 4 * (lane & 7);
#pragma unroll
      for (int i = 0; i < 8; ++i) t[i] = *(const GAS f32x4*)(W + (size_t)(k0 + kr + 8 * i) * ldw + n0 + c4);
#pragma unroll
      for (int i = 0; i < 8; ++i) { LAS float* d = scr + (kr + 8 * i) * 33 + c4;
          d[0] = t[i].x * pg8::W8_SCALE; d[1] = t[i].y * pg8::W8_SCALE; d[2] = t[i].z * pg8::W8_SCALE; d[3] = t[i].w * pg8::W8_SCALE; } }
    LDS_WAIT(); asm volatile("" ::: "memory");
#pragma unroll
    for (int j = 0; j < 2; ++j) { const int idx = lane + 64 * j, n = idx >> 2, c = idx & 3; const LAS float* s = scr + (16 * c) * 33 + n;
        v4u o; o.x = pg8::pk4_fp8(s[0 * 33], s[1 * 33], s[2 * 33], s[3 * 33]); o.y = pg8::pk4_fp8(s[4 * 33], s[5 * 33], s[6 * 33], s[7 * 33]);
        o.z = pg8::pk4_fp8(s[8 * 33], s[9 * 33], s[10 * 33], s[11 * 33]); o.w = pg8::pk4_fp8(s[12 * 33], s[13 * 33], s[14 * 33], s[15 * 33]);
        *(GAS v4u*)(WT + (size_t)(drow0 + n) * Kb + k0 + 16 * c) = o; }
    LDS_WAIT(); asm volatile("" ::: "memory");
}
struct TrItem { const float* W; const float* gain; unsigned char* WT; int ldw, Kb, k0, n0, drow0, fp8; };
__device__ __forceinline__ void tr_load(const TrItem& I, f32x4 (&t)[8], float (&gq)[8], int lane) {
    const int kr = lane >> 3, c4 = 4 * (lane & 7);
#pragma unroll
    for (int i = 0; i < 8; ++i) t[i] = *(const GAS f32x4*)(I.W + (size_t)(I.k0 + kr + 8 * i) * I.ldw + I.n0 + c4);
#pragma unroll
    for (int i = 0; i < 8; ++i) gq[i] = I.gain ? I.gain[I.k0 + kr + 8 * i] : 1.0f;
}
__device__ __forceinline__ void tr_to_lds(const TrItem& I, const f32x4 (&t)[8], const float (&gq)[8], LAS float* scr, int lane) {
    const int kr = lane >> 3, c4 = 4 * (lane & 7); const float sc = (I.fp8 == 1) ? pg8::W8_SCALE : 1.0f;
#pragma unroll
    for (int i = 0; i < 8; ++i) { const int kk = kr + 8 * i; const float gn = gq[i] * sc; LAS float* d = scr + kk * 33 + c4;
        d[0] = t[i].x * gn; d[1] = t[i].y * gn; d[2] = t[i].z * gn; d[3] = t[i].w * gn; }
    LDS_WAIT(); asm volatile("" ::: "memory");
}
__device__ __forceinline__ void tr_store(const TrItem& I, LAS float* scr, int lane) {
    if (I.fp8 == 1) {
#pragma unroll
        for (int j = 0; j < 2; ++j) { const int idx = lane + 64 * j, n = idx >> 2, c = idx & 3; const LAS float* s = scr + (16 * c) * 33 + n;
            v4u o; o.x = pg8::pk4_fp8(s[0 * 33], s[1 * 33], s[2 * 33], s[3 * 33]); o.y = pg8::pk4_fp8(s[4 * 33], s[5 * 33], s[6 * 33], s[7 * 33]);
            o.z = pg8::pk4_fp8(s[8 * 33], s[9 * 33], s[10 * 33], s[11 * 33]); o.w = pg8::pk4_fp8(s[12 * 33], s[13 * 33], s[14 * 33], s[15 * 33]);
            *(GAS v4u*)(I.WT + (size_t)(I.drow0 + n) * I.Kb + I.k0 + 16 * c) = o; }
    } else {
        const int c = lane & 7;
#pragma unroll
        for (int j = 0; j < 4; ++j) { const int n = (lane >> 3) + 8 * j; const LAS float* s = scr + (8 * c) * 33 + n;
            v4u o;
            if (I.fp8 == 2) { o.x = pg8::pk2h(s[0 * 33], s[1 * 33]); o.y = pg8::pk2h(s[2 * 33], s[3 * 33]); o.z = pg8::pk2h(s[4 * 33], s[5 * 33]); o.w = pg8::pk2h(s[6 * 33], s[7 * 33]); }
            else { o.x = pk2(s[0 * 33], s[1 * 33]); o.y = pk2(s[2 * 33], s[3 * 33]); o.z = pk2(s[4 * 33], s[5 * 33]); o.w = pk2(s[6 * 33], s[7 * 33]); }
            *(GAS v4u*)(I.WT + (size_t)(I.drow0 + n) * I.Kb + (size_t)(I.k0 + 8 * c) * 2) = o; }
    }
    LDS_WAIT(); asm volatile("" ::: "memory");
}
__device__ __forceinline__ int map_gate(int n0) { return 256 * (n0 >> 7) + (n0 & 127); }
__device__ __forceinline__ int map_up(int n0) { return 256 * (n0 >> 7) + 128 + (n0 & 127); }

__device__ __forceinline__ void rms_row(const float* xrow, const f32x4 (&g)[4], f32x4 (&v)[4], int lane) {
    const GAS f32x4* xr = (const GAS f32x4*)xrow + lane; float s = 0.f;
#pragma unroll
    for (int j = 0; j < 4; ++j) { v[j] = xr[64 * j]; s += (v[j].x * v[j].x + v[j].y * v[j].y) + (v[j].z * v[j].z + v[j].w * v[j].w); }
    const float rstd = 1.0f / sqrtf(wave_sum(s) * (1.f / D) + RMS_EPS);
#pragma unroll
    for (int j = 0; j < 4; ++j) v[j] = v[j] * rstd * g[j];
}
__device__ __forceinline__ void rms_load(const float* xrow, f32x4 (&v)[4], int lane) {
    const GAS f32x4* xr = (const GAS f32x4*)xrow + lane;
#pragma unroll
    for (int j = 0; j < 4; ++j) v[j] = __builtin_nontemporal_load(xr + 64 * j);
}
__device__ __forceinline__ void rms_finish(const f32x4 (&g)[4], f32x4 (&v)[4]) {
    float s = 0.f;
#pragma unroll
    for (int j = 0; j < 4; ++j) s += (v[j].x * v[j].x + v[j].y * v[j].y) + (v[j].z * v[j].z + v[j].w * v[j].w);
    const float rstd = 1.0f / sqrtf(wave_sum(s) * (1.f / D) + RMS_EPS);
#pragma unroll
    for (int j = 0; j < 4; ++j) v[j] = v[j] * rstd * g[j];
}
__device__ __forceinline__ void load_row_h16(const bf16* hrow, f32x4 (&v)[4], int lane) {
    typedef unsigned u32x2 __attribute__((ext_vector_type(2)));
    const GAS u32x2* hr = (const GAS u32x2*)hrow + lane;
#pragma unroll
    for (int j = 0; j < 4; ++j) { const u32x2 w = hr[64 * j]; v[j] = (f32x4){pg8::h_lo(w.x), pg8::h_hi(w.x), pg8::h_lo(w.y), pg8::h_hi(w.y)}; }
}
__device__ __forceinline__ void store_row_bf16(bf16* orow, const f32x4 (&v)[4], int lane) {
    GAS unsigned long long* o8 = (GAS unsigned long long*)orow + lane;
#pragma unroll
    for (int j = 0; j < 4; ++j) o8[64 * j] = (unsigned long long)pk2(v[j].x, v[j].y) | ((unsigned long long)pk2(v[j].z, v[j].w) << 32);
}
__device__ __forceinline__ void load_gain(const float* gp, f32x4 (&g)[4], int lane) {
#pragma unroll
    for (int j = 0; j < 4; ++j) g[j] = ((const GAS f32x4*)gp)[lane + 64 * j];
}

__device__ __forceinline__ void p0_prologue(Frame& F) {
    constexpr int WFLD = 1032;
    LAS bf16* wf = (LAS bf16*)(F.lds + RING_OFF);
    LAS float* wtot = (LAS float*)(F.lds + RING_OFF + 40960);
    const float* Win = F.in[I_ATTN_WIN];
    for (int i = 0; i < 32; ++i) { const int k = (F.tid >> 4) + 32 * i, h = F.tid & 15; wf[h * WFLD + k] = (bf16)f2bf(Win[(size_t)k * NIN + NQKV + h]); }
    __syncthreads();
    bf16* XN = (bf16*)(F.ws + WS_XN); float* C2 = (float*)(F.ws + WS_C2); float* CTOT = (float*)(F.ws + WS_CTOT);
    f32x4 g[4]; load_gain(F.in[I_ATTN_NORM], g, F.lane);
    const int hh = F.lane & 15, q4 = F.lane >> 4; const float bfg = F.in[I_ATTN_BF][hh];
    for (int chunk = blockIdx.x; chunk < NCH; chunk += F.G) {
        const int r0 = chunk * 128 + F.wave * 16;
        for (int rr = 0; rr < 16; rr += 2) { f32x4 v[4], w[4];
            rms_load(F.in[I_X] + (size_t)(r0 + rr) * D, v, F.lane); rms_load(F.in[I_X] + (size_t)(r0 + rr + 1) * D, w, F.lane);
            rms_finish(g, v); rms_finish(g, w); store_row_bf16(XN + (size_t)(r0 + rr) * D, v, F.lane); store_row_bf16(XN + (size_t)(r0 + rr + 1) * D, w, F.lane); }
        VM_WAIT();
        f32x4 acc = (f32x4){0.f, 0.f, 0.f, 0.f};
        const bf16* arow = XN + (size_t)(r0 + hh) * D + 8 * q4; const LAS bf16* brow = wf + hh * WFLD + 8 * q4;
        { bf16x8 af[32];
#pragma unroll
          for (int s = 0; s < 32; ++s) af[s] = *(const GAS bf16x8*)(arow + 32 * s);
#pragma unroll
          for (int s = 0; s < 32; ++s) { const bf16x8 b = *(const LAS bf16x8*)(brow + 32 * s); acc = __builtin_amdgcn_mfma_f32_16x16x32_bf16(af[s], b, acc, 0, 0, 0); } }
        float p[4], run = 0.f;
#pragma unroll
        for (int r = 0; r < 4; ++r) { const float x = acc[r] + bfg; const float ls = fminf(x, 0.f) - log1pf(expf(-fabsf(x))); run += ls; p[r] = run; }
        const float T0 = __shfl(run, hh), T1 = __shfl(run, hh + 16), T2 = __shfl(run, hh + 32), T3 = __shfl(run, hh + 48);
        const float excl = (q4 > 0 ? T0 : 0.f) + (q4 > 1 ? T1 : 0.f) + (q4 > 2 ? T2 : 0.f);
        if (q4 == 0) wtot[F.wave * 16 + hh] = (T0 + T1) + (T2 + T3);
        __syncthreads();
        float wp = 0.f, tot = 0.f;
#pragma unroll
        for (int i = 0; i < 8; ++i) { const float t = wtot[i * 16 + hh]; if (i < F.wave) wp += t; tot += t; }
        if (F.wave == 0 && q4 == 0) CTOT[chunk * 16 + hh] = tot;
        const int b = chunk / (SEQ / 128), t0 = (chunk % (SEQ / 128)) * 128 + F.wave * 16 + 4 * q4; const float base = wp + excl;
        *(GAS f32x4*)(C2 + (size_t)(b * H + hh) * SEQ + t0) = (f32x4){p[0] + base, p[1] + base, p[2] + base, p[3] + base};
        __syncthreads();
    }
}
constexpr int TI_QKV = (D / 64) * (NQKV / 32), TI_DD = (D / 64) * (D / 32), TI_DF = (D / 64) * (FF / 32), TI_FD = (FF / 64) * (D / 32);
constexpr int N_EARLY = TI_QKV + TI_DD, NITEMS = TI_QKV + TI_DD + 2 * TI_DF + TI_FD + TI_QKV + TI_DD + NE * (2 * TI_DF + TI_FD);
__device__ __forceinline__ void weight_copies(Frame& F, int it_lo, int it_hi, int cw, int ncw) {
    LAS float* scr = (LAS float*)(F.lds + RING_OFF + F.wave * 16384);
    constexpr int I_QKV = TI_QKV, I_DD = TI_DD, I_DF = TI_DF, I_FD = TI_FD;
    bf16* WQKV = (bf16*)(F.ws + WS_WQKV); bf16* WO = (bf16*)(F.ws + WS_WO); bf16* WGU = (bf16*)(F.ws + WS_WGU); bf16* WD = (bf16*)(F.ws + WS_WD);
    bf16* WCIN = (bf16*)(F.ws + WS_WCIN); bf16* WCO = (bf16*)(F.ws + WS_WCO); unsigned char* MGU = F.ws + WS_MGU8; unsigned char* MD = F.ws + WS_MD8;
    auto decode = [&](int it, TrItem& I) {
        int r = it; I.gain = nullptr; I.fp8 = 0;
        auto set = [&](const float* W, int ldw, int ncols, void* WT, int Kb) { const int nb = ncols / 32; I.W = W; I.ldw = ldw; I.WT = (unsigned char*)WT; I.Kb = Kb; I.k0 = 64 * (r / nb); I.n0 = 32 * (r % nb); I.drow0 = I.n0; };
        if (r < I_QKV) { set(F.in[I_ATTN_WIN], NIN, NQKV, WQKV, D * 2); return; } r -= I_QKV;
        if (r < I_DD) { set(F.in[I_ATTN_WOUT], D, D, WO, D * 2); return; } r -= I_DD;
        if (r < I_DF) { set(F.in[I_FFN_WG], FF, FF, WGU, D * 2); I.drow0 = map_gate(I.n0); I.gain = F.in[I_FFN_NORM]; I.fp8 = 2; return; } r -= I_DF;
        if (r < I_DF) { set(F.in[I_FFN_WU], FF, FF, WGU, D * 2); I.drow0 = map_up(I.n0); I.gain = F.in[I_FFN_NORM]; I.fp8 = 2; return; } r -= I_DF;
        if (r < I_FD) { set(F.in[I_FFN_WD], D, D, WD, FF * 2); return; } r -= I_FD;
        if (r < I_QKV) { set(F.in[I_CONV_WIN], NQKV, NQKV, WCIN, D * 2); const int n0 = I.n0;
            I.drow0 = n0 < D ? 2 * D + n0 : (n0 < 2 * D ? map_gate(n0 - D) : map_up(n0 - 2 * D)); I.gain = F.in[I_CONV_NORM]; I.fp8 = 2; return; } r -= I_QKV;
        if (r < I_DD) { set(F.in[I_CONV_WOUT], D, D, WCO, D * 2); return; } r -= I_DD;
        const int per_e = 2 * I_DF + I_FD, e = r / per_e; r -= e * per_e; I.fp8 = 1;
        if (r < I_DF) { set(F.in[I_MOE_WG] + (size_t)e * D * FF, FF, FF, MGU + (size_t)e * 2 * FF * D, D); I.drow0 = map_gate(I.n0); I.gain = F.in[I_MOE_NORM]; return; } r -= I_DF;
        if (r < I_DF) { set(F.in[I_MOE_WU] + (size_t)e * D * FF, FF, FF, MGU + (size_t)e * 2 * FF * D, D); I.drow0 = map_up(I.n0); I.gain = F.in[I_MOE_NORM]; return; } r -= I_DF;
        set(F.in[I_MOE_WD] + (size_t)e * FF * D, D, D, MD + (size_t)e * D * FF, FF);
    };
    f32x4 ta[8], tb[8], tc[8], td[8]; float ga[8], gb[8], gc[8], gd[8]; TrItem I; int itA = it_lo + cw; const int step = 4 * ncw;
#define WC_FIRST(T_, G_, OFF_) do { if (itA + (OFF_) < it_hi) { decode(itA + (OFF_), I); tr_load(I, T_, G_, F.lane); } } while (0)
#define WC_STEP(T_, G_, OFF_) do { if (itA + (OFF_) < it_hi) { decode(itA + (OFF_), I); tr_to_lds(I, T_, G_, scr, F.lane); \
            if (itA + (OFF_) + step < it_hi) { decode(itA + (OFF_) + step, I); tr_load(I, T_, G_, F.lane); } \
            decode(itA + (OFF_), I); tr_store(I, scr, F.lane); } } while (0)
    WC_FIRST(ta, ga, 0); WC_FIRST(tb, gb, ncw); WC_FIRST(tc, gc, 2 * ncw); WC_FIRST(td, gd, 3 * ncw);
    while (itA < it_hi) { WC_STEP(ta, ga, 0); WC_STEP(tb, gb, ncw); WC_STEP(tc, gc, 2 * ncw); WC_STEP(td, gd, 3 * ncw); itA += step; }
#undef WC_FIRST
#undef WC_STEP
}
__device__ __forceinline__ void p1_scan_fixup(Frame& F) {
    LAS float* part = (LAS float*)(F.lds + RING_OFF); LAS float* pre = part + 512;
    float* C2 = (float*)(F.ws + WS_C2); const float* CTOT = (const float*)(F.ws + WS_CTOT);
    for (int chunk = blockIdx.x; chunk < NCH; chunk += F.G) {
        const int b = chunk / (SEQ / 128), cb = chunk % (SEQ / 128), hh = F.tid & 15, j = F.tid >> 4;
        float s = 0.f;
        if (j < cb) s += CTOT[(b * (SEQ / 128) + j) * 16 + hh];
        if (j + 32 < cb) s += CTOT[(b * (SEQ / 128) + j + 32) * 16 + hh];
        part[j * 16 + hh] = s;
        __syncthreads();
        if (F.tid < 16) { float t = 0.f; for (int i = 0; i < 32; ++i) t += part[i * 16 + F.tid]; pre[F.tid] = t; }
        __syncthreads();
        const int h2 = F.tid >> 5, t4 = (F.tid & 31) * 4;
        GAS f32x4* p = (GAS f32x4*)(C2 + (size_t)(b * H + h2) * SEQ + cb * 128 + t4);
        const float pr = pre[h2]; const f32x4 v = *p; *p = (f32x4){(v.x + pr) * LOG2E, (v.y + pr) * LOG2E, (v.z + pr) * LOG2E, (v.w + pr) * LOG2E};
        __syncthreads();
    }
}
__device__ __forceinline__ void norm_phase(Frame& F, const float* gain) {
    f32x4 g[4]; load_gain(gain, g, F.lane); bf16* XN = (bf16*)(F.ws + WS_XN);
    const int gw = F.vcu * NWAVES + F.wave, NGW = F.G * NWAVES;
    for (int m = gw; m < M; m += NGW) { f32x4 v[4]; rms_row(F.out + (size_t)m * D, g, v, F.lane); store_row_bf16(XN + (size_t)m * D, v, F.lane); }
}
__device__ __forceinline__ void final_norm_phase(Frame& F) {
    f32x4 g[4]; load_gain(F.in[I_FINAL_NORM], g, F.lane);
    const int gw = F.vcu * NWAVES + F.wave, NGW = F.G * NWAVES;
    for (int m = gw; m < M; m += NGW) { f32x4 v[4]; rms_row(F.out + (size_t)m * D, g, v, F.lane); GAS f32x4* o = (GAS f32x4*)(F.out + (size_t)m * D) + F.lane;
#pragma unroll
        for (int j = 0; j < 4; ++j) o[64 * j] = v[j]; }
}
__device__ __forceinline__ void conv_fixup(Frame& F, int pm) {
    if ((pm % (SEQ / 256)) == 0) return;
    typedef unsigned u32x2 __attribute__((ext_vector_type(2)));
    const bf16* U = (const bf16*)(F.ws + WS_K); bf16* Z = (bf16*)(F.ws + WS_V); const float* cw = F.in[I_CONV_W];
    const float* zp = (const float*)(F.ws + WS_ZP); const float* bgb = (const float*)(F.ws + WS_BGB);
    const int r = F.tid >> 8, c4 = (F.tid & 255) * 4; const size_t g = (size_t)pm * 256 + r, gt0 = (size_t)pm * 256;
    const f32x4 z0 = *(const GAS f32x4*)(zp + ((size_t)pm * 2 + r) * D + c4), gt = *(const GAS f32x4*)(bgb + ((size_t)pm * 2 + r) * D + c4);
    const f32x4 w0 = *(const GAS f32x4*)(cw + c4), w1 = *(const GAS f32x4*)(cw + D + c4);
    const u32x2 ua = *(const GAS u32x2*)(U + (gt0 - 1) * D + c4), ub = *(const GAS u32x2*)(U + (gt0 - 2) * D + c4);
    const f32x4 a = (f32x4){bf_lo(ua.x), bf_hi(ua.x), bf_lo(ua.y), bf_hi(ua.y)}, b = (f32x4){bf_lo(ub.x), bf_hi(ub.x), bf_lo(ub.y), bf_hi(ub.y)};
    const f32x4 z = (r == 0) ? z0 + gt * (w0 * b + w1 * a) : z0 + gt * (w0 * a);
    u32x2 o; o.x = pk2(z.x, z.y); o.y = pk2(z.z, z.w); *(GAS u32x2*)(Z + g * D + c4) = o;
}
__device__ __forceinline__ void store_row_fp8(unsigned char* orow, const f32x4 (&v)[4], int lane) {
    GAS unsigned* o = (GAS unsigned*)orow + lane;
#pragma unroll
    for (int j = 0; j < 4; ++j) o[64 * j] = pg8::pk4_fp8(v[j].x, v[j].y, v[j].z, v[j].w);
}
__device__ __forceinline__ void route_phase(Frame& F) {
    constexpr int WLD = 1032;
    LAS _Float16* wh = (LAS _Float16*)(F.lds + RING_OFF);
    LAS _Float16* wl = wh + NE * WLD;
    LAS int* sel = (LAS int*)(F.lds + RING_OFF + 34816);
    LAS float* gv = (LAS float*)(F.lds + RING_OFF + 34816 + 1024);
    LAS int* wcnt = (LAS int*)(F.lds + RING_OFF + 34816 + 2048);
    static_assert(2 * NE * WLD * 2 <= 34816, "router tables");
    static_assert(D * NE == 16 * NWAVES * 64, "router table fill");
    float rw[16], rg[16];
    { const float* Wr = F.in[I_MOE_WR]; const float* gn = F.in[I_MOE_NORM];
#pragma unroll
      for (int j = 0; j < 16; ++j) { const int i = F.tid + j * NWAVES * 64; rw[j] = Wr[i]; rg[j] = gn[i >> 3]; } }
    unsigned char* XN8 = F.ws + WS_XN8;
    int* LIST = (int*)(F.ws + WS_LIST); unsigned* INV = (unsigned*)(F.ws + WS_INV); float* GT = (float*)(F.ws + WS_GATE); const bf16* HBc = (const bf16*)(F.ws + WS_HB);
    const int r = F.lane & 15, q = F.lane >> 4;
    for (int chunk = blockIdx.x; chunk < NCH; chunk += F.G) {
        const int rc = F.wave * 16 + r, m = chunk * 128 + rc;
        pg8::u32x4 hv[16][2]; { const GAS pg8::u32x4* hp = (const GAS pg8::u32x4*)(HBc + (size_t)m * D + 16 * q);
#pragma unroll
          for (int j = 0; j < 16; ++j) { hv[j][0] = hp[8 * j]; hv[j][1] = hp[8 * j + 1]; } }
        if (chunk == (int)blockIdx.x) {
#pragma unroll
            for (int j = 0; j < 16; ++j) { const int i = F.tid + j * NWAVES * 64, k = i >> 3, e = i & 7; const float w = rw[j] * rg[j]; const _Float16 hi = (_Float16)w;
                wh[e * WLD + k] = hi; wl[e * WLD + k] = (_Float16)((w - (float)hi) * 2048.f); }
            __syncthreads(); }
        pg8::f32x4 aH = (pg8::f32x4){0.f, 0.f, 0.f, 0.f}, aL = aH, aN = aH;
        const LAS _Float16* whp = wh + (r & 7) * WLD + 16 * q; const LAS _Float16* wlp = wl + (r & 7) * WLD + 16 * q;
#pragma unroll
        for (int j = 0; j < 16; ++j)
#pragma unroll
            for (int hf = 0; hf < 2; ++hf) { const pg8::f16x8 x = __builtin_bit_cast(pg8::f16x8, hv[j][hf]);
                const pg8::f16x8 wa = *(const LAS pg8::f16x8*)(whp + 64 * j + 8 * hf), wb = *(const LAS pg8::f16x8*)(wlp + 64 * j + 8 * hf);
                aH = __builtin_amdgcn_mfma_f32_16x16x32_f16(wa, x, aH, 0, 0, 0);
                aL = __builtin_amdgcn_mfma_f32_16x16x32_f16(wb, x, aL, 0, 0, 0);
                aN = __builtin_amdgcn_mfma_f32_16x16x32_f16(x, x, aN, 0, 0, 0); }
        const float dsel = (r & 3) == 0 ? aN[0] : ((r & 3) == 1 ? aN[1] : ((r & 3) == 2 ? aN[2] : aN[3]));
        const float rstd = 1.0f / sqrtf(__shfl(dsel, r + 16 * (r >> 2)) * (1.f / D) + RMS_EPS);
#pragma unroll
        for (int j = 0; j < 16; ++j) { const pg8::u32x4 a = hv[j][0], b = hv[j][1]; pg8::u32x4 o;
            o.x = pg8::pk4_fp8(pg8::h_lo(a.x) * rstd, pg8::h_hi(a.x) * rstd, pg8::h_lo(a.y) * rstd, pg8::h_hi(a.y) * rstd); o.y = pg8::pk4_fp8(pg8::h_lo(a.z) * rstd, pg8::h_hi(a.z) * rstd, pg8::h_lo(a.w) * rstd, pg8::h_hi(a.w) * rstd);
            o.z = pg8::pk4_fp8(pg8::h_lo(b.x) * rstd, pg8::h_hi(b.x) * rstd, pg8::h_lo(b.y) * rstd, pg8::h_hi(b.y) * rstd); o.w = pg8::pk4_fp8(pg8::h_lo(b.z) * rstd, pg8::h_hi(b.z) * rstd, pg8::h_lo(b.w) * rstd, pg8::h_hi(b.w) * rstd);
            *(GAS pg8::u32x4*)(XN8 + (size_t)m * D + 16 * (q + 4 * j)) = o; }
        float own[4], oth[4], lg[NE];
#pragma unroll
        for (int i = 0; i < 4; ++i) { own[i] = (aH[i] + aL[i] * (1.f / 2048.f)) * rstd; oth[i] = __shfl_xor(own[i], 16); }
#pragma unroll
        for (int i = 0; i < 4; ++i) { lg[i] = (q & 1) ? oth[i] : own[i]; lg[4 + i] = (q & 1) ? own[i] : oth[i]; }
        int e1 = 0; float v1 = lg[0];
#pragma unroll
        for (int e = 1; e < NE; ++e) if (lg[e] > v1) { v1 = lg[e]; e1 = e; }
        int e2 = -1; float v2 = -INFINITY;
#pragma unroll
        for (int e = 0; e < NE; ++e) if (e != e1 && lg[e] > v2) { v2 = lg[e]; e2 = e; }
        const float g1 = 1.0f / (1.0f + expf(v2 - v1));
        if (q == 0) { sel[rc * 2] = e1; sel[rc * 2 + 1] = e2; gv[rc * 2] = g1; gv[rc * 2 + 1] = 1.0f - g1; }
        __syncthreads();
        int my_e = -1, my_rank = 0;
        if (F.tid < 256) { my_e = sel[F.tid];
#pragma unroll
            for (int ex = 0; ex < NE; ++ex) { const unsigned long long mk = __ballot(my_e == ex); if (my_e == ex) my_rank = __popcll(mk & ((1ull << F.lane) - 1ull)); if (F.lane == 0) wcnt[F.wave * NE + ex] = __popcll(mk); } }
        __syncthreads();
        if (F.tid < NE) { const int c0 = wcnt[F.tid], c1 = wcnt[NE + F.tid], c2 = wcnt[2 * NE + F.tid], c3 = wcnt[3 * NE + F.tid], tot = c0 + c1 + c2 + c3;
            const int b = tot ? (int)__hip_atomic_fetch_add(F.ctl + CW_MOE + 64 * F.tid, (unsigned)tot, RLX_AGENT) : 0;
            wcnt[F.tid] = b; wcnt[NE + F.tid] = b + c0; wcnt[2 * NE + F.tid] = b + c0 + c1; wcnt[3 * NE + F.tid] = b + c0 + c1 + c2; }
        __syncthreads();
        if (F.tid < 256 && my_e >= 0) { const int pos = wcnt[F.wave * NE + my_e] + my_rank, tok = chunk * 128 + (F.tid >> 1);
            LIST[(size_t)my_e * M + pos] = tok; INV[tok * 2 + (F.tid & 1)] = ((unsigned)my_e << 20) | (unsigned)pos; GT[tok * 2 + (F.tid & 1)] = gv[F.tid]; }
        __syncthreads();
    }
}
__device__ __forceinline__ void moe_table(Frame& F) {
    LAS int* tab = (LAS int*)(F.lds + LDSCTL_OFF);
    if (F.tid < NE) tab[16 + F.tid] = (int)__hip_atomic_load(F.ctl + CW_MOE + 64 * F.tid, RLX_AGENT);
    __syncthreads();
    if (F.tid == 0) { int ts = 0; for (int e = 0; e < NE; ++e) { const int c = tab[16 + e]; tab[e] = ts; ts += (c + 255) >> 8; } tab[8] = ts; }
    __syncthreads();
}
__device__ __forceinline__ void final_phase(Frame& F) {
    typedef unsigned u32x2 __attribute__((ext_vector_type(2)));
    f32x4 g[4]; load_gain(F.in[I_FINAL_NORM], g, F.lane);
    const LAS int* tab = (const LAS int*)(F.lds + LDSCTL_OFF);
    const bf16* Y = (const bf16*)(F.ws + WS_Y); const bf16* HBc = (const bf16*)(F.ws + WS_HB); const unsigned* INV = (const unsigned*)(F.ws + WS_INV); const float* GT = (const float*)(F.ws + WS_GATE);
    const int gw = F.vcu * NWAVES + F.wave, NGW = F.G * NWAVES, nrow = (M - gw + NGW - 1) / NGW;
    for (int k0 = 0; k0 < nrow; k0 += 32) {
        const int kk = k0 + (F.lane >> 1); const bool okl = kk < nrow; const int ml = gw + kk * NGW;
        const unsigned ivl = okl ? INV[ml * 2 + (F.lane & 1)] : 0u; const float gtl = okl ? GT[ml * 2 + (F.lane & 1)] : 0.f;
        const int nb = (nrow - k0) < 32 ? (nrow - k0) : 32;
        u32x2 hw[4], ya[4], yb[4]; float g0 = 0.f, g1 = 0.f;
        auto issue = [&](int k, u32x2 (&h_)[4], u32x2 (&a_)[4], u32x2 (&b_)[4], float& g0_, float& g1_) {
            const unsigned i0 = __shfl(ivl, 2 * k), i1 = __shfl(ivl, 2 * k + 1); g0_ = __shfl(gtl, 2 * k); g1_ = __shfl(gtl, 2 * k + 1);
            const size_t r0 = (size_t)tab[i0 >> 20] * 256 + (i0 & 0xfffffu), r1 = (size_t)tab[i1 >> 20] * 256 + (i1 & 0xfffffu); const int m = gw + (k0 + k) * NGW;
            const GAS u32x2* xr = (const GAS u32x2*)(HBc + (size_t)m * D) + F.lane; const GAS u32x2* y0 = (const GAS u32x2*)(Y + r0 * D) + F.lane; const GAS u32x2* y1 = (const GAS u32x2*)(Y + r1 * D) + F.lane;
#pragma unroll
            for (int j = 0; j < 4; ++j) { h_[j] = xr[64 * j]; a_[j] = y0[64 * j]; b_[j] = y1[64 * j]; } };
        issue(0, hw, ya, yb, g0, g1);
        for (int k = 0; k < nb; ++k) {
            u32x2 hn[4] = {}, an[4] = {}, bn[4] = {}; float g0n = 0.f, g1n = 0.f;
            if (k + 1 < nb) issue(k + 1, hn, an, bn, g0n, g1n);
            f32x4 v[4]; float s = 0.f;
#pragma unroll
            for (int j = 0; j < 4; ++j) { const u32x2 a = ya[j], b = yb[j];
                v[j].x = pg8::h_lo(hw[j].x) + g0 * bf_lo(a.x) + g1 * bf_lo(b.x); v[j].y = pg8::h_hi(hw[j].x) + g0 * bf_hi(a.x) + g1 * bf_hi(b.x);
                v[j].z = pg8::h_lo(hw[j].y) + g0 * bf_lo(a.y) + g1 * bf_lo(b.y); v[j].w = pg8::h_hi(hw[j].y) + g0 * bf_hi(a.y) + g1 * bf_hi(b.y);
                s += (v[j].x * v[j].x + v[j].y * v[j].y) + (v[j].z * v[j].z + v[j].w * v[j].w); }
            const float rstd = 1.0f / sqrtf(wave_sum(s) * (1.f / D) + RMS_EPS);
            GAS f32x4* o = (GAS f32x4*)(F.out + (size_t)(gw + (k0 + k) * NGW) * D) + F.lane;
#pragma unroll
            for (int j = 0; j < 4; ++j) o[64 * j] = v[j] * rstd * g[j];
#pragma unroll
            for (int j = 0; j < 4; ++j) { hw[j] = hn[j]; ya[j] = an[j]; yb[j] = bn[j]; }
            g0 = g0n; g1 = g1n;
        }
    }
}
__device__ __forceinline__ int probe_two() { int n = 2; asm volatile("" : "+s"(n)); return n; }
#ifndef WG_P1
#define WG_P1 4
#endif
#ifndef WG_P5
#define WG_P5 4
#endif
#ifndef WG_P3
#define WG_P3 8
#endif
#ifndef WG_P6
#define WG_P6 8
#endif
#ifndef WG_P10
#define WG_P10 8
#endif
#ifndef WG_P8
#define WG_P8 8
#endif
#ifndef WG_P12
#define WG_P12 8
#endif
#ifndef WG_P13
#define WG_P13 16
#endif
struct Args { const float* in[19]; float* out; unsigned char* ws; int ph_lo, ph_hi; };
__global__ void __launch_bounds__(NWAVES * 64, 2) mk_fwd(Args args) {
    extern __shared__ __attribute__((aligned(16))) unsigned char lds[];
    Frame F;
    F.lds = (LAS unsigned char*)lds;
    F.MISC = (volatile LAS unsigned*)(F.lds + MISC_OFF);
    F.tid = threadIdx.x; F.lane = F.tid & 63; F.wave = __builtin_amdgcn_readfirstlane(F.tid >> 6);
    F.G = gridDim.x; { const int bx = blockIdx.x; F.vcu = (F.G % 8 == 0) ? (bx % 8) * (F.G / 8) + bx / 8 : bx; }
    F.ws = args.ws; F.out = args.out; F.ctl = (gu32*)(args.ws + WS_CTL);
    F.in = args.in;
    { int t0_ = F.tid; asm volatile("" : "+v"(t0_));
      for (int u = t0_; u < (LDS_BYTES - LDSCTL_OFF) / 4; u += NWAVES * 64) ((LAS unsigned*)(F.lds + LDSCTL_OFF))[u] = 0u; }
    __syncthreads();
    XcdBarrier bar; bar.bar = (unsigned*)(F.ctl + CW_BAR); bar.x = 0; bar.st = nullptr;
    if (!MK_PER_PHASE) bar = xcd_barrier_post((unsigned*)(F.ctl + CW_BAR), F.MISC + 8);
#define GRID_BAR() do { if (!MK_PER_PHASE) xcd_barrier(bar); } while (0)
    const int lo = args.ph_lo, hi = args.ph_hi;
#ifndef PH_MASK
#define PH_MASK 0x1ffff
#endif
#define IN(k) (((PH_MASK >> (k)) & 1) && lo <= (k) && (k) < hi)
#define BOTH(k) (IN(k) && IN((k) + 1))
#ifndef PROBE_PH
#define PROBE_PH (-1)
#endif
#define REP_BEGIN(k) for (int rep_ = 0, nrep_ = ((k) == PROBE_PH ? probe_two() : 1); rep_ < nrep_; ++rep_) {
#define REP_END(k) if (rep_ + 1 < nrep_) GRID_BAR(); }
    bf16* XN = (bf16*)(F.ws + WS_XN); bf16* QO = (bf16*)(F.ws + WS_QO); bf16* KB = (bf16*)(F.ws + WS_K); bf16* VB = (bf16*)(F.ws + WS_V); bf16* HID = (bf16*)(F.ws + WS_HID); bf16* OB = (bf16*)(F.ws + WS_O); bf16* HB = (bf16*)(F.ws + WS_HB);
    const int bx = (int)blockIdx.x;
#ifndef PROBE_T
#define PROBE_T (-1)
#endif
#ifndef PROBE_MULT
#define PROBE_MULT 8
#endif
    unsigned long long pt0_ = 0ull;
#define PH_T0(k) do { if ((k) == PROBE_T) pt0_ = __builtin_amdgcn_s_memrealtime(); } while (0)
#define PH_SPIN(k) do { if ((k) == PROBE_T) { const unsigned long long d_ = __builtin_amdgcn_s_memrealtime() - pt0_; while (__builtin_amdgcn_s_memrealtime() - pt0_ < (1ull + PROBE_MULT) * d_) __builtin_amdgcn_s_sleep(8); } } while (0)
#define REFRESH_F() do { int t_ = threadIdx.x; asm volatile("" : "+v"(t_)); F.tid = t_; F.lane = t_ & 63; } while (0)

    if (IN(0)) { PH_T0(0); REP_BEGIN(0) p0_prologue(F); __syncthreads(); weight_copies(F, 0, N_EARLY, F.vcu * NWAVES + F.wave, F.G * NWAVES); REP_END(0) PH_SPIN(0); if (BOTH(0)) GRID_BAR(); }
    if (IN(1)) {
        PH_T0(1); p1_scan_fixup(F);
        REP_BEGIN(1)
        typedef pg8::DenseSched<D, M / 256, NQKV / 256, WG_P1> Sc; typedef pg8::EpiBf16<D, D> Ep;
        Sc S{F.G, bx, (const char*)(F.ws + WS_WQKV)}; Ep E{QO, (size_t)(WS_K - WS_QO) / 2, QSCALE, (unsigned*)(F.ctl + CW_NRM), SEQ};
        pg8::gemm_phase<D, Ep, Sc, true, true>(F.lds + RING_OFF, (const char*)XN, S, E);
        REP_END(1)
        PH_SPIN(1); if (BOTH(1)) GRID_BAR();
    }
    if (IN(2)) {
        PH_T0(2);
        if (((bx >> 3) & 3) == 0 && F.G == 256) { weight_copies(F, N_EARLY, NITEMS, ((bx >> 5) * 8 + (bx & 7)) * NWAVES + F.wave, 64 * NWAVES); __syncthreads(); }
        else if (F.G != 256) { weight_copies(F, N_EARLY, NITEMS, F.vcu * NWAVES + F.wave, F.G * NWAVES); __syncthreads(); }
        REP_BEGIN(2)
        ATTN_PHASE_BODY
        REP_END(2)
        PH_SPIN(2); if (BOTH(2)) GRID_BAR();
    }
    if (IN(3)) {
        PH_T0(3);
        REP_BEGIN(3)
        typedef pg8::DenseSched<D, M / 256, D / 256, WG_P3> Sc; typedef pg8::EpiResH16<D, false, true> Ep;
        Sc S{F.G, bx, (const char*)(F.ws + WS_WO)}; Ep E{F.in[I_X], HB, (float*)(F.ws + WS_SS)};
        pg8::gemm_phase<D, Ep, Sc, true, true>(F.lds + RING_OFF, (const char*)OB, S, E);
        REP_END(3)
        PH_SPIN(3); if (BOTH(3)) GRID_BAR();
    }
    if (IN(5)) {
        PH_T0(5);
        REP_BEGIN(5)
        typedef pg8::DenseSched<D, M / 256, 2 * FF / 256, WG_P5> Sc; typedef pg8::EpiSwiGLU<FF, true> Ep;
        Sc S{F.G, bx, (const char*)(F.ws + WS_WGU)}; Ep E{HID, pg8::RowScale{(const float*)(F.ws + WS_SS), (PG8_LAS float*)(F.lds + RSTAB_OFF), -1, 1.0f / D, RMS_EPS}};
        pg8::gemm_phase<D, Ep, Sc, true, true, 2>(F.lds + RING_OFF, (const char*)HB, S, E);
        REP_END(5)
        PH_SPIN(5); if (BOTH(5)) GRID_BAR();
    }
    if (IN(6)) {
        PH_T0(6);
        typedef pg8::DenseSched<FF, M / 256, D / 256, WG_P6> Sc; typedef pg8::EpiResH16<D, true, true> Ep;
        Sc S{F.G, bx, (const char*)(F.ws + WS_WD)}; Ep E{HB, HB, (float*)(F.ws + WS_SS)};
        pg8::gemm_phase<FF, Ep, Sc, true, true>(F.lds + RING_OFF, (const char*)HID, S, E);
        PH_SPIN(6); if (BOTH(6)) GRID_BAR();
    }
    if (IN(8)) {
        PH_T0(8);
        REP_BEGIN(8)
        typedef pg8::ConvSched<D, M / 256, D, SEQ / 256, WG_P8> Sc; typedef pg8::EpiConvIn<D> Ep;
        Sc S{F.G, bx, (const char*)(F.ws + WS_WCIN), KB, QO, VB, F.in[I_CONV_W], (float*)(F.ws + WS_ZP), (float*)(F.ws + WS_BGB)}; Ep E{KB, QO, pg8::RowScale{(const float*)(F.ws + WS_SS), (PG8_LAS float*)(F.lds + RSTAB_OFF), -1, 1.0f / D, RMS_EPS}};
        pg8::gemm_phase<D, Ep, Sc, true, true, 2>(F.lds + RING_OFF, (const char*)HB, S, E);
        REP_END(8)
        PH_SPIN(8); if (BOTH(8)) GRID_BAR();
    }
    if (IN(10)) {
        PH_T0(10); REFRESH_F();
        { pg8::Unit u0_; pg8::DenseSched<D, M / 256, D / 256, WG_P10> S0{F.G, bx, nullptr}; for (int i = 0; S0.next(i, u0_); ++i) conv_fixup(F, u0_.pm); VM_WAIT(); __syncthreads(); }
        typedef pg8::DenseSched<D, M / 256, D / 256, WG_P10> Sc; typedef pg8::EpiResH16<D, true, false> Ep;
        Sc S{F.G, bx, (const char*)(F.ws + WS_WCO)}; Ep E{HB, HB, nullptr};
        pg8::gemm_phase<D, Ep, Sc, true, true>(F.lds + RING_OFF, (const char*)VB, S, E);
        PH_SPIN(10); if (BOTH(10)) GRID_BAR();
    }
    if (IN(11)) { PH_T0(11); REFRESH_F(); route_phase(F); PH_SPIN(11); if (BOTH(11)) GRID_BAR(); }
    {
        const int* list = (const int*)(F.ws + WS_LIST); const PG8_LAS int* tab = (const PG8_LAS int*)(F.lds + LDSCTL_OFF);
        if (IN(12)) {
            PH_T0(12); REFRESH_F(); moe_table(F);
            REP_BEGIN(12)
            typedef pg8::MoeSched<true, D / 2, 2 * FF / 256, M, WG_P12> Sc; typedef pg8::EpiSwiGLU8<FF> Ep;
            Sc S{F.G, bx, (const char*)(F.ws + WS_MGU8), tab, list, (const PG8_LAS unsigned short*)(F.lds + GTOK_OFF)}; Ep E{F.ws + WS_HID8};
            S.fill_gtok((PG8_LAS unsigned short*)(F.lds + GTOK_OFF), GTOK_UNITS);
            pg8::gemm_phase<D / 2, Ep, Sc, true, true, 1>(F.lds + RING_OFF, (const char*)(F.ws + WS_XN8), S, E);
            REP_END(12)
            PH_SPIN(12); if (BOTH(12)) GRID_BAR();
        }
        if (IN(13)) {
            PH_T0(13); REFRESH_F(); moe_table(F);
            typedef pg8::MoeSched<false, FF / 2, D / 256, M, WG_P13> Sc; typedef pg8::EpiY8<D> Ep;
            Sc S{F.G, bx, (const char*)(F.ws + WS_MD8), tab, list, nullptr}; Ep E{(bf16*)(F.ws + WS_Y)};
            pg8::gemm_phase<FF / 2, Ep, Sc, true, true, 1>(F.lds + RING_OFF, (const char*)(F.ws + WS_HID8), S, E);
            PH_SPIN(13); if (BOTH(13)) GRID_BAR();
        }
    }
    if (IN(14)) { PH_T0(14); REFRESH_F(); moe_table(F); final_phase(F); PH_SPIN(14); }
#undef IN
#undef BOTH
#undef GRID_BAR
}

extern "C" void kernel_launch(void* const* d_in, const int* in_sizes, int n_in, void* d_out, int out_size, void* d_ws, size_t ws_size, hipStream_t stream) {
    static int grid = 0;
    if (grid == 0) {
        if (n_in != 19 || in_sizes[0] != M * D || out_size != M * D || ws_size < WS_END) { fprintf(stderr, "kernel_launch: built for 19 inputs, x and out of %d floats, >= %zu bytes of workspace; got n_in %d, in0 %d, out %d, ws %zu; nothing launched\n", M * D, (size_t)WS_END, n_in, n_in > 0 ? in_sizes[0] : -1, out_size, ws_size); grid = -1; return; }
        int dev = 0, cus = 0, per_cu = 0;
        if (hipGetDevice(&dev) != hipSuccess || hipDeviceGetAttribute(&cus, hipDeviceAttributeMultiprocessorCount, dev) != hipSuccess) { fprintf(stderr, "kernel_launch: hipGetDevice / hipDeviceGetAttribute failed; nothing launched\n"); grid = -1; return; }
        if (hipFuncSetAttribute((const void*)mk_fwd, hipFuncAttributeMaxDynamicSharedMemorySize, LDS_BYTES) != hipSuccess) { fprintf(stderr, "kernel_launch: hipFuncSetAttribute failed; nothing launched\n"); grid = -1; return; }
        if (hipOccupancyMaxActiveBlocksPerMultiprocessor(&per_cu, (const void*)mk_fwd, NWAVES * 64, LDS_BYTES) != hipSuccess || per_cu < 1)
            fprintf(stderr, "kernel_launch: note: the occupancy query reports %d workgroups per CU\n", per_cu);
        (void)hipGetLastError();
        grid = cus;
    }
    if (grid < 0) return;
    if (hipMemsetAsync((char*)d_ws + WS_CTL, 0, CTL_ZERO_BYTES, stream) != hipSuccess) { fprintf(stderr, "kernel_launch: hipMemsetAsync of the control words failed; nothing launched\n"); return; }
    Args a{};
    for (int i = 0; i < 19; ++i) a.in[i] = (const float*)d_in[i];
    a.out = (float*)d_out; a.ws = (unsigned char*)d_ws;
    const int nl = MK_PER_PHASE ? N_PHASES : 1;
    for (int li = 0; li < nl; ++li) {
        a.ph_lo = MK_PER_PHASE ? li : 0; a.ph_hi = MK_PER_PHASE ? li + 1 : N_PHASES;
        hipLaunchKernelGGL(mk_fwd, dim3(grid), dim3(NWAVES * 64), LDS_BYTES, stream, a);
        const hipError_t le = hipPeekAtLastError();
        if (le != hipSuccess) { fprintf(stderr, "kernel_launch: launch %d failed: %s\n", li, hipGetErrorName(le)); break; }
    }
}
```
